# Optimizing an MI355X kernel written in HIP

```python
import math
import jax, jax.numpy as jnp
from jax import lax
import numpy as np

D_MODEL = 4096
BATCH = 4
SEQ = 4096
DEPTH = 2

GRID_W = 64
CTX_LEN = 256
N_MIXERS = 2
EPS = 1e-6

DA_HEADS = 16
DA_HEAD_DIM = 128
DA_V_DIM = 2 * DA_HEAD_DIM
DA_Q_W = DA_HEADS * 2 * DA_HEAD_DIM
DA_K_W = DA_HEADS * 2 * DA_HEAD_DIM
DA_V_W = DA_HEADS * DA_V_DIM
DA_GATE_W = DA_V_W
DA_IN_W = DA_Q_W + DA_K_W + DA_V_W + DA_GATE_W
DA_K0 = DA_Q_W
DA_V0 = DA_Q_W + DA_K_W
DA_G0 = DA_Q_W + DA_K_W + DA_V_W
Q_BLOCK = 128
ROPE_BASE = 10000.0

S5_WIDTH = D_MODEL
S5_GROUP = 16
S5_GROUPS = S5_WIDTH // S5_GROUP
S5_STATE = 64
DT_MIN = 1e-3
DT_MAX = 1e-1

N_ATTN_LAYERS = (DEPTH + 1) // 2
N_S5_LAYERS = DEPTH // 2

kernel_name = 'hybrid_diffattn_s5_prefix_dit'


def rmsnorm(x, g):
    xf = x.astype(jnp.float32)
    y = xf * lax.rsqrt(jnp.mean(xf * xf, axis=-1, keepdims=True) + EPS)
    return (y * g.astype(jnp.float32)).astype(x.dtype)


def axial_rope_tables(n_tokens):
    rows = n_tokens // GRID_W
    row = jnp.repeat(jnp.arange(rows), GRID_W)
    col = jnp.tile(jnp.arange(GRID_W), rows)
    n_freq = DA_HEAD_DIM // 4
    inv_freq = ROPE_BASE ** (-jnp.arange(n_freq, dtype=jnp.float32) / n_freq)
    ang = jnp.stack([row, col], axis=-1).astype(jnp.float32)[:, :, None] * inv_freq
    return jnp.cos(ang)[:, :, None, :], jnp.sin(ang)[:, :, None, :]


def apply_axial_rope(t, cos, sin):
    shp = t.shape
    tr = t.reshape(shp[:-1] + (2, 2, shp[-1] // 4))
    rot = jnp.stack([-tr[..., 1, :], tr[..., 0, :]], axis=-2)
    return (tr * cos.astype(t.dtype) + rot * sin.astype(t.dtype)).reshape(shp)


def split_qk(t):
    b, n = t.shape[:2]
    return t.reshape(b, n, DA_HEADS, 2, DA_HEAD_DIM).transpose(3, 0, 2, 1, 4)


def split_v(t):
    b, n = t.shape[:2]
    return t.reshape(b, n, DA_HEADS, DA_V_DIM).transpose(0, 2, 1, 3)


def diff_softmax_core(q, k, v, lam):
    s = jnp.einsum('nbhqd,nbhkd->nbhqk', q, k).astype(jnp.float32) * (DA_HEAD_DIM ** -0.5)
    p = jax.nn.softmax(s, axis=-1)
    w = p[0] - lam * p[1]
    return jnp.einsum('bhqk,bhkv->bhqv', w.astype(v.dtype), v)


def diff_attn_mixer(h_lat, h_ctx, w_in, w_out, lam_vecs, subln_g, lam_init, need_ctx_out):
    bsz, n_lat, _ = h_lat.shape
    p_lat = h_lat @ w_in
    cos, sin = axial_rope_tables(n_lat)
    q_lat = apply_axial_rope(split_qk(p_lat[..., :DA_K0]), cos, sin)
    k_lat = apply_axial_rope(split_qk(p_lat[..., DA_K0:DA_V0]), cos, sin)
    v_lat = split_v(p_lat[..., DA_V0:DA_G0])
    g_lat = p_lat[..., DA_G0:]
    if need_ctx_out:
        p_ctx = h_ctx @ w_in
        kv_ctx = p_ctx[..., DA_K0:DA_G0]
    else:
        kv_ctx = h_ctx @ w_in[:, DA_K0:DA_G0]
    k_ctx = split_qk(kv_ctx[..., :DA_K_W])
    v_ctx = split_v(kv_ctx[..., DA_K_W:])
    lv = lam_vecs.astype(jnp.float32)
    lam = jnp.exp(jnp.sum(lv[0] * lv[1])) - jnp.exp(jnp.sum(lv[2] * lv[3])) + lam_init
    k_all = jnp.concatenate([k_ctx, k_lat], axis=3)
    v_all = jnp.concatenate([v_ctx, v_lat], axis=2)
    n_blk = n_lat // Q_BLOCK
    q_blocks = q_lat.reshape(2, bsz, DA_HEADS, n_blk, Q_BLOCK, DA_HEAD_DIM).transpose(3, 0, 1, 2, 4, 5)
    o_blocks = lax.map(lambda qb: diff_softmax_core(qb, k_all, v_all, lam), q_blocks)
    o_lat = o_blocks.transpose(1, 2, 0, 3, 4).reshape(bsz, DA_HEADS, n_lat, DA_V_DIM)

    def finish(o, gate):
        o = rmsnorm(o, subln_g) * (1.0 - lam_init)
        o = o.transpose(0, 2, 1, 3).reshape(o.shape[0], o.shape[2], DA_V_W)
        return (o * jax.nn.silu(gate)) @ w_out

    out_lat = finish(o_lat, g_lat)
    out_ctx = None
    if need_ctx_out:
        q_ctx = split_qk(p_ctx[..., :DA_K0])
        o_ctx = diff_softmax_core(q_ctx, k_ctx, v_ctx, lam)
        out_ctx = finish(o_ctx, p_ctx[..., DA_G0:])
    return out_lat, out_ctx


def s5_discretize(A_re, A_im, log_dt, B_re, B_im):
    A_re = A_re.astype(jnp.float32)
    A_im = A_im.astype(jnp.float32)
    dt = jnp.exp(log_dt.astype(jnp.float32))[:, None]
    mag = jnp.exp(A_re * dt)
    a_re = mag * jnp.cos(A_im * dt)
    a_im = mag * jnp.sin(A_im * dt)
    den = A_re * A_re + A_im * A_im
    f_re = ((a_re - 1.0) * A_re + a_im * A_im) / den
    f_im = (a_im * A_re - (a_re - 1.0) * A_im) / den
    B_re = B_re.astype(jnp.float32)
    B_im = B_im.astype(jnp.float32)
    bb_re = f_re[..., None] * B_re - f_im[..., None] * B_im
    bb_im = f_re[..., None] * B_im + f_im[..., None] * B_re
    return a_re, a_im, bb_re, bb_im


def ssm_combine(e1, e2):
    a1r, a1i, b1r, b1i = e1
    a2r, a2i, b2r, b2i = e2
    return (a2r * a1r - a2i * a1i,
            a2r * a1i + a2i * a1r,
            a2r * b1r - a2i * b1i + b2r,
            a2r * b1i + a2i * b1r + b2i)


def s5_scan(u, a_re, a_im, bb_re, bb_im, h0):
    bu_re = jnp.einsum('lbgc,gpc->lbgp', u, bb_re)
    bu_im = jnp.einsum('lbgc,gpc->lbgp', u, bb_im)
    if h0 is not None:
        h0_re, h0_im = h0
        bu_re = bu_re.at[0].add(a_re * h0_re - a_im * h0_im)
        bu_im = bu_im.at[0].add(a_re * h0_im + a_im * h0_re)
    n = u.shape[0]
    ar = jnp.broadcast_to(a_re, (n, 1) + a_re.shape)
    ai = jnp.broadcast_to(a_im, (n, 1) + a_im.shape)
    _, _, h_re, h_im = lax.associative_scan(ssm_combine, (ar, ai, bu_re, bu_im), axis=0)
    return h_re, h_im


def s5_readout(h_re, h_im, C_re, C_im):
    return (jnp.einsum('lbgp,gcp->lbgc', h_re, C_re.astype(jnp.float32))
            - jnp.einsum('lbgp,gcp->lbgc', h_im, C_im.astype(jnp.float32)))


def to_groups(u):
    b, n = u.shape[:2]
    return u.astype(jnp.float32).reshape(b, n, S5_GROUPS, S5_GROUP).transpose(1, 0, 2, 3)


def from_groups(y):
    n, b = y.shape[:2]
    return y.transpose(1, 0, 2, 3).reshape(b, n, S5_WIDTH)


def s5_mixer(h_lat, h_ctx, w_in, A_re, A_im, log_dt, B_re, B_im, C_re, C_im, d_skip, w_glu, w_out, need_ctx_out):
    p_lat = h_lat @ w_in
    u_lat, z_lat = p_lat[..., :S5_WIDTH], p_lat[..., S5_WIDTH:]
    if need_ctx_out:
        p_ctx = h_ctx @ w_in
        u_ctx, z_ctx = p_ctx[..., :S5_WIDTH], p_ctx[..., S5_WIDTH:]
    else:
        u_ctx = h_ctx @ w_in[:, :S5_WIDTH]
    ug_lat = to_groups(u_lat)
    ug_ctx = to_groups(u_ctx)
    y_lat = jnp.zeros_like(ug_lat)
    y_ctx = jnp.zeros_like(ug_ctx)
    for d in range(2):
        a_re, a_im, bb_re, bb_im = s5_discretize(A_re[d], A_im[d], log_dt[d], B_re[d], B_im[d])
        uc = ug_ctx if d == 0 else ug_ctx[::-1]
        ul = ug_lat if d == 0 else ug_lat[::-1]
        hc_re, hc_im = s5_scan(uc, a_re, a_im, bb_re, bb_im, None)
        hl_re, hl_im = s5_scan(ul, a_re, a_im, bb_re, bb_im, (hc_re[-1], hc_im[-1]))
        yl = s5_readout(hl_re, hl_im, C_re[d], C_im[d])
        y_lat = y_lat + (yl if d == 0 else yl[::-1])
        if need_ctx_out:
            yc = s5_readout(hc_re, hc_im, C_re[d], C_im[d])
            y_ctx = y_ctx + (yc if d == 0 else yc[::-1])
    dk = d_skip.astype(jnp.float32)

    def finish(y, u, z):
        y = (from_groups(y) + dk * u.astype(jnp.float32)).astype(u.dtype)
        y = jax.nn.gelu(y)
        y = y * jax.nn.sigmoid(y @ w_glu)
        return (y * jax.nn.silu(z)) @ w_out

    out_lat = finish(y_lat, u_lat, z_lat)
    out_ctx = finish(y_ctx, u_ctx, z_ctx) if need_ctx_out else None
    return out_lat, out_ctx


def setup_inputs(seed: int = 0) -> dict:
    key = jax.random.key(seed)
    ks = jax.random.split(key, 24)
    nrm = jax.random.normal
    E, G, P, C16 = S5_WIDTH, S5_GROUPS, S5_STATE, S5_GROUP
    NA, NS = N_ATTN_LAYERS, N_S5_LAYERS
    x = nrm(ks[0], (BATCH, SEQ, D_MODEL), jnp.float32)
    c = nrm(ks[1], (BATCH, D_MODEL), jnp.float32)
    ctx = nrm(ks[2], (BATCH, CTX_LEN, D_MODEL), jnp.float32)
    c_ctx = nrm(ks[3], (D_MODEL,), jnp.float32)
    ada_w = nrm(ks[4], (DEPTH, D_MODEL, 3 * D_MODEL), jnp.float32) * D_MODEL ** -0.5
    ada_b = 0.01 * nrm(ks[5], (DEPTH, 3 * D_MODEL), jnp.float32)
    norm_pre = 1.0 + 0.02 * nrm(ks[6], (DEPTH, D_MODEL), jnp.float32)
    norm_post = 1.0 + 0.02 * nrm(ks[7], (DEPTH, D_MODEL), jnp.float32)
    attn_w_in = nrm(ks[8], (NA, D_MODEL, DA_IN_W), jnp.float32) * D_MODEL ** -0.5
    attn_w_out = nrm(ks[9], (NA, DA_V_W, D_MODEL), jnp.float32) * DA_V_W ** -0.5
    attn_lam = 0.1 * nrm(ks[10], (NA, 4, DA_HEAD_DIM), jnp.float32)
    attn_subln = 1.0 + 0.02 * nrm(ks[11], (NA, DA_V_DIM), jnp.float32)
    s5_w_in = nrm(ks[12], (NS, D_MODEL, 2 * E), jnp.float32) * D_MODEL ** -0.5
    s5_A_re = -0.5 + 0.01 * nrm(ks[13], (NS, 2, G, P), jnp.float32)
    s5_A_im = math.pi * jnp.arange(P, dtype=jnp.float32) + 0.01 * nrm(ks[14], (NS, 2, G, P), jnp.float32)
    s5_log_dt = jax.random.uniform(ks[15], (NS, 2, G), jnp.float32, math.log(DT_MIN), math.log(DT_MAX))
    s5_B_re = nrm(ks[16], (NS, 2, G, P, C16), jnp.float32) * (2 * C16) ** -0.5
    s5_B_im = nrm(ks[17], (NS, 2, G, P, C16), jnp.float32) * (2 * C16) ** -0.5
    s5_C_re = nrm(ks[18], (NS, 2, G, C16, P), jnp.float32) * (2 * P) ** -0.5
    s5_C_im = nrm(ks[19], (NS, 2, G, C16, P), jnp.float32) * (2 * P) ** -0.5
    s5_D = 0.5 * nrm(ks[20], (NS, E), jnp.float32)
    s5_w_glu = nrm(ks[21], (NS, E, E), jnp.float32) * E ** -0.5
    s5_w_out = nrm(ks[22], (NS, E, D_MODEL), jnp.float32) * E ** -0.5
    return {'x': x, 'c': c, 'ctx': ctx, 'c_ctx': c_ctx,
            'ada_w': ada_w, 'ada_b': ada_b, 'norm_pre': norm_pre, 'norm_post': norm_post,
            'attn_w_in': attn_w_in, 'attn_w_out': attn_w_out, 'attn_lam': attn_lam, 'attn_subln': attn_subln,
            's5_w_in': s5_w_in, 's5_A_re': s5_A_re, 's5_A_im': s5_A_im, 's5_log_dt': s5_log_dt,
            's5_B_re': s5_B_re, 's5_B_im': s5_B_im, 's5_C_re': s5_C_re, 's5_C_im': s5_C_im,
            's5_D': s5_D, 's5_w_glu': s5_w_glu, 's5_w_out': s5_w_out}


def reference(x, c, ctx, c_ctx, ada_w, ada_b, norm_pre, norm_post,
              attn_w_in, attn_w_out, attn_lam, attn_subln,
              s5_w_in, s5_A_re, s5_A_im, s5_log_dt, s5_B_re, s5_B_im, s5_C_re, s5_C_im,
              s5_D, s5_w_glu, s5_w_out):
    x_lat, x_ctx = x, ctx
    for i in range(DEPTH):
        need_ctx_out = i < DEPTH - 1
        mod = jax.nn.silu(c) @ ada_w[i] + ada_b[i]
        mod_c = jax.nn.silu(c_ctx) @ ada_w[i] + ada_b[i]
        shift, scale, gate = jnp.split(mod, 3, axis=-1)
        shift_c, scale_c, gate_c = jnp.split(mod_c, 3, axis=-1)
        h_lat = rmsnorm(x_lat, norm_pre[i]) * (1.0 + scale[:, None, :]) + shift[:, None, :]
        h_ctx = rmsnorm(x_ctx, norm_pre[i]) * (1.0 + scale_c) + shift_c
        j = i // N_MIXERS
        if i % N_MIXERS == 0:
            lam_init = 0.8 - 0.6 * math.exp(-0.3 * i)
            out_lat, out_ctx = diff_attn_mixer(h_lat, h_ctx, attn_w_in[j], attn_w_out[j], attn_lam[j],
                                               attn_subln[j], lam_init, need_ctx_out)
        else:
            out_lat, out_ctx = s5_mixer(h_lat, h_ctx, s5_w_in[j], s5_A_re[j], s5_A_im[j], s5_log_dt[j],
                                        s5_B_re[j], s5_B_im[j], s5_C_re[j], s5_C_im[j], s5_D[j],
                                        s5_w_glu[j], s5_w_out[j], need_ctx_out)
        x_lat = x_lat + gate[:, None, :] * rmsnorm(out_lat, norm_post[i])
        if need_ctx_out:
            x_ctx = x_ctx + gate_c * rmsnorm(out_ctx, norm_post[i])
    return x_lat
```

```cpp
#include <hip/hip_runtime.h>
#include <cstdio>
#include <cstdint>
#include <type_traits>

#ifndef MK_PER_PHASE
#define MK_PER_PHASE 0
#endif
#ifndef MK_LAST_PHASE
#define MK_LAST_PHASE 14
#endif

namespace pg8 {
#define PG8_LAS __attribute__((address_space(3)))
typedef unsigned short bf16_t;
typedef short bf16x8 __attribute__((ext_vector_type(8)));
typedef float f32x4 __attribute__((ext_vector_type(4)));
typedef unsigned u32x4 __attribute__((ext_vector_type(4)));
typedef int i32x4 __attribute__((ext_vector_type(4)));
constexpr int BM = 256, BK = 64, HALF = 128, HTB = HALF * BK * 2, STAGE_BYTES = 8 * HTB, NXCD = 8, WGM = 8;

__host__ __device__ __forceinline__ int lds_byte(int r, int c) { const int st = (r >> 4) * 2 + (c >> 5), rr = r & 15, cc = c & 31, ob = rr * 64 + cc * 2; return st * 1024 + (ob ^ (((ob >> 9) & 1) << 5)); }
__host__ __device__ __forceinline__ void stage_rc(int b, int& R, int& C) { const int st = b / 1024, sb = b % 1024, swz = sb ^ (((sb >> 9) & 1) << 5); R = (st >> 1) * 16 + swz / 64; C = (st & 1) * 32 + (swz % 64) / 2; }
__host__ __device__ __forceinline__ int perm32(int rho) { const int n = rho >> 4, i = rho & 15; return 8 * (i >> 2) + 4 * n + (i & 3); }

struct Unit { int pm, pn; };
struct Gemm { const bf16_t* A; const bf16_t* Bt; int K; unsigned a_row, a_cg, a_kt, a_tile, b_row, b_kt, b_tile; };
__host__ __device__ __forceinline__ size_t blk8_off(int r, int c) { return ((size_t)((r >> 8) * 32 + (c >> 7)) << 15) + (size_t)(((r & 255) << 7) + (c & 127)); }
__host__ __device__ __forceinline__ size_t blk_off(int r, int c) { return ((size_t)((r >> 8) * 64 + (c >> 6)) << 14) + (size_t)(((r & 255) << 6) + (c & 63)); }

__host__ __device__ __forceinline__ void static_map(int L, int nM, int nN, int& pm, int& pn) {
    const int nwg = nM * nN; int wgid = L;
    { const int q = nwg / NXCD, r = nwg % NXCD, xcd = wgid % NXCD, off = wgid / NXCD; wgid = (xcd < r ? xcd * (q + 1) : r * (q + 1) + (xcd - r) * q) + off; }
    const int nig = WGM * nN, gid = wgid / nig, fm = gid * WGM, gsz = (nM - fm) < WGM ? (nM - fm) : WGM;
    pm = fm + ((wgid % nig) % gsz); pn = (wgid % nig) / gsz;
}
struct StaticOrder {
    int nM, nN, nwg, G, c;
    __host__ __device__ void init(int nM_, int nN_, int G_, int c_) { nM = nM_; nN = nN_; nwg = nM * nN; G = G_; c = c_; }
    __host__ __device__ bool next(int i, Unit& u) const { const long L = (long)i * G + c; if (L >= nwg) return false; static_map((int)L, nM, nN, u.pm, u.pn); return true; }
    __device__ __forceinline__ void a_ready(const Unit&) const {}
    __device__ __forceinline__ void done(const Unit&) const {}
};
struct OrderP7 {
    int G, c;
    __host__ __device__ bool next(int i, Unit& u) const { const long L = (long)i * G + c; if (L >= 2112) return false;
        if (L < 2048) static_map((int)L, 64, 32, u.pm, u.pn); else { const int e = (int)L - 2048; u.pm = 64 + (e & 3); u.pn = e >> 2; } return true; }
    __device__ __forceinline__ void a_ready(const Unit&) const {}
    __device__ __forceinline__ void done(const Unit&) const {}
};
template <int RT> struct OrderGrp {
    int G, c;
    __host__ __device__ bool next(int i, Unit& u) const { const int g = c + (i / RT) * G, rt = i % RT; if (g >= 256) return false; u.pm = g * 5 + rt; u.pn = g; return true; }
    __device__ __forceinline__ void a_ready(const Unit&) const {}
    __device__ __forceinline__ void done(const Unit&) const {}
};
template <int RT> struct OrderS5 {
    int G, c;
    __host__ __device__ bool next(int i, Unit& u) const { const long L = (long)i * G + c; if (L >= 256 * RT) return false; const int g = (int)L / RT, rt = (int)L % RT; u.pm = g * 5 + rt; u.pn = g; return true; }
    __device__ __forceinline__ void a_ready(const Unit&) const {}
    __device__ __forceinline__ void done(const Unit&) const {}
};

__device__ __forceinline__ unsigned cvt_pk_bf16(float lo, float hi) { unsigned r; asm("v_cvt_pk_bf16_f32 %0, %1, %2" : "=v"(r) : "v"(lo), "v"(hi)); return r; }
__device__ __forceinline__ float bflo(unsigned w) { return __uint_as_float(w << 16); }
__device__ __forceinline__ float bfhi(unsigned w) { return __uint_as_float(w & 0xffff0000u); }
__device__ __forceinline__ u32x4 pack8(const f32x4& v0, const f32x4& v1) { u32x4 w; w.x = cvt_pk_bf16(v0[0], v0[1]); w.y = cvt_pk_bf16(v0[2], v0[3]); w.z = cvt_pk_bf16(v1[0], v1[1]); w.w = cvt_pk_bf16(v1[2], v1[3]); return w; }
__device__ __forceinline__ float sigmoidf_fast(float v) { return __builtin_amdgcn_rcpf(1.f + __builtin_amdgcn_exp2f(-1.4426950408889634f * v)); }

struct EpiStore {
    static constexpr bool PERM = true, AFTER_DRAIN = false;
    bf16_t* O; int ldc; int use_pn;
    __device__ __forceinline__ void operator()(const f32x4 (&acc)[2][2][4][2], const Unit& u, int wr, int wc, int fr, int fq) const {
        const int row0 = u.pm * BM + wr * 64 + fr, col0 = (use_pn ? u.pn * BM : 0) + wc * 32 + 8 * fq;
#pragma unroll
        for (int ai = 0; ai < 2; ++ai)
#pragma unroll
            for (int m = 0; m < 4; ++m) { bf16_t* rowp = O + (size_t)(row0 + ai * HALF + m * 16) * ldc + col0;
#pragma unroll
                for (int bj = 0; bj < 2; ++bj) *(u32x4*)(rowp + bj * HALF) = pack8(acc[ai][bj][m][0], acc[ai][bj][m][1]); }
    }
};
struct EpiRope {
    static constexpr bool PERM = true, AFTER_DRAIN = false;
    bf16_t* QH; bf16_t* KH; bf16_t* VH; bf16_t* GT; const float* rope; int pn_off;
    __device__ __forceinline__ void operator()(const f32x4 (&acc)[2][2][4][2], const Unit& u, int wr, int wc, int fr, int fq) const {
        const int row0 = u.pm * BM + wr * 64 + fr, sec = (u.pn + pn_off) >> 4, h = (u.pn + pn_off) & 15, cw = wc * 32 + 8 * fq;
        const bool do_rope = (u.pm < 64) && (sec < 2);
        const int axis = wc >> 1, f0 = (wc & 1) * 16 + 4 * fq;
        bf16_t* base; size_t rstride, bjstride;
        if (sec < 2) { base = (sec == 0 ? QH : KH) + (size_t)(h * 2) * 17408 * 128; rstride = 128; bjstride = (size_t)17408 * 128; }
        else if (sec == 2) { base = VH + (size_t)h * 17408 * 256; rstride = 256; bjstride = 128; }
        else { base = GT + h * 256; rstride = 4096; bjstride = 128; }
#pragma unroll
        for (int ai = 0; ai < 2; ++ai)
#pragma unroll
            for (int m = 0; m < 4; ++m) { const int row = row0 + ai * HALF + m * 16; bf16_t* rowp = base + (size_t)row * rstride + cw;
                f32x4 c0 = {1.f, 0.f, 1.f, 0.f}, c1 = {1.f, 0.f, 1.f, 0.f};
                if (do_rope) { const int t = row & 4095, pos = axis ? (t & 63) : (t >> 6); const f32x4* tp = (const f32x4*)(rope + (pos * 32 + f0) * 2); c0 = tp[0]; c1 = tp[1]; }
#pragma unroll
                for (int bj = 0; bj < 2; ++bj) { const f32x4 a = acc[ai][bj][m][0], b = acc[ai][bj][m][1]; f32x4 v0, v1;
                    v0[0] = a[0] * c0[0] - a[1] * c0[1]; v0[1] = a[1] * c0[0] + a[0] * c0[1]; v0[2] = a[2] * c0[2] - a[3] * c0[3]; v0[3] = a[3] * c0[2] + a[2] * c0[3];
                    v1[0] = b[0] * c1[0] - b[1] * c1[1]; v1[1] = b[1] * c1[0] + b[0] * c1[1]; v1[2] = b[2] * c1[2] - b[3] * c1[3]; v1[3] = b[3] * c1[2] + b[2] * c1[3];
                    *(u32x4*)(rowp + bj * bjstride) = pack8(v0, v1); } }
    }
};
struct EpiRope8 {
    static constexpr bool PERM = true, AFTER_DRAIN = false;
    bf16_t* QH; bf16_t* KH; bf16_t* VH; bf16_t* GT; const float* rope; const float* RS; const float* CS;
    __device__ __forceinline__ void operator()(const i32x4 (&acc)[2][2][4][2], const Unit& u, int wr, int wc, int fr, int fq) const {
        const int row0 = u.pm * BM + wr * 64 + fr, sec = u.pn >> 4, h = u.pn & 15, cw = wc * 32 + 8 * fq;
        const bool do_rope = (u.pm < 64) && (sec < 2);
        const int axis = wc >> 1, f0 = (wc & 1) * 16 + 4 * fq;
        f32x4 csv[2][2];
#pragma unroll
        for (int bj = 0; bj < 2; ++bj)
#pragma unroll
            for (int n = 0; n < 2; ++n) csv[bj][n] = *(const f32x4*)(CS + u.pn * BM + bj * HALF + cw + 4 * n);
        bf16_t* base; size_t rstride, bjstride;
        if (sec < 2) { base = (sec == 0 ? QH : KH) + (size_t)(h * 2) * 17408 * 128; rstride = 128; bjstride = (size_t)17408 * 128; }
        else if (sec == 2) { base = VH + (size_t)h * 17408 * 256; rstride = 256; bjstride = 128; }
        else { base = GT + h * 256; rstride = 4096; bjstride = 128; }
        if (!do_rope) {
#pragma unroll
            for (int ai = 0; ai < 2; ++ai)
#pragma unroll
                for (int m = 0; m < 4; ++m) { const int row = row0 + ai * HALF + m * 16; bf16_t* rowp = base + (size_t)row * rstride + cw; const float rsv = RS[row];
#pragma unroll
                    for (int bj = 0; bj < 2; ++bj) *(u32x4*)(rowp + bj * bjstride) = pack8(__builtin_convertvector(acc[ai][bj][m][0], f32x4) * (csv[bj][0] * rsv), __builtin_convertvector(acc[ai][bj][m][1], f32x4) * (csv[bj][1] * rsv)); }
            return;
        }
#pragma unroll
        for (int ai = 0; ai < 2; ++ai)
#pragma unroll
            for (int m = 0; m < 4; ++m) { const int row = row0 + ai * HALF + m * 16; bf16_t* rowp = base + (size_t)row * rstride + cw; const float rsv = RS[row];
                f32x4 c0 = {1.f, 0.f, 1.f, 0.f}, c1 = {1.f, 0.f, 1.f, 0.f};
                if (do_rope) { const int t = row & 4095, pos = axis ? (t & 63) : (t >> 6); const f32x4* tp = (const f32x4*)(rope + (pos * 32 + f0) * 2); c0 = tp[0]; c1 = tp[1]; }
#pragma unroll
                for (int bj = 0; bj < 2; ++bj) { const f32x4 a = __builtin_convertvector(acc[ai][bj][m][0], f32x4) * (csv[bj][0] * rsv), b = __builtin_convertvector(acc[ai][bj][m][1], f32x4) * (csv[bj][1] * rsv); f32x4 v0, v1;
                    v0[0] = a[0] * c0[0] - a[1] * c0[1]; v0[1] = a[1] * c0[0] + a[0] * c0[1]; v0[2] = a[2] * c0[2] - a[3] * c0[3]; v0[3] = a[3] * c0[2] + a[2] * c0[3];
                    v1[0] = b[0] * c1[0] - b[1] * c1[1]; v1[1] = b[1] * c1[0] + b[0] * c1[1]; v1[2] = b[2] * c1[2] - b[3] * c1[3]; v1[3] = b[3] * c1[2] + b[2] * c1[3];
                    *(u32x4*)(rowp + bj * bjstride) = pack8(v0, v1); } }
    }
};
struct EpiS5In {
    static constexpr bool PERM = true, AFTER_DRAIN = false;
    bf16_t* XS; bf16_t* SZ;
    __device__ __forceinline__ void operator()(const f32x4 (&acc)[2][2][4][2], const Unit& u, int wr, int wc, int fr, int fq) const {
        const int row0 = u.pm * BM + wr * 64 + fr, col0 = u.pn * BM + wc * 32 + 8 * fq;
        if (u.pn < 16) {
#pragma unroll
            for (int ai = 0; ai < 2; ++ai)
#pragma unroll
                for (int m = 0; m < 4; ++m) { const int row = row0 + ai * HALF + m * 16; const int xsrow = (row < 16384) ? (row >> 4) : (1024 + ((row - 16384) >> 4)), tt = row & 15;
#pragma unroll
                    for (int bj = 0; bj < 2; ++bj) { const int col = col0 + bj * HALF, g = col >> 4, half = col & 15;
                        *(u32x4*)((char*)XS + (size_t)g * (1280u * 1024u) + (size_t)xsrow * 1024 + tt * 32 + half * 2) = pack8(acc[ai][bj][m][0], acc[ai][bj][m][1]); } }
        } else {
#pragma unroll
            for (int ai = 0; ai < 2; ++ai)
#pragma unroll
                for (int m = 0; m < 4; ++m) { bf16_t* rowp = SZ + (size_t)(row0 + ai * HALF + m * 16) * 4096 + (col0 - 4096);
#pragma unroll
                    for (int bj = 0; bj < 2; ++bj) { f32x4 a = acc[ai][bj][m][0], b = acc[ai][bj][m][1];
#pragma unroll
                        for (int e = 0; e < 4; ++e) { a[e] = a[e] * sigmoidf_fast(a[e]); b[e] = b[e] * sigmoidf_fast(b[e]); }
                        *(u32x4*)(rowp + bj * HALF) = pack8(a, b); } }
        }
    }
};
struct EpiS5Out {
    static constexpr bool PERM = true, AFTER_DRAIN = false;
    bf16_t* YG; unsigned* tokmax;
    __device__ __forceinline__ void operator()(const f32x4 (&acc)[2][2][4][2], const Unit& u, int wr, int wc, int fr, int fq) const {
        const int g = u.pn, rt = u.pm - 5 * g; const int row0 = (g * 4 + rt) * BM + wr * 64 + fr, col0 = wc * 32 + 8 * fq;
#pragma unroll
        for (int ai = 0; ai < 2; ++ai)
#pragma unroll
            for (int m = 0; m < 4; ++m) { bf16_t* rowp = YG + (size_t)(row0 + ai * HALF + m * 16) * 256 + col0;
#pragma unroll
                for (int bj = 0; bj < 2; ++bj) { f32x4 a = acc[ai][bj][m][0], b = acc[ai][bj][m][1];
#pragma unroll
                    for (int e = 0; e < 4; ++e) { const float za = 1.5957691216057308f * (a[e] + 0.044715f * a[e] * a[e] * a[e]); a[e] = a[e] * sigmoidf_fast(za);
                                                  const float zb = 1.5957691216057308f * (b[e] + 0.044715f * b[e] * b[e] * b[e]); b[e] = b[e] * sigmoidf_fast(zb); }
                    *(u32x4*)(rowp + bj * HALF) = pack8(a, b);
                    float mx = fmaxf(fmaxf(fmaxf(__builtin_fabsf(a[0]), __builtin_fabsf(a[1])), fmaxf(__builtin_fabsf(a[2]), __builtin_fabsf(a[3]))), fmaxf(fmaxf(__builtin_fabsf(b[0]), __builtin_fabsf(b[1])), fmaxf(__builtin_fabsf(b[2]), __builtin_fabsf(b[3]))));
                    mx = fmaxf(mx, __shfl_xor(mx, 16));
                    if ((fq & 1) == 0) (void)__hip_atomic_fetch_max(tokmax + ((rt * BM + wr * 64 + fr + ai * HALF + m * 16) * 16 + wc * 2 + (fq >> 1) + bj * 8), __float_as_uint(mx), __ATOMIC_RELAXED, __HIP_MEMORY_SCOPE_AGENT); } }
    }
};
struct EpiGlu {
    static constexpr bool PERM = true, AFTER_DRAIN = false;
    const bf16_t* YG; const bf16_t* SZ; bf16_t* Y2;
    __device__ __forceinline__ void operator()(const f32x4 (&acc)[2][2][4][2], const Unit& u, int wr, int wc, int fr, int fq) const {
        const int row0 = u.pm * BM + wr * 64 + fr, col0 = u.pn * BM + wc * 32 + 8 * fq;
#pragma unroll
        for (int ai = 0; ai < 2; ++ai)
#pragma unroll
            for (int m = 0; m < 4; ++m) { const int row = row0 + ai * HALF + m * 16;
#pragma unroll
                for (int bj = 0; bj < 2; ++bj) { const int col = col0 + bj * HALF;
                    const u32x4 yv = *(const u32x4*)((const char*)YG + (size_t)(col >> 4) * (16384u * 32u) + (size_t)row * 32 + (col & 15) * 2);
                    const u32x4 sv = *(const u32x4*)(SZ + (size_t)row * 4096 + col);
                    const f32x4 a = acc[ai][bj][m][0], b = acc[ai][bj][m][1]; f32x4 v0, v1;
                    v0[0] = bflo(yv.x) * bflo(sv.x) * sigmoidf_fast(a[0]); v0[1] = bfhi(yv.x) * bfhi(sv.x) * sigmoidf_fast(a[1]);
                    v0[2] = bflo(yv.y) * bflo(sv.y) * sigmoidf_fast(a[2]); v0[3] = bfhi(yv.y) * bfhi(sv.y) * sigmoidf_fast(a[3]);
                    v1[0] = bflo(yv.z) * bflo(sv.z) * sigmoidf_fast(b[0]); v1[1] = bfhi(yv.z) * bfhi(sv.z) * sigmoidf_fast(b[1]);
                    v1[2] = bflo(yv.w) * bflo(sv.w) * sigmoidf_fast(b[2]); v1[3] = bfhi(yv.w) * bfhi(sv.w) * sigmoidf_fast(b[3]);
                    *(u32x4*)(Y2 + blk_off(row, col)) = pack8(v0, v1); } }
    }
};
struct EpiGlu8 {
    static constexpr bool PERM = true, AFTER_DRAIN = false;
    const bf16_t* YG; const bf16_t* SZ; bf16_t* Y2; const float* RS; const float* CS;
    __device__ __forceinline__ void operator()(const i32x4 (&acc)[2][2][4][2], const Unit& u, int wr, int wc, int fr, int fq) const {
        const int row0 = u.pm * BM + wr * 64 + fr, col0 = u.pn * BM + wc * 32 + 8 * fq;
        f32x4 csv[2][2];
#pragma unroll
        for (int bj = 0; bj < 2; ++bj)
#pragma unroll
            for (int n = 0; n < 2; ++n) csv[bj][n] = *(const f32x4*)(CS + col0 + bj * HALF + 4 * n);
#pragma unroll
        for (int am = 0; am < 4; ++am) { const int ai = am >> 1, mb = (am & 1) * 2;
            u32x4 yv[2][2], sv[2][2]; float rsv[2];
#pragma unroll
            for (int m = 0; m < 2; ++m) { const int row = row0 + ai * HALF + (mb + m) * 16; rsv[m] = RS[row];
#pragma unroll
                for (int bj = 0; bj < 2; ++bj) { const int col = col0 + bj * HALF;
                    yv[m][bj] = *(const u32x4*)((const char*)YG + (size_t)(col >> 4) * (16384u * 32u) + (size_t)row * 32 + (col & 15) * 2);
                    sv[m][bj] = *(const u32x4*)(SZ + (size_t)row * 4096 + col); } }
#pragma unroll
            for (int m = 0; m < 2; ++m) { const int row = row0 + ai * HALF + (mb + m) * 16;
#pragma unroll
                for (int bj = 0; bj < 2; ++bj) { const int col = col0 + bj * HALF; const u32x4 y = yv[m][bj], z = sv[m][bj];
                    const f32x4 a = __builtin_convertvector(acc[ai][bj][mb + m][0], f32x4) * (csv[bj][0] * rsv[m]), b = __builtin_convertvector(acc[ai][bj][mb + m][1], f32x4) * (csv[bj][1] * rsv[m]); f32x4 v0, v1;
                    v0[0] = bflo(y.x) * bflo(z.x) * sigmoidf_fast(a[0]); v0[1] = bfhi(y.x) * bfhi(z.x) * sigmoidf_fast(a[1]);
                    v0[2] = bflo(y.y) * bflo(z.y) * sigmoidf_fast(a[2]); v0[3] = bfhi(y.y) * bfhi(z.y) * sigmoidf_fast(a[3]);
                    v1[0] = bflo(y.z) * bflo(z.z) * sigmoidf_fast(b[0]); v1[1] = bfhi(y.z) * bfhi(z.z) * sigmoidf_fast(b[1]);
                    v1[2] = bflo(y.w) * bflo(z.w) * sigmoidf_fast(b[2]); v1[3] = bfhi(y.w) * bfhi(z.w) * sigmoidf_fast(b[3]);
                    *(u32x4*)(Y2 + blk_off(row, col)) = pack8(v0, v1); } }
        }
    }
};

template <class Epi, class Sched, bool ALIGN_EPI = false, bool SP2 = false, bool I8 = false>
__device__ __forceinline__ void gemm_phase(PG8_LAS unsigned char* lds, const Gemm g, const Sched& S, const Epi& E) {
    const int tid = threadIdx.x, wid = __builtin_amdgcn_readfirstlane(tid >> 6), lane = tid & 63, wr = wid >> 2, wc = wid & 3, fr = lane & 15, fq = lane >> 4;
    const int K = g.K, nt = K / BK;
    unsigned voffA[2], voffB[2];
#pragma unroll
    for (int i = 0; i < 2; ++i) { int R, C; stage_rc(tid * 16 + i * 8192, R, C); const int Rb = Epi::PERM ? ((R & ~31) + perm32(R & 31)) : R;
        voffA[i] = (unsigned)R * g.a_row + (unsigned)(C >> 4) * g.a_cg + (unsigned)(C & 15) * 2u; voffB[i] = (unsigned)Rb * g.b_row + (unsigned)C * 2u; }
    const size_t kstepA = (size_t)g.a_kt, kstepB = (size_t)g.b_kt;
    const size_t hstepA = (size_t)HALF * g.a_row, hstepB = (size_t)HALF * g.b_row;
    const size_t tstepA = (size_t)g.a_tile, tstepB = (size_t)g.b_tile;
    const unsigned ldsw = (unsigned)wid * 1024u;
    const int aoff = lds_byte(wr * 64 + fr, fq * 8), boff = lds_byte(wc * 32 + fr, fq * 8);
#define PG8_SA(b, h) (((b) * 2 + (h)) * HTB)
#define PG8_SB(b, h) ((4 + (b) * 2 + (h)) * HTB)
#define PG8_STAGE(bufoff, gbase, voff) do { _Pragma("unroll") for (int _i = 0; _i < 2; ++_i) \
        __builtin_amdgcn_global_load_lds((const unsigned*)((const char*)(gbase) + (voff)[_i]), (PG8_LAS unsigned*)(lds + (bufoff) + ldsw + _i * 8192), 16, 0, 0); } while (0)
#define PG8_LDA(dst, b, h) do { _Pragma("unroll") for (int m = 0; m < 4; ++m) _Pragma("unroll") for (int k = 0; k < 2; ++k) dst[m][k] = *(const PG8_LAS bf16x8*)(lds + PG8_SA(b, h) + aoff + m * 2048 + k * 1024); } while (0)
#define PG8_LDB(dst, b, h) do { _Pragma("unroll") for (int n = 0; n < 2; ++n) _Pragma("unroll") for (int k = 0; k < 2; ++k) dst[n][k] = *(const PG8_LAS bf16x8*)(lds + PG8_SB(b, h) + boff + n * 2048 + k * 1024); } while (0)
#define PG8_MMA(ai, bj, At, Bt) do { __builtin_amdgcn_s_setprio(1); _Pragma("unroll") for (int m = 0; m < 4; ++m) _Pragma("unroll") for (int n = 0; n < 2; ++n) _Pragma("unroll") for (int k = 0; k < 2; ++k) \
        { if constexpr (I8) acc[ai][bj][m][n] = __builtin_amdgcn_mfma_i32_16x16x64_i8(__builtin_bit_cast(i32x4, Bt[n][k]), __builtin_bit_cast(i32x4, At[m][k]), acc[ai][bj][m][n], 0, 0, 0); \
          else acc[ai][bj][m][n] = __builtin_amdgcn_mfma_f32_16x16x32_bf16(Bt[n][k], At[m][k], acc[ai][bj][m][n], 0, 0, 0); } __builtin_amdgcn_s_setprio(0); } while (0)
#define PG8_WAIT_V(n) asm volatile("s_waitcnt vmcnt(" #n ")" ::: "memory")
#define PG8_WAIT_L(n) asm volatile("s_waitcnt lgkmcnt(" #n ")" ::: "memory")
#define PG8_BAR __builtin_amdgcn_s_barrier()
#define PG8_SCHED __builtin_amdgcn_sched_barrier(0)
    Unit cur, nxt; int ui = 0;
    if (!S.next(0, cur)) return;
    typedef typename std::conditional<I8, i32x4, f32x4>::type acc_t;
    acc_t acc[2][2][4][2];
#pragma unroll
    for (int a = 0; a < 2; ++a)
#pragma unroll
        for (int b = 0; b < 2; ++b)
#pragma unroll
            for (int m = 0; m < 4; ++m)
#pragma unroll
                for (int n = 0; n < 2; ++n) acc[a][b][m][n] = acc_t{};
    bf16x8 At[4][2], B0[2][2], B1[2][2];
    const char* cA = (const char*)g.A + (size_t)cur.pm * tstepA; const char* cB = (const char*)g.Bt + (size_t)cur.pn * tstepB;
    S.a_ready(cur);
    if constexpr (SP2) {
        PG8_STAGE(PG8_SB(0, 0), cB, voffB); PG8_STAGE(PG8_SB(0, 1), cB + hstepB, voffB); PG8_STAGE(PG8_SA(0, 0), cA, voffA); PG8_STAGE(PG8_SA(0, 1), cA + hstepA, voffA);
        if (wr == 1) PG8_BAR;
        PG8_WAIT_V(2); PG8_BAR;
        PG8_STAGE(PG8_SB(1, 0), cB + kstepB, voffB); PG8_STAGE(PG8_SA(1, 0), cA + kstepA, voffA); PG8_STAGE(PG8_SB(1, 1), cB + hstepB + kstepB, voffB);
        PG8_WAIT_V(6); PG8_BAR;
    } else {
        PG8_STAGE(PG8_SB(0, 0), cB, voffB); PG8_STAGE(PG8_SA(0, 0), cA, voffA); PG8_STAGE(PG8_SB(0, 1), cB + hstepB, voffB); PG8_STAGE(PG8_SA(0, 1), cA + hstepA, voffA);
        if (wr == 1) PG8_BAR;
        PG8_WAIT_V(4); PG8_BAR;
        PG8_STAGE(PG8_SB(1, 0), cB + kstepB, voffB); PG8_STAGE(PG8_SA(1, 0), cA + kstepA, voffA); PG8_STAGE(PG8_SB(1, 1), cB + hstepB + kstepB, voffB);
        PG8_WAIT_V(6); PG8_BAR;
    }
    for (;;) {
        const bool has_next = S.next(ui + 1, nxt);
        const char* nA = has_next ? (const char*)g.A + (size_t)nxt.pm * tstepA : cA; const char* nB = has_next ? (const char*)g.Bt + (size_t)nxt.pn * tstepB : cB;
#pragma unroll 1
        for (int t = 0; t < nt; t += 2) {
            const bool last = (t == nt - 2);
            const char* a1 = cA + (size_t)(t + 1) * kstepA;
            const char* a2 = last ? nA : cA + (size_t)(t + 2) * kstepA; const char* b2 = last ? nB : cB + (size_t)(t + 2) * kstepB;
            const char* a3 = a2 + kstepA; const char* b3 = b2 + kstepB;
            if (last && has_next) S.a_ready(nxt);
            if constexpr (SP2) {
            PG8_LDB(B0, 0, 0); PG8_LDB(B1, 0, 1); PG8_SCHED; PG8_LDA(At, 0, 0); PG8_STAGE(PG8_SA(1, 1), a1 + hstepA, voffA);
            PG8_WAIT_V(8); PG8_WAIT_L(0); PG8_BAR; PG8_MMA(0, 0, At, B0); PG8_MMA(0, 1, At, B1); PG8_BAR; PG8_SCHED;
            PG8_LDA(At, 0, 1); PG8_STAGE(PG8_SB(0, 0), b2, voffB); PG8_STAGE(PG8_SB(0, 1), b2 + hstepB, voffB); PG8_STAGE(PG8_SA(0, 0), a2, voffA);
            PG8_WAIT_V(8); PG8_WAIT_L(0); PG8_BAR; PG8_MMA(1, 0, At, B0); PG8_MMA(1, 1, At, B1); PG8_BAR; PG8_SCHED;
            PG8_LDB(B0, 1, 0); PG8_LDB(B1, 1, 1); PG8_SCHED; PG8_LDA(At, 1, 0); PG8_STAGE(PG8_SA(0, 1), a2 + hstepA, voffA);
            PG8_WAIT_V(8); PG8_WAIT_L(0); PG8_BAR; PG8_MMA(0, 0, At, B0); PG8_MMA(0, 1, At, B1); PG8_BAR; PG8_SCHED;
            PG8_LDA(At, 1, 1); PG8_STAGE(PG8_SB(1, 0), b3, voffB); PG8_STAGE(PG8_SB(1, 1), b3 + hstepB, voffB); PG8_STAGE(PG8_SA(1, 0), a3, voffA);
            PG8_WAIT_V(8); PG8_WAIT_L(0); PG8_BAR; PG8_MMA(1, 0, At, B0); PG8_MMA(1, 1, At, B1); PG8_BAR; PG8_SCHED;
            } else {
            PG8_LDB(B0, 0, 0); PG8_SCHED; PG8_LDA(At, 0, 0); PG8_STAGE(PG8_SA(1, 1), a1 + hstepA, voffA);
            PG8_WAIT_L(8); PG8_BAR; PG8_WAIT_L(0); PG8_MMA(0, 0, At, B0); PG8_BAR; PG8_SCHED;
            PG8_LDB(B1, 0, 1); PG8_STAGE(PG8_SB(0, 0), b2, voffB);
            PG8_BAR; PG8_WAIT_L(0); PG8_MMA(0, 1, At, B1); PG8_BAR;
            PG8_LDA(At, 0, 1); PG8_STAGE(PG8_SA(0, 0), a2, voffA);
            PG8_BAR; PG8_WAIT_L(0); PG8_MMA(1, 0, At, B0); PG8_BAR; PG8_SCHED;
            PG8_STAGE(PG8_SB(0, 1), b2 + hstepB, voffB);
            PG8_WAIT_V(6); PG8_BAR; PG8_MMA(1, 1, At, B1); PG8_BAR;
            PG8_LDB(B0, 1, 0); PG8_SCHED; PG8_LDA(At, 1, 0); PG8_STAGE(PG8_SA(0, 1), a2 + hstepA, voffA);
            PG8_WAIT_L(8); PG8_BAR; PG8_WAIT_L(0); PG8_MMA(0, 0, At, B0); PG8_BAR; PG8_SCHED;
            PG8_LDB(B1, 1, 1); PG8_STAGE(PG8_SB(1, 0), b3, voffB);
            PG8_BAR; PG8_WAIT_L(0); PG8_MMA(0, 1, At, B1); PG8_BAR;
            PG8_LDA(At, 1, 1); PG8_STAGE(PG8_SA(1, 0), a3, voffA);
            PG8_BAR; PG8_WAIT_L(0); PG8_MMA(1, 0, At, B0); PG8_BAR; PG8_SCHED;
            PG8_STAGE(PG8_SB(1, 1), b3 + hstepB, voffB);
            PG8_WAIT_V(6); PG8_BAR; PG8_MMA(1, 1, At, B1); PG8_BAR;
            }
        }
        if constexpr (ALIGN_EPI) { if (wr == 0) PG8_BAR; }
        asm volatile("s_nop 15\n\ts_nop 7" ::: "memory");
        if constexpr (!Epi::AFTER_DRAIN) { E(acc, cur, wr, wc, fr, fq); S.done(cur); }
        if (!has_next) break;
#pragma unroll
        for (int a = 0; a < 2; ++a)
#pragma unroll
            for (int b = 0; b < 2; ++b)
#pragma unroll
                for (int m = 0; m < 4; ++m)
#pragma unroll
                    for (int n = 0; n < 2; ++n) acc[a][b][m][n] = acc_t{};
        cur = nxt; cA = nA; cB = nB; ++ui;
        if constexpr (ALIGN_EPI) { if (wr == 1) PG8_BAR; }
    }
    PG8_WAIT_V(0);
    if constexpr (!ALIGN_EPI) { if (wr == 0) PG8_BAR; }
    PG8_BAR;
#undef PG8_SA
#undef PG8_SB
#undef PG8_STAGE
#undef PG8_LDA
#undef PG8_LDB
#undef PG8_MMA
#undef PG8_WAIT_V
#undef PG8_WAIT_L
#undef PG8_BAR
#undef PG8_SCHED
}
}
#define PG8_SP2 true
#define PG8_ALIGN true

namespace att {
typedef unsigned short bf16;
constexpr int D = 128, NW = 8, QBLK = 32, KVBLK = 64, CTXN = 256;
constexpr float SCALE = 0.088388347648318440f;
constexpr float THR = 8.f;
constexpr int SDEPTH = 2;
constexpr long LDQ = 128, LDK = 128, LDV = 256, LDO = 8192;
constexpr size_t SHM_V = KVBLK * D * 2, SHM_K = KVBLK * D * 2, SHM_ATTN = 2 * SHM_V + 2 * SHM_K + NW * 64 * 4;
using bf16x8 = __attribute__((ext_vector_type(8))) short;
using s16x4  = __attribute__((ext_vector_type(4))) short;
using f32x16 = __attribute__((ext_vector_type(16))) float;
using u32x4  = __attribute__((ext_vector_type(4))) unsigned;
#define KSWZ(row, colB) ((row) * 256 + ((colB) ^ (((row) & 7) << 4)))
#define SBAR() __builtin_amdgcn_sched_barrier(0)
__device__ __forceinline__ int crow(int r, int hi) { return (r & 3) + 8 * (r >> 2) + 4 * hi; }
__device__ __forceinline__ unsigned cvtpk(float lo, float hi) { unsigned r; asm volatile("v_cvt_pk_bf16_f32 %0, %1, %2" : "=v"(r) : "v"(lo), "v"(hi)); return r; }

__device__ __forceinline__ void partialSM(f32x16& p0, f32x16& p1, float& m_reg, float& mn, float& alpha) {
  constexpr float C = SCALE * 1.4426950408889634f;
  float pmax = p0[0]; for (int r = 1; r < 16; ++r) pmax = fmaxf(pmax, p0[r]); for (int r = 0; r < 16; ++r) pmax = fmaxf(pmax, p1[r]);
  { auto rr = __builtin_amdgcn_permlane32_swap(__float_as_uint(pmax), __float_as_uint(pmax), false, false);
    pmax = fmaxf(__uint_as_float(rr[0]), __uint_as_float(rr[1])); }
  if (__builtin_expect(__all(pmax - m_reg <= THR / SCALE), 1)) { mn = m_reg; alpha = 1.f; }
  else { mn = fmaxf(m_reg, pmax); alpha = __builtin_amdgcn_exp2f((m_reg - mn) * C); m_reg = mn; }
  float mnC = -mn * C;
  for (int r = 0; r < 16; ++r) p0[r] = fmaf(p0[r], C, mnC); for (int r = 0; r < 16; ++r) p1[r] = fmaf(p1[r], C, mnC);
  for (int r = 0; r < 16; ++r) p0[r] = __builtin_amdgcn_exp2f(p0[r]);
}
__device__ __forceinline__ void finishSM(f32x16& p0, f32x16& p1, float alpha, float& l_reg, bf16x8& pa0, bf16x8& pa1, bf16x8& pa2, bf16x8& pa3) {
  for (int r = 0; r < 16; ++r) p1[r] = __builtin_amdgcn_exp2f(p1[r]);
  float ps = 0; for (int r = 0; r < 16; ++r) ps += p0[r]; for (int r = 0; r < 16; ++r) ps += p1[r];
  { auto rr = __builtin_amdgcn_permlane32_swap(__float_as_uint(ps), __float_as_uint(ps), false, false);
    ps = __uint_as_float(rr[0]) + __uint_as_float(rr[1]); }
  l_reg = l_reg * alpha + ps;
#define PK4(P, BASE, OUT) do { unsigned a0 = cvtpk(P[BASE + 0], P[BASE + 1]), a1 = cvtpk(P[BASE + 2], P[BASE + 3]);   \
    unsigned b0 = cvtpk(P[BASE + 4], P[BASE + 5]), b1 = cvtpk(P[BASE + 6], P[BASE + 7]);                              \
    auto r0 = __builtin_amdgcn_permlane32_swap(a0, b0, false, false); auto r1 = __builtin_amdgcn_permlane32_swap(a1, b1, false, false); \
    u32x4 w = {r0[0], r1[0], r0[1], r1[1]}; OUT = *reinterpret_cast<bf16x8*>(&w); } while (0)
  PK4(p0, 0, pa0); PK4(p0, 8, pa1); PK4(p1, 0, pa2); PK4(p1, 8, pa3);
#undef PK4
}
__device__ __forceinline__ void qkt(f32x16& p0, f32x16& p1, const bf16* Ks, const bf16x8* qr, int r32, int hi) {
  p0 = f32x16{}; p1 = f32x16{};
  for (int d0 = 0; d0 < 8; ++d0) { int cb = (d0 * 16 + hi * 8) * 2;
    bf16x8 b0 = *reinterpret_cast<const bf16x8*>((const char*)Ks + KSWZ(r32, cb));
    bf16x8 b1 = *reinterpret_cast<const bf16x8*>((const char*)Ks + KSWZ(32 + r32, cb));
    p0 = __builtin_amdgcn_mfma_f32_32x32x16_bf16(b0, qr[d0], p0, 0, 0, 0);
    p1 = __builtin_amdgcn_mfma_f32_32x32x16_bf16(b1, qr[d0], p1, 0, 0, 0); }
}
__device__ __forceinline__ int v_st(int k, int c) { const int kk = (k & ~0xC) | ((k & 4) << 1) | ((k & 8) >> 1); return ((kk >> 3) * 4 + (c >> 5)) * 512 + ((kk & 7) * 32 + (c & 31)) * 2; }
__device__ __forceinline__ int v_rd_base(int lane) { return ((lane & 3) << 3) | (((lane >> 2) & 3) << 6) | (((lane >> 4) & 1) << 5) | (((lane >> 5) & 1) << 8); }
constexpr int v_rd_off(int d0, int ks, int half) { return d0 * 512 + ks * 4096 + half * 2048; }
template <int OFF> __device__ __forceinline__ s16x4 tr_read(int vb) {
  s16x4 r; asm volatile("ds_read_b64_tr_b16 %0, %1 offset:%2" : "=&v"(r) : "v"(vb), "i"(OFF) : "memory"); return r;
}
template <int D0> __device__ __forceinline__ void pv_one(f32x16& od, int vb, bf16x8 pa0, bf16x8 pa1, bf16x8 pa2, bf16x8 pa3) {
  const s16x4 l0 = tr_read<v_rd_off(D0, 0, 0)>(vb), h0 = tr_read<v_rd_off(D0, 0, 1)>(vb), l1 = tr_read<v_rd_off(D0, 1, 0)>(vb), h1 = tr_read<v_rd_off(D0, 1, 1)>(vb);
  const s16x4 l2 = tr_read<v_rd_off(D0, 2, 0)>(vb), h2 = tr_read<v_rd_off(D0, 2, 1)>(vb), l3 = tr_read<v_rd_off(D0, 3, 0)>(vb), h3 = tr_read<v_rd_off(D0, 3, 1)>(vb);
  asm volatile("s_waitcnt lgkmcnt(0)" ::: "memory"); SBAR();
#define PK(L, H) (bf16x8){L[0], L[1], L[2], L[3], H[0], H[1], H[2], H[3]}
  od = __builtin_amdgcn_mfma_f32_32x32x16_bf16(pa0, PK(l0, h0), od, 0, 0, 0);
  od = __builtin_amdgcn_mfma_f32_32x32x16_bf16(pa1, PK(l1, h1), od, 0, 0, 0);
  od = __builtin_amdgcn_mfma_f32_32x32x16_bf16(pa2, PK(l2, h2), od, 0, 0, 0);
  od = __builtin_amdgcn_mfma_f32_32x32x16_bf16(pa3, PK(l3, h3), od, 0, 0, 0);
#undef PK
}
__device__ __forceinline__ void pv_d0(f32x16* o, int vb, bf16x8 pa0, bf16x8 pa1, bf16x8 pa2, bf16x8 pa3) {
  pv_one<0>(o[0], vb, pa0, pa1, pa2, pa3); pv_one<1>(o[1], vb, pa0, pa1, pa2, pa3); pv_one<2>(o[2], vb, pa0, pa1, pa2, pa3); pv_one<3>(o[3], vb, pa0, pa1, pa2, pa3);
}
__device__ __forceinline__ void attn_dense_body(const bf16* __restrict__ Qb, const bf16* __restrict__ Kc, const bf16* __restrict__ Kl, const bf16* __restrict__ Vc, const bf16* __restrict__ Vl,
                                                bf16* __restrict__ Ob, int seq, char* lds) {
  const int tid = threadIdx.x, wid = tid >> 6, lane = tid & 63, r32 = lane & 31, hi = lane >> 5;
  bf16* V_lds = (bf16*)lds; bf16* K_lds = (bf16*)(lds + 2 * SHM_V);
  float* ws = (float*)(lds + 2 * SHM_V + 2 * SHM_K) + wid * 64; float* li_l = ws; float* al_l = ws + 32;
  float m_reg = -1e30f, l_reg = 0; f32x16 o[4] = {}; bf16x8 qr[8];
  const bf16* Qw = Qb + (long)(wid * QBLK + r32) * LDQ + hi * 8;
#pragma unroll
  for (int d0 = 0; d0 < 8; ++d0) qr[d0] = *reinterpret_cast<const bf16x8*>(Qw + d0 * 16);
  const int sr = tid >> 4, sc = (tid & 15) * 8, vst0 = v_st(sr, sc), vst1 = v_st(32 + sr, sc);
  const int vb0 = (int)(uintptr_t)V_lds + v_rd_base(lane);
  struct { bf16x8 vs0, vs1, ks0, ks1; } sr_[SDEPTH];
#define SLOAD(i, k0) do { const bf16* kb_ = ((k0) < CTXN) ? Kc + (long)(k0) * LDK : Kl + (long)((k0) - CTXN) * LDK; const bf16* vb_ = ((k0) < CTXN) ? Vc + (long)(k0) * LDV : Vl + (long)((k0) - CTXN) * LDV; \
    sr_[i].vs0 = *reinterpret_cast<const bf16x8*>(&vb_[(long)sr * LDV + sc]); sr_[i].vs1 = *reinterpret_cast<const bf16x8*>(&vb_[(long)(32 + sr) * LDV + sc]); \
    sr_[i].ks0 = *reinterpret_cast<const bf16x8*>(&kb_[(long)sr * LDK + sc]); sr_[i].ks1 = *reinterpret_cast<const bf16x8*>(&kb_[(long)(32 + sr) * LDK + sc]); } while (0)
#define SWRITE(b, i) do { *(bf16x8*)((char*)V_lds + (b) * SHM_V + vst0) = sr_[i].vs0;          \
    *(bf16x8*)((char*)V_lds + (b) * SHM_V + vst1) = sr_[i].vs1; int kc = sc * 2;               \
    *(bf16x8*)((char*)K_lds + (b) * SHM_K + KSWZ(sr, kc)) = sr_[i].ks0;                       \
    *(bf16x8*)((char*)K_lds + (b) * SHM_K + KSWZ(32 + sr, kc)) = sr_[i].ks1; } while (0)
#define SWAIT() do { if constexpr (SDEPTH == 2) asm volatile("s_waitcnt vmcnt(4)" ::: "memory"); else asm volatile("s_waitcnt vmcnt(0)" ::: "memory"); } while (0)
#define RESC(a) do { if (__any((a) < 1.f)) { if (hi == 0) al_l[r32] = (a); asm volatile("s_waitcnt lgkmcnt(0)" ::: "memory"); \
    for (int d = 0; d < 4; ++d) for (int r = 0; r < 16; ++r) o[d][r] *= al_l[crow(r, hi)]; } } while (0)
  f32x16 pA0, pA1, pB0, pB1; float mnA, mnB, alA, alB; bf16x8 pa0, pa1, pa2, pa3; const int NT = seq / KVBLK;
  constexpr int SE = 0, SO = SDEPTH - 1;
  SLOAD(SE, 0); asm volatile("s_waitcnt vmcnt(0)" ::: "memory"); SWRITE(0, SE); __syncthreads();
  qkt(pA0, pA1, K_lds, qr, r32, hi); partialSM(pA0, pA1, m_reg, mnA, alA);
  SLOAD(SO, KVBLK); if constexpr (SDEPTH == 2) { if (2 < NT) SLOAD(SE, 2 * KVBLK); }
  SWAIT(); SWRITE(1, SO); __syncthreads();
  for (int j = 1; j + 1 < NT; j += 2) {
    SBAR(); qkt(pB0, pB1, (bf16*)((char*)K_lds + SHM_K), qr, r32, hi);
    finishSM(pA0, pA1, alA, l_reg, pa0, pa1, pa2, pa3); SBAR();
    SLOAD(SO, (j + SDEPTH) * KVBLK); SBAR();
    pv_d0(o, vb0, pa0, pa1, pa2, pa3); partialSM(pB0, pB1, m_reg, mnB, alB);
    __syncthreads(); SWAIT(); SWRITE(0, SE);
    RESC(alB); __syncthreads();
    SBAR(); qkt(pA0, pA1, K_lds, qr, r32, hi);
    finishSM(pB0, pB1, alB, l_reg, pa0, pa1, pa2, pa3); SBAR();
    if (SDEPTH == 1 || j + 3 < NT) SLOAD(SE, (j + 1 + SDEPTH) * KVBLK); SBAR();
    pv_d0(o, vb0 + (int)SHM_V, pa0, pa1, pa2, pa3); partialSM(pA0, pA1, m_reg, mnA, alA);
    __syncthreads(); SWAIT(); SWRITE(1, SO);
    RESC(alA); __syncthreads();
  }
  SBAR(); qkt(pB0, pB1, (bf16*)((char*)K_lds + SHM_K), qr, r32, hi);
  finishSM(pA0, pA1, alA, l_reg, pa0, pa1, pa2, pa3); SBAR();
  pv_d0(o, vb0, pa0, pa1, pa2, pa3); partialSM(pB0, pB1, m_reg, mnB, alB);
  __syncthreads(); RESC(alB);
  finishSM(pB0, pB1, alB, l_reg, pa0, pa1, pa2, pa3); SBAR();
  pv_d0(o, vb0 + (int)SHM_V, pa0, pa1, pa2, pa3);
  if (hi == 0) li_l[r32] = l_reg; asm volatile("s_waitcnt lgkmcnt(0)" ::: "memory");
  float rli[16];
#pragma unroll
  for (int r = 0; r < 16; ++r) rli[r] = __builtin_amdgcn_rcpf(li_l[crow(r, hi)]);
  bf16* Ow = Ob + (long)(wid * QBLK) * LDO;
#pragma unroll
  for (int r = 0; r < 16; ++r) { int orow = crow(r, hi);
    for (int d0 = 0; d0 < 4; ++d0) { const unsigned w = cvtpk(o[d0][r] * rli[r], 0.f); Ow[(long)orow * LDO + d0 * 32 + r32] = (bf16)(w & 0xffffu); } }
#undef SLOAD
#undef SWRITE
#undef SWAIT
#undef RESC
}
}


namespace att2 {
typedef unsigned short bf16;
using bf16x8 = __attribute__((ext_vector_type(8))) short;
using s16x4  = __attribute__((ext_vector_type(4))) short;
using f32x16 = __attribute__((ext_vector_type(16))) float;
using u32x4  = __attribute__((ext_vector_type(4))) unsigned;
typedef short v4i16_t __attribute__((ext_vector_type(4)));
typedef __attribute__((address_space(3))) const char* lds_cptr;
constexpr int KBUF = 16384, VBUF = 32768, LDS_K = 0, LDS_V = 2 * KBUF, RING = LDS_V + 3 * VBUF;
constexpr int CTXN = 256, LDO = 8192;
constexpr float SCALE = 0.088388347648318440f, THR = 8.f, C = SCALE * 1.4426950408889634f;
#define A2_WAIT_BAR(N) asm volatile("s_waitcnt vmcnt(" #N ") lgkmcnt(0)\n\ts_barrier" ::: "memory")
__device__ __forceinline__ void glds16(const void* gsrc, unsigned lds_dst) { unsigned keep;
  asm volatile("s_mov_b32 %0, m0\n\ts_mov_b32 m0, %2\n\ts_nop 0\n\tglobal_load_lds_dwordx4 %1, off\n\ts_mov_b32 m0, %0" : "=&s"(keep) : "v"(gsrc), "s"(lds_dst) : "memory"); }
__device__ __forceinline__ int crow(int r, int hi) { return (r & 3) + 8 * (r >> 2) + 4 * hi; }
__device__ __forceinline__ unsigned cvtpk(float lo, float hi) { unsigned r; asm volatile("v_cvt_pk_bf16_f32 %0, %1, %2" : "=v"(r) : "v"(lo), "v"(hi)); return r; }
__device__ __forceinline__ s16x4 vtr(lds_cptr p) { return __builtin_bit_cast(s16x4, __builtin_amdgcn_ds_read_tr16_b64_v4i16((__attribute__((address_space(3))) v4i16_t*)p)); }
__device__ __forceinline__ int v_rd_base(int lane) { return ((lane & 3) << 3) | (((lane >> 2) & 3) << 6) | (((lane >> 4) & 1) << 5) | (((lane >> 5) & 1) << 8); }

__device__ __forceinline__ void qkt(f32x16& p, lds_cptr kb, const bf16x8* qr, int krow, int hi) {
  p = f32x16{};
#pragma unroll
  for (int d0 = 0; d0 < 8; ++d0) { const int cb = d0 * 32 + hi * 16;
    const bf16x8 kf = *(const __attribute__((address_space(3))) bf16x8*)(kb + krow * 256 + (cb ^ ((krow & 7) << 4)));
    p = __builtin_amdgcn_mfma_f32_32x32x16_bf16(kf, qr[d0], p, 0, 0, 0); }
}
__device__ __forceinline__ void pv(f32x16* o, lds_cptr vp, bf16x8 pa0, bf16x8 pa1) {
#define A2_PK(L, H) (bf16x8){L[0], L[1], L[2], L[3], H[0], H[1], H[2], H[3]}
#pragma unroll
  for (int d0 = 0; d0 < 8; ++d0) {
    const s16x4 l0 = vtr(vp + d0 * 512), h0 = vtr(vp + d0 * 512 + 4096), l1 = vtr(vp + d0 * 512 + 8192), h1 = vtr(vp + d0 * 512 + 8192 + 4096);
    o[d0] = __builtin_amdgcn_mfma_f32_32x32x16_bf16(pa0, A2_PK(l0, h0), o[d0], 0, 0, 0);
    o[d0] = __builtin_amdgcn_mfma_f32_32x32x16_bf16(pa1, A2_PK(l1, h1), o[d0], 0, 0, 0); }
#undef A2_PK
}
__device__ __forceinline__ void softmax_step(f32x16& p, float& m_reg, float& l_reg, float& alpha, bf16x8& pa0, bf16x8& pa1) {
  float pmax = p[0];
#pragma unroll
  for (int r = 1; r < 16; ++r) pmax = fmaxf(pmax, p[r]);
  { auto rr = __builtin_amdgcn_permlane32_swap(__float_as_uint(pmax), __float_as_uint(pmax), false, false); pmax = fmaxf(__uint_as_float(rr[0]), __uint_as_float(rr[1])); }
  const bool keep = __all(pmax - m_reg <= THR / SCALE);
  const float mn = keep ? m_reg : fmaxf(m_reg, pmax);
  alpha = keep ? 1.f : __builtin_amdgcn_exp2f((m_reg - mn) * C);
  m_reg = mn;
  const float mnC = -mn * C;
#pragma unroll
  for (int r = 0; r < 16; ++r) p[r] = __builtin_amdgcn_exp2f(fmaf(p[r], C, mnC));
  float ps = 0.f;
#pragma unroll
  for (int r = 0; r < 16; ++r) ps += p[r];
  { auto rr = __builtin_amdgcn_permlane32_swap(__float_as_uint(ps), __float_as_uint(ps), false, false); ps = __uint_as_float(rr[0]) + __uint_as_float(rr[1]); }
  l_reg = l_reg * alpha + ps;
#define A2_PK4(P, BASE, OUT) do { unsigned a0 = cvtpk(P[BASE + 0], P[BASE + 1]), a1 = cvtpk(P[BASE + 2], P[BASE + 3]);   \
    unsigned b0 = cvtpk(P[BASE + 4], P[BASE + 5]), b1 = cvtpk(P[BASE + 6], P[BASE + 7]);                              \
    auto r0 = __builtin_amdgcn_permlane32_swap(a0, b0, false, false); auto r1 = __builtin_amdgcn_permlane32_swap(a1, b1, false, false); \
    u32x4 w = {r0[0], r1[0], r0[1], r1[1]}; OUT = __builtin_bit_cast(bf16x8, w); } while (0)
  A2_PK4(p, 0, pa0); A2_PK4(p, 8, pa1);
#undef A2_PK4
}

__device__ __forceinline__ void attn_unit(const bf16* __restrict__ Qb, const bf16* __restrict__ Kc, const bf16* __restrict__ Kl, const bf16* __restrict__ Vc, const bf16* __restrict__ Vl,
                                          bf16* __restrict__ Ob, int seq, char* shm, float* sml) {
  int tid = threadIdx.x; asm volatile("" : "+v"(tid));
  const int lane = tid & 63, r32 = lane & 31, hi = lane >> 5; const int wid = __builtin_amdgcn_readfirstlane(tid >> 6), rg = wid & 3, kh = wid >> 2;
  const unsigned lds0 = (unsigned)(uintptr_t)shm; const lds_cptr shm3 = (lds_cptr)shm;
  float* wsf = sml + wid * 128; float* wsp = sml + (wid ^ 4) * 128;
  unsigned koff[2], voff[4];
#pragma unroll
  for (int i = 0; i < 2; ++i) { const int q = wid * 2 + i, row = 4 * q + (lane >> 4); koff[i] = (unsigned)(row * 256 + (((lane & 15) << 4) ^ ((row & 7) << 4))); }
#pragma unroll
  for (int i = 0; i < 4; ++i) { const int q = wid * 4 + i, st = 2 * q + (lane >> 5), kk = (st >> 3) * 8 + ((lane & 31) >> 2), k = (kk & ~0xC) | ((kk & 4) << 1) | ((kk & 8) >> 1), c = (st & 7) * 32 + (lane & 3) * 8;
    voff[i] = (unsigned)(k * 512 + c * 2); }
  const unsigned kdst = lds0 + LDS_K + wid * 2048, vdst = lds0 + LDS_V + wid * 4096;
#define A2_DMA(t, kslot, vslot) do { const int k0_ = (t) * 64; \
    const char* kt_ = (k0_ < CTXN) ? (const char*)Kc + (size_t)k0_ * 256 : (const char*)Kl + (size_t)(k0_ - CTXN) * 256; \
    const char* vt_ = (k0_ < CTXN) ? (const char*)Vc + (size_t)k0_ * 512 : (const char*)Vl + (size_t)(k0_ - CTXN) * 512; \
    _Pragma("unroll") for (int i_ = 0; i_ < 2; ++i_) glds16(kt_ + koff[i_], (unsigned)__builtin_amdgcn_readfirstlane(kdst + i_ * 1024 + (kslot))); \
    _Pragma("unroll") for (int i_ = 0; i_ < 4; ++i_) glds16(vt_ + voff[i_], (unsigned)__builtin_amdgcn_readfirstlane(vdst + i_ * 1024 + (vslot))); } while (0)
  const int NT = seq / 64;
  bf16x8 qr[8];
  { const bf16* Qw = Qb + (size_t)(rg * 32 + r32) * 128 + hi * 8;
#pragma unroll
    for (int d0 = 0; d0 < 8; ++d0) qr[d0] = *reinterpret_cast<const bf16x8*>(Qw + d0 * 16); }
  if (kh) __builtin_amdgcn_s_setprio(1);
  { const char* k0p = (const char*)Kc; const char* v0p = (const char*)Vc;
#pragma unroll
    for (int i = 0; i < 2; ++i) glds16(k0p + koff[i], (unsigned)__builtin_amdgcn_readfirstlane(kdst + i * 1024));
#pragma unroll
    for (int i = 0; i < 2; ++i) glds16(k0p + 64 * 256 + koff[i], (unsigned)__builtin_amdgcn_readfirstlane(kdst + KBUF + i * 1024));
#pragma unroll
    for (int i = 0; i < 4; ++i) glds16(v0p + voff[i], (unsigned)__builtin_amdgcn_readfirstlane(vdst + i * 1024)); }
  const int krow = kh * 32 + r32, kx = (krow & 7) << 4;
  const lds_cptr kp0 = shm3 + LDS_K + krow * 256, vp0 = shm3 + LDS_V + v_rd_base(lane) + kh * 16384;
  float m_reg = -1e30f, l_reg = 0.f, alpha = 1.f; f32x16 o[8];
#pragma unroll
  for (int d = 0; d < 8; ++d) o[d] = f32x16{};
  f32x16 pA, pB; bf16x8 pa0, pa1;
#define A2_SB() __builtin_amdgcn_sched_barrier(0)
#define A2_PK(L, H) (bf16x8){L[0], L[1], L[2], L[3], H[0], H[1], H[2], H[3]}
#define A2_KLD(d0) (*(const __attribute__((address_space(3))) bf16x8*)(kb + ((((d0) * 32 + hi * 16)) ^ kx)))
#define A2_VLDA(S, d0) do { S##0 = vtr(vp + (d0) * 512); S##1 = vtr(vp + (d0) * 512 + 4096); } while (0)
#define A2_VLDB(S, d0) do { S##0 = vtr(vp + (d0) * 512 + 8192); S##1 = vtr(vp + (d0) * 512 + 12288); } while (0)
#define A2_PVA(d0, S) o[d0] = __builtin_amdgcn_mfma_f32_32x32x16_bf16(pa0, A2_PK(S##0, S##1), o[d0], 0, 0, 0)
#define A2_PVB(d0, S) o[d0] = __builtin_amdgcn_mfma_f32_32x32x16_bf16(pa1, A2_PK(S##0, S##1), o[d0], 0, 0, 0)
#define A2_MAX3(a, b, c) fmaxf(fmaxf((a), (b)), (c))
#define A2_E4(P, i) do { P[i] = __builtin_amdgcn_exp2f(fmaf(P[i], C, mnC)); P[(i) + 1] = __builtin_amdgcn_exp2f(fmaf(P[(i) + 1], C, mnC)); \
    P[(i) + 2] = __builtin_amdgcn_exp2f(fmaf(P[(i) + 2], C, mnC)); P[(i) + 3] = __builtin_amdgcn_exp2f(fmaf(P[(i) + 3], C, mnC)); } while (0)
#define A2_PACK(P, BASE, OUT) do { unsigned a0 = cvtpk(P[BASE + 0], P[BASE + 1]), a1 = cvtpk(P[BASE + 2], P[BASE + 3]);   \
    unsigned b0 = cvtpk(P[BASE + 4], P[BASE + 5]), b1 = cvtpk(P[BASE + 6], P[BASE + 7]);                              \
    auto r0 = __builtin_amdgcn_permlane32_swap(a0, b0, false, false); auto r1 = __builtin_amdgcn_permlane32_swap(a1, b1, false, false); \
    u32x4 w = {r0[0], r1[0], r0[1], r1[1]}; OUT = __builtin_bit_cast(bf16x8, w); } while (0)
#define A2_STEP(PC, PN, KRD, KST, VRD, VST, j) do { \
    A2_WAIT_BAR(0); \
    const int tk_ = ((j) + 2 < NT) ? (j) + 2 : NT - 1, tv_ = ((j) + 1 < NT) ? (j) + 1 : NT - 1; \
    const char* ktn = (tk_ * 64 < CTXN) ? (const char*)Kc + (size_t)(tk_ * 64) * 256 : (const char*)Kl + (size_t)(tk_ * 64 - CTXN) * 256; \
    const char* vtn = (tv_ * 64 < CTXN) ? (const char*)Vc + (size_t)(tv_ * 64) * 512 : (const char*)Vl + (size_t)(tv_ * 64 - CTXN) * 512; \
    const unsigned kdn = (unsigned)__builtin_amdgcn_readfirstlane(kdst + (KST)), vdn = (unsigned)__builtin_amdgcn_readfirstlane(vdst + (VST)); \
    const lds_cptr kb = kp0 + (KRD); const lds_cptr vp = vp0 + (VRD); \
    bf16x8 ka, kc; s16x4 va0, va1, vb0, vb1; \
    ka = A2_KLD(0); kc = A2_KLD(1); A2_SB(); \
    PN = __builtin_amdgcn_mfma_f32_32x32x16_bf16(ka, qr[0], f32x16{}, 0, 0, 0); ka = A2_KLD(2); glds16(ktn + koff[0], kdn); \
    const float x1_ = A2_MAX3(PC[0], PC[1], PC[2]), x2_ = A2_MAX3(PC[3], PC[4], PC[5]), x3_ = A2_MAX3(PC[6], PC[7], PC[8]), x4_ = A2_MAX3(PC[9], PC[10], PC[11]), x5_ = A2_MAX3(PC[12], PC[13], PC[14]); A2_SB(); \
    PN = __builtin_amdgcn_mfma_f32_32x32x16_bf16(kc, qr[1], PN, 0, 0, 0); kc = A2_KLD(3); glds16(ktn + koff[1], kdn + 1024); \
    float pmax = fmaxf(A2_MAX3(x1_, x2_, x3_), A2_MAX3(x4_, x5_, PC[15])); \
    { auto rr = __builtin_amdgcn_permlane32_swap(__float_as_uint(pmax), __float_as_uint(pmax), false, false); pmax = fmaxf(__uint_as_float(rr[0]), __uint_as_float(rr[1])); } A2_SB(); \
    PN = __builtin_amdgcn_mfma_f32_32x32x16_bf16(ka, qr[2], PN, 0, 0, 0); ka = A2_KLD(4); glds16(vtn + voff[0], vdn); \
    const float mn = (pmax - m_reg > THR / SCALE) ? fmaxf(m_reg, pmax) : m_reg; \
    alpha = __builtin_amdgcn_exp2f((m_reg - mn) * C); m_reg = mn; const float mnC = -mn * C; A2_SB(); \
    PN = __builtin_amdgcn_mfma_f32_32x32x16_bf16(kc, qr[3], PN, 0, 0, 0); kc = A2_KLD(5); glds16(vtn + voff[1], vdn + 1024); A2_E4(PC, 0); A2_SB(); \
    PN = __builtin_amdgcn_mfma_f32_32x32x16_bf16(ka, qr[4], PN, 0, 0, 0); ka = A2_KLD(6); glds16(vtn + voff[2], vdn + 2048); A2_E4(PC, 4); float sa = PC[0] + PC[1], sb = PC[2] + PC[3]; A2_SB(); \
    PN = __builtin_amdgcn_mfma_f32_32x32x16_bf16(kc, qr[5], PN, 0, 0, 0); kc = A2_KLD(7); glds16(vtn + voff[3], vdn + 3072); A2_E4(PC, 8); sa += PC[4]; sb += PC[5]; sa += PC[6]; sb += PC[7]; A2_SB(); \
    PN = __builtin_amdgcn_mfma_f32_32x32x16_bf16(ka, qr[6], PN, 0, 0, 0); A2_VLDA(va, 0); A2_E4(PC, 12); sa += PC[8]; sb += PC[9]; sa += PC[10]; sb += PC[11]; A2_SB(); \
    PN = __builtin_amdgcn_mfma_f32_32x32x16_bf16(kc, qr[7], PN, 0, 0, 0); A2_VLDA(vb, 1); sa += PC[12]; sb += PC[13]; sa += PC[14]; sb += PC[15]; float ps = sa + sb; \
    { auto rr = __builtin_amdgcn_permlane32_swap(__float_as_uint(ps), __float_as_uint(ps), false, false); ps = __uint_as_float(rr[0]) + __uint_as_float(rr[1]); } \
    l_reg = l_reg * alpha + ps; A2_PACK(PC, 0, pa0); A2_SB(); \
    if (__any(alpha < 1.f)) { if (hi == 0) wsf[r32] = alpha; asm volatile("s_waitcnt lgkmcnt(0)" ::: "memory"); \
      _Pragma("unroll") for (int r = 0; r < 16; ++r) { const float a_ = wsf[crow(r, hi)]; \
        _Pragma("unroll") for (int d = 0; d < 8; ++d) o[d][r] *= a_; } } \
    A2_PVA(0, va); A2_VLDA(va, 2); { unsigned a0 = cvtpk(PC[8], PC[9]), a1 = cvtpk(PC[10], PC[11]), b0 = cvtpk(PC[12], PC[13]), b1 = cvtpk(PC[14], PC[15]); \
      auto r0 = __builtin_amdgcn_permlane32_swap(a0, b0, false, false); auto r1 = __builtin_amdgcn_permlane32_swap(a1, b1, false, false); u32x4 w = {r0[0], r1[0], r0[1], r1[1]}; pa1 = __builtin_bit_cast(bf16x8, w); } A2_SB(); \
    A2_PVA(1, vb); A2_VLDA(vb, 3); A2_SB(); A2_PVA(2, va); A2_VLDA(va, 4); A2_SB(); A2_PVA(3, vb); A2_VLDA(vb, 5); A2_SB(); \
    A2_PVA(4, va); A2_VLDA(va, 6); A2_SB(); A2_PVA(5, vb); A2_VLDA(vb, 7); A2_SB(); A2_PVA(6, va); A2_VLDB(va, 0); A2_SB(); A2_PVA(7, vb); A2_VLDB(vb, 1); A2_SB(); \
    A2_PVB(0, va); A2_VLDB(va, 2); A2_SB(); A2_PVB(1, vb); A2_VLDB(vb, 3); A2_SB(); A2_PVB(2, va); A2_VLDB(va, 4); A2_SB(); A2_PVB(3, vb); A2_VLDB(vb, 5); A2_SB(); \
    A2_PVB(4, va); A2_VLDB(va, 6); A2_SB(); A2_PVB(5, vb); A2_VLDB(vb, 7); A2_SB(); A2_PVB(6, va); A2_SB(); A2_PVB(7, vb); A2_SB(); } while (0)
  A2_WAIT_BAR(0);
  qkt(pA, shm3 + LDS_K, qr, krow, hi);
  for (int j = 0; j < NT; j += 2) {
    A2_STEP(pA, pB, KBUF, 0, 0, VBUF, j);
    A2_STEP(pB, pA, 0, KBUF, VBUF, 0, j + 1);
  }
#undef A2_STEP
#undef A2_PACK
#undef A2_E4
#undef A2_MAX3
#undef A2_PVA
#undef A2_PVB
#undef A2_VLDA
#undef A2_VLDB
#undef A2_KLD
#undef A2_PK
#undef A2_SB
  if (hi == 0) { wsf[32 + r32] = m_reg; wsf[64 + r32] = l_reg; }
  A2_WAIT_BAR(0);
  { const float pm = wsp[32 + r32], pl = wsp[64 + r32], M = fmaxf(m_reg, pm);
    const float fs = __builtin_amdgcn_exp2f((m_reg - M) * C), fp = __builtin_amdgcn_exp2f((pm - M) * C);
    const float Ltot = l_reg * fs + pl * fp;
    if (hi == 0) wsf[r32] = fs * __builtin_amdgcn_rcpf(Ltot); }
  asm volatile("s_waitcnt lgkmcnt(0)" ::: "memory");
  float fr_[16];
#pragma unroll
  for (int r = 0; r < 16; ++r) fr_[r] = wsf[crow(r, hi)];
  int lane2 = lane; asm volatile("" : "+v"(lane2));
  const int r32b = lane2 & 31, hib = lane2 >> 5;
  float* xs = (float*)shm + wid * 4096 + lane2; const float* xr = (const float*)shm + (wid ^ 4) * 4096 + lane2;
  bf16* Ow = Ob + (size_t)(rg * 32) * LDO + r32b;
  if (kh == 0) {
#pragma unroll
    for (int d = 0; d < 4; ++d)
#pragma unroll
      for (int r = 0; r < 16; ++r) xs[(d * 16 + r) * 64] = o[4 + d][r] * fr_[r];
    A2_WAIT_BAR(0);
#pragma unroll
    for (int d = 0; d < 4; ++d)
#pragma unroll
      for (int r = 0; r < 16; ++r) { const float v = o[d][r] * fr_[r] + xr[(d * 16 + r) * 64]; Ow[(size_t)crow(r, hib) * LDO + d * 32] = (bf16)(cvtpk(v, 0.f) & 0xffffu); }
  } else {
#pragma unroll
    for (int d = 0; d < 4; ++d)
#pragma unroll
      for (int r = 0; r < 16; ++r) xs[(d * 16 + r) * 64] = o[d][r] * fr_[r];
    A2_WAIT_BAR(0);
#pragma unroll
    for (int d = 0; d < 4; ++d)
#pragma unroll
      for (int r = 0; r < 16; ++r) { const float v = o[4 + d][r] * fr_[r] + xr[(d * 16 + r) * 64]; Ow[(size_t)crow(r, hib) * LDO + 128 + d * 32] = (bf16)(cvtpk(v, 0.f) & 0xffffu); }
  }
  A2_WAIT_BAR(0);
  __builtin_amdgcn_s_setprio(0);
#undef A2_DMA
}

__device__ __forceinline__ void attn_unit256(const bf16* __restrict__ Qb, const bf16* __restrict__ Kc, const bf16* __restrict__ Kl, const bf16* __restrict__ Vc, const bf16* __restrict__ Vl,
                                             bf16* __restrict__ Ob, int seq, char* shm, float* sml) {
  int tid = threadIdx.x; asm volatile("" : "+v"(tid));
  const int lane = tid & 63, r32 = lane & 31, hi = lane >> 5; const int wid = __builtin_amdgcn_readfirstlane(tid >> 6);
  const unsigned lds0 = (unsigned)(uintptr_t)shm; const lds_cptr shm3 = (lds_cptr)shm;
  float* wsf = sml + wid * 128;
  unsigned koff[2], voff[4];
#pragma unroll
  for (int i = 0; i < 2; ++i) { const int q = wid * 2 + i, row = 4 * q + (lane >> 4); koff[i] = (unsigned)(row * 256 + (((lane & 15) << 4) ^ ((row & 7) << 4))); }
#pragma unroll
  for (int i = 0; i < 4; ++i) { const int q = wid * 4 + i, st = 2 * q + (lane >> 5), kk = (st >> 3) * 8 + ((lane & 31) >> 2), k = (kk & ~0xC) | ((kk & 4) << 1) | ((kk & 8) >> 1), c = (st & 7) * 32 + (lane & 3) * 8;
    voff[i] = (unsigned)(k * 512 + c * 2); }
  const unsigned kdst = lds0 + LDS_K + wid * 2048, vdst = lds0 + LDS_V + wid * 4096;
  const int NT = seq / 64;
  bf16x8 qr[8];
  { const bf16* Qw = Qb + (size_t)(wid * 32 + r32) * 128 + hi * 8;
#pragma unroll
    for (int d0 = 0; d0 < 8; ++d0) qr[d0] = *reinterpret_cast<const bf16x8*>(Qw + d0 * 16); }
  { const char* k0p = (const char*)Kc; const char* v0p = (const char*)Vc;
#pragma unroll
    for (int i = 0; i < 2; ++i) glds16(k0p + koff[i], (unsigned)__builtin_amdgcn_readfirstlane(kdst + i * 1024));
#pragma unroll
    for (int i = 0; i < 4; ++i) glds16(v0p + voff[i], (unsigned)__builtin_amdgcn_readfirstlane(vdst + i * 1024)); }
  const int kx = (r32 & 7) << 4;
  const lds_cptr kp0 = shm3 + LDS_K + r32 * 256, vp0 = shm3 + LDS_V + v_rd_base(lane);
  float m_reg = -1e30f, l_reg = 0.f, alpha = 1.f; f32x16 o[8];
#pragma unroll
  for (int d = 0; d < 8; ++d) o[d] = f32x16{};
  f32x16 p; bf16x8 pa0, pa1;
#define A5_SB() __builtin_amdgcn_sched_barrier(0)
#define A5_PK(L, H) (bf16x8){L[0], L[1], L[2], L[3], H[0], H[1], H[2], H[3]}
#define A5_KLD(d0) (*(const __attribute__((address_space(3))) bf16x8*)(kb + ((((d0) * 32 + hi * 16)) ^ kx)))
#define A5_VLDA(S, d0) do { S##0 = vtr(vp + (d0) * 512); S##1 = vtr(vp + (d0) * 512 + 4096); } while (0)
#define A5_VLDB(S, d0) do { S##0 = vtr(vp + (d0) * 512 + 8192); S##1 = vtr(vp + (d0) * 512 + 12288); } while (0)
#define A5_PVA(d0, S) o[d0] = __builtin_amdgcn_mfma_f32_32x32x16_bf16(pa0, A5_PK(S##0, S##1), o[d0], 0, 0, 0)
#define A5_PVB(d0, S) o[d0] = __builtin_amdgcn_mfma_f32_32x32x16_bf16(pa1, A5_PK(S##0, S##1), o[d0], 0, 0, 0)
#define A5_MAX3(a, b, c) fmaxf(fmaxf((a), (b)), (c))
#define A5_NOPIECE(i) do { } while (0)
#define A5_PIECE(i) do { if ((i) == 0) glds16(ktn + koff[0], kdn); else if ((i) == 1) glds16(ktn + koff[1], kdn + 1024); else glds16(vtn + voff[(i) - 2], vdn + ((i) - 2) * 1024); } while (0)
#define A5_HALF(KOFF, VOFF, PIECE) do { \
    const lds_cptr kb = kp0 + (KOFF); const lds_cptr vp = vp0 + (VOFF); \
    bf16x8 ka, kc; s16x4 va0, va1, vb0, vb1; \
    ka = A5_KLD(0); kc = A5_KLD(1); A5_SB(); \
    p = __builtin_amdgcn_mfma_f32_32x32x16_bf16(ka, qr[0], f32x16{}, 0, 0, 0); ka = A5_KLD(2); PIECE(0); A5_SB(); \
    p = __builtin_amdgcn_mfma_f32_32x32x16_bf16(kc, qr[1], p, 0, 0, 0); kc = A5_KLD(3); PIECE(1); A5_SB(); \
    p = __builtin_amdgcn_mfma_f32_32x32x16_bf16(ka, qr[2], p, 0, 0, 0); ka = A5_KLD(4); PIECE(2); A5_SB(); \
    p = __builtin_amdgcn_mfma_f32_32x32x16_bf16(kc, qr[3], p, 0, 0, 0); kc = A5_KLD(5); PIECE(3); A5_SB(); \
    p = __builtin_amdgcn_mfma_f32_32x32x16_bf16(ka, qr[4], p, 0, 0, 0); ka = A5_KLD(6); PIECE(4); A5_SB(); \
    p = __builtin_amdgcn_mfma_f32_32x32x16_bf16(kc, qr[5], p, 0, 0, 0); kc = A5_KLD(7); PIECE(5); A5_SB(); \
    p = __builtin_amdgcn_mfma_f32_32x32x16_bf16(ka, qr[6], p, 0, 0, 0); A5_VLDA(va, 0); A5_SB(); \
    p = __builtin_amdgcn_mfma_f32_32x32x16_bf16(kc, qr[7], p, 0, 0, 0); A5_VLDA(vb, 1); A5_SB(); \
    const float x1_ = A5_MAX3(p[0], p[1], p[2]), x2_ = A5_MAX3(p[3], p[4], p[5]), x3_ = A5_MAX3(p[6], p[7], p[8]), x4_ = A5_MAX3(p[9], p[10], p[11]), x5_ = A5_MAX3(p[12], p[13], p[14]); \
    float pmax = fmaxf(A5_MAX3(x1_, x2_, x3_), A5_MAX3(x4_, x5_, p[15])); \
    { auto rr = __builtin_amdgcn_permlane32_swap(__float_as_uint(pmax), __float_as_uint(pmax), false, false); pmax = fmaxf(__uint_as_float(rr[0]), __uint_as_float(rr[1])); } \
    const float mn = (pmax - m_reg > THR / SCALE) ? fmaxf(m_reg, pmax) : m_reg; \
    alpha = __builtin_amdgcn_exp2f((m_reg - mn) * C); m_reg = mn; const float mnC = -mn * C; \
    _Pragma("unroll") for (int r = 0; r < 16; ++r) p[r] = __builtin_amdgcn_exp2f(fmaf(p[r], C, mnC)); \
    float ps = ((p[0] + p[1]) + (p[2] + p[3])) + ((p[4] + p[5]) + (p[6] + p[7])); ps += ((p[8] + p[9]) + (p[10] + p[11])) + ((p[12] + p[13]) + (p[14] + p[15])); \
    { auto rr = __builtin_amdgcn_permlane32_swap(__float_as_uint(ps), __float_as_uint(ps), false, false); ps = __uint_as_float(rr[0]) + __uint_as_float(rr[1]); } \
    l_reg = l_reg * alpha + ps; \
    { unsigned a0 = cvtpk(p[0], p[1]), a1 = cvtpk(p[2], p[3]), b0 = cvtpk(p[4], p[5]), b1 = cvtpk(p[6], p[7]); \
      auto r0 = __builtin_amdgcn_permlane32_swap(a0, b0, false, false); auto r1 = __builtin_amdgcn_permlane32_swap(a1, b1, false, false); u32x4 w = {r0[0], r1[0], r0[1], r1[1]}; pa0 = __builtin_bit_cast(bf16x8, w); } \
    { unsigned a0 = cvtpk(p[8], p[9]), a1 = cvtpk(p[10], p[11]), b0 = cvtpk(p[12], p[13]), b1 = cvtpk(p[14], p[15]); \
      auto r0 = __builtin_amdgcn_permlane32_swap(a0, b0, false, false); auto r1 = __builtin_amdgcn_permlane32_swap(a1, b1, false, false); u32x4 w = {r0[0], r1[0], r0[1], r1[1]}; pa1 = __builtin_bit_cast(bf16x8, w); } \
    if (__any(alpha < 1.f)) { if (hi == 0) wsf[r32] = alpha; asm volatile("s_waitcnt lgkmcnt(0)" ::: "memory"); \
      _Pragma("unroll") for (int r = 0; r < 16; ++r) { const float a_ = wsf[crow(r, hi)]; \
        _Pragma("unroll") for (int d = 0; d < 8; ++d) o[d][r] *= a_; } } \
    A5_SB(); \
    A5_PVA(0, va); A5_VLDA(va, 2); A5_SB(); A5_PVA(1, vb); A5_VLDA(vb, 3); A5_SB(); A5_PVA(2, va); A5_VLDA(va, 4); A5_SB(); A5_PVA(3, vb); A5_VLDA(vb, 5); A5_SB(); \
    A5_PVA(4, va); A5_VLDA(va, 6); A5_SB(); A5_PVA(5, vb); A5_VLDA(vb, 7); A5_SB(); A5_PVA(6, va); A5_VLDB(va, 0); A5_SB(); A5_PVA(7, vb); A5_VLDB(vb, 1); A5_SB(); \
    A5_PVB(0, va); A5_VLDB(va, 2); A5_SB(); A5_PVB(1, vb); A5_VLDB(vb, 3); A5_SB(); A5_PVB(2, va); A5_VLDB(va, 4); A5_SB(); A5_PVB(3, vb); A5_VLDB(vb, 5); A5_SB(); \
    A5_PVB(4, va); A5_VLDB(va, 6); A5_SB(); A5_PVB(5, vb); A5_VLDB(vb, 7); A5_SB(); A5_PVB(6, va); A5_SB(); A5_PVB(7, vb); A5_SB(); } while (0)
#define A5_TILE(KS, VS, KSN, VSN, j) do { \
    A2_WAIT_BAR(0); \
    const int tn_ = ((j) + 1 < NT) ? (j) + 1 : NT - 1; \
    const char* ktn = (tn_ * 64 < CTXN) ? (const char*)Kc + (size_t)(tn_ * 64) * 256 : (const char*)Kl + (size_t)(tn_ * 64 - CTXN) * 256; \
    const char* vtn = (tn_ * 64 < CTXN) ? (const char*)Vc + (size_t)(tn_ * 64) * 512 : (const char*)Vl + (size_t)(tn_ * 64 - CTXN) * 512; \
    const unsigned kdn = (unsigned)__builtin_amdgcn_readfirstlane(kdst + (KSN)), vdn = (unsigned)__builtin_amdgcn_readfirstlane(vdst + (VSN)); \
    A5_HALF((KS), (VS), A5_PIECE); \
    A5_HALF((KS) + 8192, (VS) + 16384, A5_NOPIECE); } while (0)
  for (int j = 0; j < NT; j += 2) {
    A5_TILE(0, 0, KBUF, VBUF, j);
    A5_TILE(KBUF, VBUF, 0, 0, j + 1);
  }
#undef A5_TILE
#undef A5_HALF
#undef A5_PIECE
#undef A5_NOPIECE
#undef A5_MAX3
#undef A5_PVA
#undef A5_PVB
#undef A5_VLDA
#undef A5_VLDB
#undef A5_KLD
#undef A5_PK
#undef A5_SB
  if (hi == 0) wsf[32 + r32] = l_reg;
  asm volatile("s_waitcnt lgkmcnt(0)" ::: "memory");
  int lane2 = lane; asm volatile("" : "+v"(lane2));
  const int r32b = lane2 & 31, hib = lane2 >> 5;
  float rli[16];
#pragma unroll
  for (int r = 0; r < 16; ++r) rli[r] = __builtin_amdgcn_rcpf(wsf[32 + crow(r, hib)]);
  bf16* Ow = Ob + (size_t)(wid * 32) * LDO + r32b;
#pragma unroll
  for (int r = 0; r < 16; ++r)
#pragma unroll
    for (int d = 0; d < 8; ++d) Ow[(size_t)crow(r, hib) * LDO + d * 32] = (bf16)(cvtpk(o[d][r] * rli[r], 0.f) & 0xffffu);
  A2_WAIT_BAR(0);
}

using i32x4v = __attribute__((ext_vector_type(4))) int;
using i32x16 = __attribute__((ext_vector_type(16))) int;
using f32x4v = __attribute__((ext_vector_type(4))) float;
__device__ __forceinline__ unsigned q8p(float a, float b, float c, float d) {
  const int ia = (int)__builtin_rintf(a), ib = (int)__builtin_rintf(b), ic = (int)__builtin_rintf(c), id = (int)__builtin_rintf(d);
  return (unsigned)(ia & 255) | ((unsigned)(ib & 255) << 8) | ((unsigned)(ic & 255) << 16) | ((unsigned)id << 24); }
__device__ __forceinline__ float blo(unsigned w) { return __uint_as_float(w << 16); }
__device__ __forceinline__ float bhi(unsigned w) { return __uint_as_float(w & 0xffff0000u); }
__device__ __forceinline__ void attn_unit256q(const bf16* __restrict__ Qb, const unsigned char* __restrict__ Kc, const unsigned char* __restrict__ Kl, const float* __restrict__ Sc, const float* __restrict__ Sl,
                                              const bf16* __restrict__ Vc, const bf16* __restrict__ Vl, bf16* __restrict__ Ob, int seq, char* shm, float* sml) {
  int tid = threadIdx.x; asm volatile("" : "+v"(tid));
  const int lane = tid & 63, r32 = lane & 31, hi = lane >> 5; const int wid = __builtin_amdgcn_readfirstlane(tid >> 6);
  const unsigned lds0 = (unsigned)(uintptr_t)shm; const lds_cptr shm3 = (lds_cptr)shm;
  float* wsf = sml + wid * 128;
  unsigned koff, voff[4];
  { const int row = wid * 8 + (lane >> 3); koff = (unsigned)(row * 128 + (((lane & 7) ^ (row & 7)) << 4)); }
#pragma unroll
  for (int i = 0; i < 4; ++i) { const int q = wid * 4 + i, st = 2 * q + (lane >> 5), kk = (st >> 3) * 8 + ((lane & 31) >> 2), k = (kk & ~0xC) | ((kk & 4) << 1) | ((kk & 8) >> 1), c = (st & 7) * 32 + (lane & 3) * 8;
    voff[i] = (unsigned)(k * 512 + c * 2); }
  const unsigned kdst = lds0 + LDS_K + wid * 1024, vdst = lds0 + LDS_V + wid * 4096;
  const int NT = seq / 64;
  i32x4v qr[4]; float Cq, thrq;
  { const u32x4* Qw = (const u32x4*)(Qb + (size_t)(wid * 32 + r32) * 128 + hi * 16);
    u32x4 qa[4], qb[4];
#pragma unroll
    for (int d0 = 0; d0 < 4; ++d0) { qa[d0] = Qw[d0 * 4]; qb[d0] = Qw[d0 * 4 + 1]; }
    float mx = 0.f;
#define Q5_MX(w) mx = fmaxf(mx, fmaxf(__builtin_fabsf(blo(w)), __builtin_fabsf(bhi(w))))
#pragma unroll
    for (int d0 = 0; d0 < 4; ++d0) { Q5_MX(qa[d0].x); Q5_MX(qa[d0].y); Q5_MX(qa[d0].z); Q5_MX(qa[d0].w); Q5_MX(qb[d0].x); Q5_MX(qb[d0].y); Q5_MX(qb[d0].z); Q5_MX(qb[d0].w); }
#undef Q5_MX
    { auto rr = __builtin_amdgcn_permlane32_swap(__float_as_uint(mx), __float_as_uint(mx), false, false); mx = fmaxf(__uint_as_float(rr[0]), __uint_as_float(rr[1])); }
    const float inv = mx > 0.f ? 127.f / mx : 0.f, qs = mx * (1.f / 127.f);
    Cq = C * qs; thrq = mx > 0.f ? THR / (SCALE * qs) : 3.0e38f;
#define Q5_Q2(w0, w1) q8p(blo(w0) * inv, bhi(w0) * inv, blo(w1) * inv, bhi(w1) * inv)
#pragma unroll
    for (int d0 = 0; d0 < 4; ++d0) { qr[d0][0] = (int)Q5_Q2(qa[d0].x, qa[d0].y); qr[d0][1] = (int)Q5_Q2(qa[d0].z, qa[d0].w); qr[d0][2] = (int)Q5_Q2(qb[d0].x, qb[d0].y); qr[d0][3] = (int)Q5_Q2(qb[d0].z, qb[d0].w); }
#undef Q5_Q2
  }
  { glds16((const char*)Kc + koff, (unsigned)__builtin_amdgcn_readfirstlane(kdst));
#pragma unroll
    for (int i = 0; i < 4; ++i) glds16((const char*)Vc + voff[i], (unsigned)__builtin_amdgcn_readfirstlane(vdst + i * 1024)); }
  const int kx = (r32 & 7) << 4;
  const lds_cptr kp0 = shm3 + LDS_K + r32 * 128, vp0 = shm3 + LDS_V + v_rd_base(lane);
  float ksn0 = Sc[0], ksn1 = Sc[1];
  constexpr float BIAS = 12582912.f;
  i32x16 bini;
#pragma unroll
  for (int r = 0; r < 16; ++r) bini[r] = 0x4B400000;
  asm volatile("" : "+v"(bini));
  float m_reg = -1e30f, l_reg = 0.f, alpha = 1.f; f32x16 o[8];
#pragma unroll
  for (int d = 0; d < 8; ++d) o[d] = f32x16{};
  f32x16 p; i32x16 p8; bf16x8 pa0, pa1; float ks0, ks1;
#define A5_SB() __builtin_amdgcn_sched_barrier(0)
#define A5_PK(L, H) (bf16x8){L[0], L[1], L[2], L[3], H[0], H[1], H[2], H[3]}
#define A5_KLD(d0) (*(const __attribute__((address_space(3))) i32x4v*)(kb + ((((d0) * 32 + hi * 16)) ^ kx)))
#define A5_VLDA(S, d0) do { S##0 = vtr(vp + (d0) * 512); S##1 = vtr(vp + (d0) * 512 + 4096); } while (0)
#define A5_VLDB(S, d0) do { S##0 = vtr(vp + (d0) * 512 + 8192); S##1 = vtr(vp + (d0) * 512 + 12288); } while (0)
#define A5_PVA(d0, S) o[d0] = __builtin_amdgcn_mfma_f32_32x32x16_bf16(pa0, A5_PK(S##0, S##1), o[d0], 0, 0, 0)
#define A5_PVB(d0, S) o[d0] = __builtin_amdgcn_mfma_f32_32x32x16_bf16(pa1, A5_PK(S##0, S##1), o[d0], 0, 0, 0)
#define A5_MAX3(a, b, c) fmaxf(fmaxf((a), (b)), (c))
#define A5_NOPIECE(i) do { } while (0)
#define A5_PIECE(i) do { if ((i) == 0) glds16(ktn + koff, kdn); else if ((i) < 5) glds16(vtn + voff[(i) - 1], vdn + ((i) - 1) * 1024); } while (0)
#define A5_HALF(KOFF, KSB, VOFF, PIECE) do { \
    const lds_cptr kb = kp0 + (KOFF); const lds_cptr vp = vp0 + (VOFF); \
    i32x4v ka, kc; s16x4 va0, va1, vb0, vb1; \
    ka = A5_KLD(0); kc = A5_KLD(1); A5_SB(); \
    p8 = __builtin_amdgcn_mfma_i32_32x32x32_i8(ka, qr[0], bini, 0, 0, 0); ka = A5_KLD(2); PIECE(0); PIECE(1); A5_SB(); \
    p8 = __builtin_amdgcn_mfma_i32_32x32x32_i8(kc, qr[1], p8, 0, 0, 0); kc = A5_KLD(3); PIECE(2); PIECE(3); A5_SB(); \
    p8 = __builtin_amdgcn_mfma_i32_32x32x32_i8(ka, qr[2], p8, 0, 0, 0); PIECE(4); A5_VLDA(va, 0); A5_SB(); \
    p8 = __builtin_amdgcn_mfma_i32_32x32x32_i8(kc, qr[3], p8, 0, 0, 0); A5_VLDA(vb, 1); A5_SB(); \
    _Pragma("unroll") for (int r = 0; r < 16; ++r) p[r] = __int_as_float(p8[r]); \
    const float x1_ = A5_MAX3(p[0], p[1], p[2]), x2_ = A5_MAX3(p[3], p[4], p[5]), x3_ = A5_MAX3(p[6], p[7], p[8]), x4_ = A5_MAX3(p[9], p[10], p[11]), x5_ = A5_MAX3(p[12], p[13], p[14]); \
    float pmax = fmaxf(A5_MAX3(x1_, x2_, x3_), A5_MAX3(x4_, x5_, p[15])); \
    { auto rr = __builtin_amdgcn_permlane32_swap(__float_as_uint(pmax), __float_as_uint(pmax), false, false); pmax = fmaxf(__uint_as_float(rr[0]), __uint_as_float(rr[1])); } \
    pmax = (pmax - BIAS) * (KSB); \
    const float mn = (pmax - m_reg > thrq) ? fmaxf(m_reg, pmax) : m_reg; \
    alpha = __builtin_amdgcn_exp2f((m_reg - mn) * Cq); m_reg = mn; const float c1_ = (KSB) * Cq, mnC = -fmaf(BIAS, c1_, mn * Cq); \
    _Pragma("unroll") for (int r = 0; r < 16; ++r) p[r] = __builtin_amdgcn_exp2f(fmaf(p[r], c1_, mnC)); \
    float ps = ((p[0] + p[1]) + (p[2] + p[3])) + ((p[4] + p[5]) + (p[6] + p[7])); ps += ((p[8] + p[9]) + (p[10] + p[11])) + ((p[12] + p[13]) + (p[14] + p[15])); \
    { auto rr = __builtin_amdgcn_permlane32_swap(__float_as_uint(ps), __float_as_uint(ps), false, false); ps = __uint_as_float(rr[0]) + __uint_as_float(rr[1]); } \
    l_reg = l_reg * alpha + ps; \
    { unsigned a0 = cvtpk(p[0], p[1]), a1 = cvtpk(p[2], p[3]), b0 = cvtpk(p[4], p[5]), b1 = cvtpk(p[6], p[7]); \
      auto r0 = __builtin_amdgcn_permlane32_swap(a0, b0, false, false); auto r1 = __builtin_amdgcn_permlane32_swap(a1, b1, false, false); u32x4 w = {r0[0], r1[0], r0[1], r1[1]}; pa0 = __builtin_bit_cast(bf16x8, w); } \
    { unsigned a0 = cvtpk(p[8], p[9]), a1 = cvtpk(p[10], p[11]), b0 = cvtpk(p[12], p[13]), b1 = cvtpk(p[14], p[15]); \
      auto r0 = __builtin_amdgcn_permlane32_swap(a0, b0, false, false); auto r1 = __builtin_amdgcn_permlane32_swap(a1, b1, false, false); u32x4 w = {r0[0], r1[0], r0[1], r1[1]}; pa1 = __builtin_bit_cast(bf16x8, w); } \
    if (__any(alpha < 1.f)) { if (hi == 0) wsf[r32] = alpha; asm volatile("s_waitcnt lgkmcnt(0)" ::: "memory"); \
      _Pragma("unroll") for (int r = 0; r < 16; ++r) { const float a_ = wsf[crow(r, hi)]; \
        _Pragma("unroll") for (int d = 0; d < 8; ++d) o[d][r] *= a_; } } \
    A5_SB(); \
    A5_PVA(0, va); A5_VLDA(va, 2); A5_SB(); A5_PVA(1, vb); A5_VLDA(vb, 3); A5_SB(); A5_PVA(2, va); A5_VLDA(va, 4); A5_SB(); A5_PVA(3, vb); A5_VLDA(vb, 5); A5_SB(); \
    A5_PVA(4, va); A5_VLDA(va, 6); A5_SB(); A5_PVA(5, vb); A5_VLDA(vb, 7); A5_SB(); A5_PVA(6, va); A5_VLDB(va, 0); A5_SB(); A5_PVA(7, vb); A5_VLDB(vb, 1); A5_SB(); \
    A5_PVB(0, va); A5_VLDB(va, 2); A5_SB(); A5_PVB(1, vb); A5_VLDB(vb, 3); A5_SB(); A5_PVB(2, va); A5_VLDB(va, 4); A5_SB(); A5_PVB(3, vb); A5_VLDB(vb, 5); A5_SB(); \
    A5_PVB(4, va); A5_VLDB(va, 6); A5_SB(); A5_PVB(5, vb); A5_VLDB(vb, 7); A5_SB(); A5_PVB(6, va); A5_SB(); A5_PVB(7, vb); A5_SB(); } while (0)
#define A5_TILE(KS, VS, KSN, VSN, j) do { \
    A2_WAIT_BAR(0); \
    asm volatile("" : "+v"(ksn0), "+v"(ksn1)); ks0 = ksn0; ks1 = ksn1;        \
    const int tn_ = ((j) + 1 < NT) ? (j) + 1 : NT - 1; \
    const char* ktn = (tn_ * 64 < CTXN) ? (const char*)Kc + (size_t)(tn_ * 64) * 128 : (const char*)Kl + (size_t)(tn_ * 64 - CTXN) * 128; \
    { const float* stn = (tn_ * 64 < CTXN) ? Sc + tn_ * 2 : Sl + (tn_ * 2 - CTXN / 32); ksn0 = stn[0]; ksn1 = stn[1]; } \
    const char* vtn = (tn_ * 64 < CTXN) ? (const char*)Vc + (size_t)(tn_ * 64) * 512 : (const char*)Vl + (size_t)(tn_ * 64 - CTXN) * 512; \
    const unsigned kdn = (unsigned)__builtin_amdgcn_readfirstlane(kdst + (KSN)), vdn = (unsigned)__builtin_amdgcn_readfirstlane(vdst + (VSN)); \
    A5_HALF((KS), ks0, (VS), A5_PIECE); \
    A5_HALF((KS) + 4096, ks1, (VS) + 16384, A5_NOPIECE); } while (0)
  for (int j = 0; j < NT; j += 2) {
    A5_TILE(0, 0, KBUF, VBUF, j);
    A5_TILE(KBUF, VBUF, 0, 0, j + 1);
  }
#undef A5_TILE
#undef A5_HALF
#undef A5_PIECE
#undef A5_NOPIECE
#undef A5_MAX3
#undef A5_PVA
#undef A5_PVB
#undef A5_VLDA
#undef A5_VLDB
#undef A5_KLD
#undef A5_PK
#undef A5_SB
  if (hi == 0) wsf[32 + r32] = l_reg;
  asm volatile("s_waitcnt lgkmcnt(0)" ::: "memory");
  int lane2 = lane; asm volatile("" : "+v"(lane2));
  const int r32b = lane2 & 31, hib = lane2 >> 5;
  float rli[16];
#pragma unroll
  for (int r = 0; r < 16; ++r) rli[r] = __builtin_amdgcn_rcpf(wsf[32 + crow(r, hib)]);
  bf16* Ow = Ob + (size_t)(wid * 32) * LDO + r32b;
#pragma unroll
  for (int r = 0; r < 16; ++r)
#pragma unroll
    for (int d = 0; d < 8; ++d) Ow[(size_t)crow(r, hib) * LDO + d * 32] = (bf16)(cvtpk(o[d][r] * rli[r], 0.f) & 0xffffu);
  A2_WAIT_BAR(0);
}
}

#ifndef FORCE_LAM_ALL8
#define FORCE_LAM_ALL8 0.30f
#endif
constexpr int NWAVES = 8;
constexpr int G8T = 8;
constexpr int QB8 = 384 + 8 * G8T;
constexpr float LAM_ALL8 = FORCE_LAM_ALL8, LAM_SAFE = 0.50f;
constexpr int DM = 4096, NB = 4, SEQL = 4096, CTXL = 256;
constexpr int MLAT = NB * SEQL, MCTX = NB * CTXL, MTOT = MLAT + MCTX;
constexpr int NIN0 = 16384;
constexpr float EPS = 1e-6f;
constexpr int N_PHASES = 14;

constexpr size_t MiB = 1u << 20;
constexpr size_t WS_CTL = 0, CTL_ZERO_BYTES = 1 * MiB;
constexpr size_t WS_MOD = 1 * MiB;
constexpr size_t WS_ROPE = WS_MOD + 512 * 1024;
constexpr size_t WS_A16 = WS_ROPE + 64 * 1024;
constexpr size_t WS_RS = WS_A16 + 256 * 1024;
constexpr size_t WS_CS = WS_RS + 72 * 1024;
constexpr size_t WS_CS2 = WS_CS + 64 * 1024;
constexpr size_t WS_WIN0 = 2 * MiB;
constexpr size_t WS_WOUT0 = WS_WIN0 + 128 * MiB;
constexpr size_t WS_W5IN = WS_WOUT0 + 32 * MiB;
constexpr size_t WS_WGLU = WS_W5IN + 64 * MiB;
constexpr size_t WS_W5OUT = WS_WGLU + 32 * MiB;
constexpr size_t WS_E = WS_W5OUT + 32 * MiB;
constexpr size_t WS_W2 = WS_E + 32 * MiB;
constexpr size_t WS_H = WS_W2 + 64 * MiB;
constexpr size_t WS_P = WS_H + 136 * MiB;
constexpr size_t WS_OB = WS_P + 544 * MiB;
constexpr size_t WS_PARTM = WS_OB + 272 * MiB;
constexpr size_t WS_END = WS_PARTM + 8 * MiB;
constexpr size_t WS_QH = WS_P, WS_KH = WS_P + 136 * MiB, WS_VH = WS_P + 272 * MiB, WS_GT = WS_P + 408 * MiB;
constexpr size_t WS_AO = WS_H, WS_OUT0 = WS_P, WS_XS = WS_P, WS_SZ = WS_P + 320 * MiB, WS_HLOC = WS_OB, WS_YG = WS_H, WS_Y2 = WS_OB, WS_OUT1 = WS_P;
constexpr size_t CTL_COLMAX2 = 320 * 1024, CTL_TOKMAX = 384 * 1024;
constexpr size_t CTL_COLMAX = 256 * 1024;
constexpr int CW_TMO = 0, CW_BAR = 4096, CW_MODT = 16384;

constexpr int RING_OFF = 0, RING_BYTES = 131072;
constexpr int LDSCTL_OFF = RING_BYTES, MISC_OFF = LDSCTL_OFF + 320;
constexpr int LDS_BYTES = 147456;
constexpr int ATT_SML_OFF = RING_BYTES + 1024;

#define GAS __attribute__((address_space(1)))
#define LAS __attribute__((address_space(3)))
typedef unsigned short bf16;
typedef unsigned v4u __attribute__((ext_vector_type(4)));
typedef unsigned v2u __attribute__((ext_vector_type(2)));
typedef float f32x4 __attribute__((ext_vector_type(4)));
typedef float f32x2 __attribute__((ext_vector_type(2)));
typedef GAS unsigned gu32;
#define RLX_AGENT __ATOMIC_RELAXED, __HIP_MEMORY_SCOPE_AGENT
#define LDS_WAIT() asm volatile("s_waitcnt lgkmcnt(0)" ::: "memory")
__device__ __forceinline__ unsigned pk2(float lo, float hi) { return pg8::cvt_pk_bf16(lo, hi); }
__device__ __forceinline__ float wave_sum(float v) {
#pragma unroll
    for (int o = 1; o < 64; o <<= 1) v += __shfl_xor(v, o);
    return v;
}
__device__ __forceinline__ float half_sum(float v) {
#pragma unroll
    for (int o = 1; o < 32; o <<= 1) v += __shfl_xor(v, o);
    return v;
}

#define XB_TMO      128
#define XB_XCNT(j)  (256  + 64 * (j))
#define XB_XSUB(j)  (1280 + 64 * (j))
#define XB_XGEN(j)  (2304 + 64 * (j))
#define XB_TOP      3328
#define XB_TOPGEN   3392
#define XCD_BAR_WORDS 3456
#define XB_SPIN_CAP (1u << 18)
__device__ __forceinline__ unsigned xb_ld(unsigned* p)              { return __hip_atomic_load(p, __ATOMIC_RELAXED, __HIP_MEMORY_SCOPE_AGENT); }
__device__ __forceinline__ unsigned xb_add(unsigned* p, unsigned v) { return __hip_atomic_fetch_add(p, v, __ATOMIC_RELAXED, __HIP_MEMORY_SCOPE_AGENT); }
__device__ __forceinline__ unsigned xb_xcc_id() { return (unsigned)__builtin_amdgcn_s_getreg((3 << 11) | 20) & 0xFu; }
#define XB_SPIN(cond, bar) do { unsigned _sp = 0; while (cond) { __builtin_amdgcn_s_sleep(1); \
    if ((++_sp & 255u) == 0u) { if (xb_ld(&(bar)[XB_TMO])) break; if (_sp > XB_SPIN_CAP) { atomicAdd(&(bar)[XB_TMO], 1u); break; } } } } while (0)
struct XcdBarrier { unsigned* bar; unsigned x; volatile LAS unsigned* st; };
__device__ __forceinline__ XcdBarrier xcd_barrier_post(unsigned* bar, volatile LAS unsigned* st) {
    XcdBarrier b; b.bar = bar; b.x = xb_xcc_id(); b.st = st;
    if (threadIdx.x == 0) (void)xb_add(&bar[XB_XCNT(b.x)], 1u);
    return b;
}
__device__ __forceinline__ void xcd_barrier_complete(unsigned* bar, unsigned x, unsigned& nloc, unsigned& nx) {
    const unsigned G = gridDim.x * gridDim.y * gridDim.z;
    unsigned sum, cnt, mine, sp = 0u;
    for (;;) {
        sum = 0u; cnt = 0u; mine = 0u;
#pragma unroll
        for (unsigned j = 0; j < 16; ++j) { const unsigned c = xb_ld(&bar[XB_XCNT(j)]); sum += c; cnt += (c > 0u) ? 1u : 0u; mine = (j == x) ? c : mine; }
        if (sum == G) break;
        __builtin_amdgcn_s_sleep(1);
        if ((++sp & 255u) == 0u) { if (xb_ld(&bar[XB_TMO])) break; if (sp > XB_SPIN_CAP) { atomicAdd(&bar[XB_TMO], 1u); break; } }
    }
    nloc = mine > 0u ? mine : 1u; nx = cnt > 0u ? cnt : 1u;
}
__device__ __forceinline__ void xcd_barrier(const XcdBarrier& b) {
    asm volatile("s_waitcnt vmcnt(0)" ::: "memory");
    __syncthreads();
    if (threadIdx.x == 0) {
        unsigned* bar = b.bar;
        __builtin_amdgcn_s_waitcnt(0);
        unsigned nloc = b.st[0], nx = b.st[1];
        if (nloc == 0u) { xcd_barrier_complete(bar, b.x, nloc, nx); b.st[0] = nloc; b.st[1] = nx; }
        const unsigned old = xb_add(&bar[XB_XSUB(b.x)], 1u);
        const unsigned gen = old / nloc;
        if (old + 1u == (gen + 1u) * nloc) {
            __builtin_amdgcn_fence(__ATOMIC_RELEASE, "agent");
            asm volatile("s_waitcnt vmcnt(0)" ::: "memory");
            const unsigned og = xb_add(&bar[XB_TOP], 1u);
            const unsigned tg = og / nx;
            if (og + 1u == (tg + 1u) * nx) xb_add(&bar[XB_TOPGEN], 1u);
            else XB_SPIN(xb_ld(&bar[XB_TOPGEN]) == tg, bar);
            __builtin_amdgcn_fence(__ATOMIC_ACQUIRE, "agent");
            xb_add(&bar[XB_XGEN(b.x)], 1u);
            asm volatile("s_waitcnt vmcnt(0)" ::: "memory");
        } else {
            XB_SPIN(xb_ld(&bar[XB_XGEN(b.x)]) == gen, bar);
            __builtin_amdgcn_fence(__ATOMIC_ACQUIRE, "agent");
            asm volatile("s_waitcnt vmcnt(0)" ::: "memory");
        }
    }
    __syncthreads();
}

__device__ __forceinline__ void sincos_d(double x, double& s, double& c) {
    const double k = __builtin_rint(x * 0.15915494309189535);
    double r = __builtin_fma(-k, 6.283185307179586, x); r = __builtin_fma(-k, 2.4492935982947064e-16, r);
    const double q = r * 0.25, q2 = q * q;
    double sp = -7.647163731819816e-13;
    sp = sp * q2 + 1.6059043836821613e-10;
    sp = sp * q2 - 2.505210838544172e-08;
    sp = sp * q2 + 2.7557319223985893e-06;
    sp = sp * q2 - 1.984126984126984e-04;
    sp = sp * q2 + 8.333333333333333e-03;
    sp = sp * q2 - 1.6666666666666666e-01;
    double s1 = q + q * q2 * sp;
    double cp = 4.779477332387385e-14;
    cp = cp * q2 - 1.1470745597729725e-11;
    cp = cp * q2 + 2.08767569878681e-09;
    cp = cp * q2 - 2.755731922398589e-07;
    cp = cp * q2 + 2.48015873015873e-05;
    cp = cp * q2 - 1.388888888888889e-03;
    cp = cp * q2 + 4.1666666666666664e-02;
    cp = cp * q2 - 0.5;
    double c1 = 1.0 + q2 * cp;
    double s2 = 2.0 * s1 * c1, c2 = 1.0 - 2.0 * s1 * s1;
    s = 2.0 * s2 * c2; c = 1.0 - 2.0 * s2 * s2;
}
__device__ __forceinline__ double exp_d(double x) {
    const double k = __builtin_rint(x * 1.4426950408889634);
    const double r = __builtin_fma(-k, 0.6931471805599453, x) - k * 2.3190468138462996e-17;
    double p = 1.0 / 479001600.0;
    p = p * r + 1.0 / 39916800.0; p = p * r + 1.0 / 3628800.0; p = p * r + 1.0 / 362880.0; p = p * r + 1.0 / 40320.0; p = p * r + 1.0 / 5040.0;
    p = p * r + 1.0 / 720.0; p = p * r + 1.0 / 120.0; p = p * r + 1.0 / 24.0; p = p * r + 1.0 / 6.0; p = p * r + 0.5; p = p * r + 1.0; p = p * r + 1.0;
    const long long ki = (long long)k;
    const double sc = __builtin_bit_cast(double, (unsigned long long)((ki + 1023) << 52));
    return p * sc;
}

struct Args { const float* in[23]; float* out; unsigned char* ws; int ph_lo, ph_hi; };
enum { I_X = 0, I_C, I_CTX, I_CCTX, I_ADAW, I_ADAB, I_NPRE, I_NPOST, I_AWIN, I_AWOUT, I_ALAM, I_ASUB, I_SWIN, I_SARE, I_SAIM, I_SLDT, I_SBRE, I_SBIM, I_SCRE, I_SCIM, I_SD, I_SWGLU, I_SWOUT };

template <bool QKPERM>
__device__ __forceinline__ void transpose_item(const float* W, int K, int N, bf16* WT, LAS float* scr, int item, int lane, int row_sub = 0) {
    const int nblk = N / 32, kb = item / nblk, nb = item % nblk, k0 = 64 * kb, n0 = 32 * nb;
#pragma unroll 8
    for (int i = 0; i < 32; ++i) { const int kk = 2 * i + (lane >> 5); scr[kk * 33 + (lane & 31)] = __builtin_nontemporal_load(W + (size_t)(k0 + kk) * N + n0 + (lane & 31)); }
    LDS_WAIT(); asm volatile("" ::: "memory");
    const int c = lane & 7;
#pragma unroll
    for (int j = 0; j < 4; ++j) { const int n = (lane >> 3) + 8 * j; const LAS float* s = scr + (8 * c) * 33 + n;
        v4u o; o.x = pk2(s[0 * 33], s[1 * 33]); o.y = pk2(s[2 * 33], s[3 * 33]); o.z = pk2(s[4 * 33], s[5 * 33]); o.w = pk2(s[6 * 33], s[7 * 33]);
        int nn = n0 + n;
        if (QKPERM && nn < 8192) { const int d = nn & 127, a = d >> 6, jj = (d >> 5) & 1, f = d & 31; nn = (nn & ~127) + 2 * (a * 32 + f) + jj; }
        *(GAS v4u*)(WT + pg8::blk_off(nn - row_sub, k0 + 8 * c)) = o; }
    LDS_WAIT(); asm volatile("" ::: "memory");
}

#define GEMV_ITEM(item) do { \
                const int layer = item / 384, rem = item % 384, ks = rem / 24, cs = rem % 24, k0 = ks * 256, n0 = cs * 512; \
                for (int e = tid; e < 1280; e += NWAVES * 64) { const int r = e >> 8, kk = e & 255; const float v = (r < 4) ? cvec[r * 4096 + k0 + kk] : cctx[k0 + kk]; sv[e] = v * pg8::sigmoidf_fast(v); } \
                __syncthreads(); \
                const int cg = tid & 127, sub = tid >> 7; \
                const float* wp = args.in[I_ADAW] + ((size_t)layer * 4096 + k0 + sub * 64) * 12288 + n0 + cg * 4; \
                f32x4 acc[5]; \
_Pragma("unroll") \
                for (int r = 0; r < 5; ++r) acc[r] = (f32x4){0.f, 0.f, 0.f, 0.f}; \
                for (int i = 0; i < 64; i += 8) { \
                    f32x4 w[8]; \
_Pragma("unroll") \
                    for (int q = 0; q < 8; ++q) w[q] = __builtin_nontemporal_load((const GAS f32x4*)(wp + (size_t)(i + q) * 12288)); \
_Pragma("unroll") \
                    for (int q = 0; q < 8; ++q) \
_Pragma("unroll") \
                        for (int r = 0; r < 5; ++r) acc[r] += w[q] * sv[r * 256 + sub * 64 + i + q]; \
                } \
_Pragma("unroll") \
                for (int r = 0; r < 5; ++r) red[(sub * 128 + cg) * 5 + r] = acc[r]; \
                __syncthreads(); \
                float* part = PARTM + ((size_t)((layer * 24 + cs) * 16 + ks)) * 2560; \
                for (int e = tid; e < 640; e += NWAVES * 64) { const int cg2 = e / 5, r = e % 5; \
                    const f32x4 sm = red[(0 * 128 + cg2) * 5 + r] + red[(1 * 128 + cg2) * 5 + r] + red[(2 * 128 + cg2) * 5 + r] + red[(3 * 128 + cg2) * 5 + r]; \
                    float* pp = part + r * 512 + cg2 * 4; \
                    __hip_atomic_store(pp + 0, sm.x, __ATOMIC_RELAXED, __HIP_MEMORY_SCOPE_AGENT); __hip_atomic_store(pp + 1, sm.y, __ATOMIC_RELAXED, __HIP_MEMORY_SCOPE_AGENT); \
                    __hip_atomic_store(pp + 2, sm.z, __ATOMIC_RELAXED, __HIP_MEMORY_SCOPE_AGENT); __hip_atomic_store(pp + 3, sm.w, __ATOMIC_RELAXED, __HIP_MEMORY_SCOPE_AGENT); } \
                asm volatile("s_waitcnt vmcnt(0)" ::: "memory"); \
                __syncthreads(); \
                if (tid == 0) MISC[16] = __hip_atomic_fetch_add((unsigned*)(ctl + CW_MODT + 64 * (layer * 24 + cs)), 1u, __ATOMIC_RELAXED, __HIP_MEMORY_SCOPE_AGENT); \
                __syncthreads(); \
                if (MISC[16] == 15u) { \
                    __builtin_amdgcn_fence(__ATOMIC_ACQUIRE, "agent"); \
                    const float* pb = PARTM + ((size_t)((layer * 24 + cs) * 16)) * 2560; \
                    for (int e = tid; e < 2560; e += NWAVES * 64) { const int r = e >> 9, cn = e & 511; float sm = args.in[I_ADAB][layer * 12288 + n0 + cn]; \
_Pragma("unroll") \
                        for (int k = 0; k < 16; ++k) sm += __hip_atomic_load(pb + (size_t)k * 2560 + e, __ATOMIC_RELAXED, __HIP_MEMORY_SCOPE_AGENT); \
                        MOD[((size_t)layer * 5 + r) * 12288 + n0 + cn] = sm; } \
                } \
                __syncthreads(); \
            } while (0)

__device__ __forceinline__ float wave_max(float v) {
#pragma unroll
    for (int o = 1; o < 64; o <<= 1) v = fmaxf(v, __shfl_xor(v, o));
    return v;
}
__device__ __forceinline__ int qkperm_col(int nn) { if (nn < 8192) { const int d = nn & 127, a = d >> 6, jj = (d >> 5) & 1, f = d & 31; nn = (nn & ~127) + 2 * (a * 32 + f) + jj; } return nn; }
template <bool PERM>
__device__ __forceinline__ void colmax_item(const float* W, int N, unsigned* colmax, int item, int lane) {
    const int nblk = N / 32, kb = item / nblk, nb = item % nblk, k0 = 64 * kb, n0 = 32 * nb; float m = 0.f;
#pragma unroll 8
    for (int i = 0; i < 32; ++i) m = fmaxf(m, __builtin_fabsf(__builtin_nontemporal_load(W + (size_t)(k0 + 2 * i + (lane >> 5)) * N + n0 + (lane & 31))));
    m = fmaxf(m, __shfl_xor(m, 32));
    if (lane < 32) (void)__hip_atomic_fetch_max(colmax + (PERM ? qkperm_col(n0 + lane) : n0 + lane), __float_as_uint(m), __ATOMIC_RELAXED, __HIP_MEMORY_SCOPE_AGENT);
}
__device__ __forceinline__ unsigned q8pack(float a, float b, float c, float d) {
    const int ia = (int)__builtin_rintf(a), ib = (int)__builtin_rintf(b), ic = (int)__builtin_rintf(c), id = (int)__builtin_rintf(d);
    return (unsigned)(ia & 255) | ((unsigned)(ib & 255) << 8) | ((unsigned)(ic & 255) << 16) | ((unsigned)id << 24);
}
template <bool PERM>
__device__ __forceinline__ void quant_item(const float* W, int N, const unsigned* colmax, unsigned char* WQ, float* CS, LAS float* scr, int item, int lane) {
    const int nblk = N / 32, kb = item / nblk, nb = item % nblk, k0 = 64 * kb, n0 = 32 * nb;
#pragma unroll 8
    for (int i = 0; i < 32; ++i) { const int kk = 2 * i + (lane >> 5); scr[kk * 33 + (lane & 31)] = __builtin_nontemporal_load(W + (size_t)(k0 + kk) * N + n0 + (lane & 31)); }
    LDS_WAIT(); asm volatile("" ::: "memory");
    const int c = lane & 7;
#pragma unroll
    for (int j = 0; j < 4; ++j) { const int n = (lane >> 3) + 8 * j, nn = PERM ? qkperm_col(n0 + n) : n0 + n; const LAS float* sp = scr + (8 * c) * 33 + n;
        const float cm = __uint_as_float(colmax[nn]), inv = cm > 0.f ? 127.f / cm : 0.f;
        v2u o; o.x = q8pack(sp[0 * 33] * inv, sp[1 * 33] * inv, sp[2 * 33] * inv, sp[3 * 33] * inv); o.y = q8pack(sp[4 * 33] * inv, sp[5 * 33] * inv, sp[6 * 33] * inv, sp[7 * 33] * inv);
        *(GAS v2u*)(WQ + pg8::blk8_off(nn, k0 + 8 * c)) = o;
        if (kb == 0 && c == 0) CS[nn] = cm * (1.f / 127.f); }
    LDS_WAIT(); asm volatile("" ::: "memory");
}

__global__ void __launch_bounds__(NWAVES * 64, 2) fwd_kernel(Args args) {
    extern __shared__ __attribute__((aligned(16))) unsigned char lds[];
    LAS unsigned char* L = (LAS unsigned char*)lds;
    volatile LAS unsigned* MISC = (volatile LAS unsigned*)(L + MISC_OFF);
    const int tid = threadIdx.x, lane = tid & 63, wave = __builtin_amdgcn_readfirstlane(tid >> 6);
    const int G = gridDim.x; const int bx = blockIdx.x; const int vcu = (G % 8 == 0) ? (bx % 8) * (G / 8) + bx / 8 : bx;
    const int gw = vcu * NWAVES + wave, NGW = G * NWAVES;
    unsigned char* ws = args.ws;
    gu32* ctl = (gu32*)(ws + WS_CTL);
    for (int u = tid; u < (LDS_BYTES - LDSCTL_OFF) / 4; u += NWAVES * 64) ((LAS unsigned*)(L + LDSCTL_OFF))[u] = 0u;
    __syncthreads();
    XcdBarrier bar; bar.bar = (unsigned*)(ctl + CW_BAR); bar.x = 0; bar.st = nullptr;
    if (!MK_PER_PHASE) bar = xcd_barrier_post((unsigned*)(ctl + CW_BAR), MISC + 8);
    const int lo = args.ph_lo, hi = args.ph_hi;
#define IN(k) (lo <= (k) && (k) < hi)
#define SEAM(k) do { if (IN(k) && IN((k) + 1)) xcd_barrier(bar); } while (0)

    int n8;
    { const float* lv_ = args.in[I_ALAM];
      const float d01_ = wave_sum(lv_[lane] * lv_[128 + lane] + lv_[64 + lane] * lv_[192 + lane]), d23_ = wave_sum(lv_[256 + lane] * lv_[384 + lane] + lv_[320 + lane] * lv_[448 + lane]);
      const float lam_ = __expf(d01_) - __expf(d23_) + 0.2f; n8 = __builtin_amdgcn_readfirstlane((lam_ <= LAM_ALL8) ? 64 : (lam_ <= LAM_SAFE) ? 48 + G8T : 32); }
    const int qb8 = n8 * 8;
    const float* x = args.in[I_X]; const float* cvec = args.in[I_C]; const float* ctx = args.in[I_CTX]; const float* cctx = args.in[I_CCTX];
    float* RS = (float*)(ws + WS_RS); float* CS = (float*)(ws + WS_CS); unsigned* COLMAX = (unsigned*)(ws + WS_CTL + CTL_COLMAX);
    unsigned char* HQ = ws + WS_OB; unsigned char* WQ8 = ws + WS_WIN0; bf16* WG0 = (bf16*)(ws + WS_WIN0 + 64 * MiB);
    float* CS2 = (float*)(ws + WS_CS2); unsigned* COLMAX2 = (unsigned*)(ws + WS_CTL + CTL_COLMAX2); unsigned* TOKMAX = (unsigned*)(ws + WS_CTL + CTL_TOKMAX);
    unsigned char* WGLU8 = ws + WS_WGLU; unsigned char* A8 = ws + WS_P;
    unsigned char* K8 = ws + WS_H; float* KSC = (float*)(ws + WS_H + 72 * MiB);
    bf16* X1B = (bf16*)(ws + WS_WIN0);
    float* MOD = (float*)(ws + WS_MOD); float* PARTM = (float*)(ws + WS_PARTM); float* ROPE = (float*)(ws + WS_ROPE); float* A16 = (float*)(ws + WS_A16);
    bf16* Win0 = (bf16*)(ws + WS_WIN0); bf16* Wout0 = (bf16*)(ws + WS_WOUT0); bf16* W5in = (bf16*)(ws + WS_W5IN); bf16* Wglu = (bf16*)(ws + WS_WGLU); bf16* W5out = (bf16*)(ws + WS_W5OUT);
    bf16* Etab = (bf16*)(ws + WS_E); bf16* W2tab = (bf16*)(ws + WS_W2);
    bf16* Hb = (bf16*)(ws + WS_H); bf16* OB = (bf16*)(ws + WS_OB); bf16* QH = (bf16*)(ws + WS_QH); bf16* KH = (bf16*)(ws + WS_KH); bf16* VH = (bf16*)(ws + WS_VH); bf16* GT = (bf16*)(ws + WS_GT);
    bf16* AO = (bf16*)(ws + WS_AO); bf16* OUT0 = (bf16*)(ws + WS_OUT0); bf16* XS = (bf16*)(ws + WS_XS); bf16* SZ = (bf16*)(ws + WS_SZ);
    bf16* HLOC = (bf16*)(ws + WS_HLOC); bf16* YG = (bf16*)(ws + WS_YG); bf16* Y2 = (bf16*)(ws + WS_Y2); bf16* OUT1 = (bf16*)(ws + WS_OUT1);

    if (IN(0)) {
        {
            LAS float* sv = (LAS float*)L;
            LAS f32x4* red = (LAS f32x4*)(L + 8192);
            for (int item = vcu; item < 384; item += G) GEMV_ITEM(item);
        }
        __syncthreads();
        if (vcu == 0) for (int e = tid; e < 2048; e += 512) { const int pos = e >> 5, f = e & 31; const double invf = exp_d(-(double)f * (9.210340371976184 / 32.0)); double sn, cs; sincos_d((double)pos * invf, sn, cs);
            *(GAS f32x2*)(ROPE + e * 2) = (f32x2){(float)cs, (float)sn}; }
        __syncthreads();
        {
            LAS float* scr = (LAS float*)(L + RING_OFF + wave * 16384);
            constexpr int I_0 = 64 * 512, I_1 = 0, I_2 = 0, I_3 = 0, I_4 = 0;
            constexpr int NITEMS = I_0 + I_1 + I_2 + I_3 + I_4;
            for (int it = gw; it < NITEMS; it += NGW) {
                int r = it;
                if (r < I_0) { if ((r % 512) < qb8) colmax_item<true>(args.in[I_AWIN], 16384, COLMAX, r, lane);
                               else transpose_item<false>(args.in[I_AWIN], 4096, 16384, WG0, scr, r, lane, 8192);
                               continue; } r -= I_0;
                if (r < I_1) { transpose_item<false>(args.in[I_AWOUT], 4096, 4096, Wout0, scr, r, lane); continue; } r -= I_1;
                if (r < I_2) { transpose_item<false>(args.in[I_SWIN], 4096, 8192, W5in, scr, r, lane); continue; } r -= I_2;
                if (r < I_3) { colmax_item<false>(args.in[I_SWGLU], 4096, COLMAX2, r, lane); continue; } r -= I_3;
                (void)r;
            }
        }
        __syncthreads();
        __syncthreads();
    }
    SEAM(0);

    if (IN(1)) {
        const float* npre = args.in[I_NPRE];
        const int wgb = G >> 2, bq = (wgb > 0) ? vcu / wgb : 4, wl = (wgb > 0) ? vcu % wgb : 0;
        LAS f32x4* Va = (LAS f32x4*)L; LAS f32x4* Vs = Va + 1024;
#define P1_LOADVEC(mb) do { const float* shift_ = MOD + (size_t)(mb) * 12288; const float* scale_ = shift_ + 4096; \
            for (int q = tid; q < 1024; q += NWAVES * 64) { Va[q] = ((const GAS f32x4*)npre)[q] * (((const GAS f32x4*)scale_)[q] + 1.f); Vs[q] = ((const GAS f32x4*)shift_)[q]; } } while (0)
#define P1_ROW(row, xr) do { \
            unsigned vbase = (unsigned)lane * 16u; asm volatile("" : "+v"(vbase)); \
            const LAS f32x4* Va_ = (const LAS f32x4*)(L + vbase); const LAS f32x4* Vs_ = Va_ + 1024; \
            f32x4 v[16]; float ss = 0.f; \
            _Pragma("unroll") for (int j = 0; j < 16; ++j) { v[j] = __builtin_nontemporal_load((const GAS f32x4*)(xr) + lane + 64 * j); ss += (v[j].x * v[j].x + v[j].y * v[j].y) + (v[j].z * v[j].z + v[j].w * v[j].w); } \
            const float rstd = __builtin_amdgcn_rsqf(wave_sum(ss) * (1.f / DM) + EPS); float mx = 0.f; \
            _Pragma("unroll") for (int j = 0; j < 16; ++j) { v[j] = v[j] * rstd * Va_[64 * j] + Vs_[64 * j]; \
                mx = fmaxf(fmaxf(mx, fmaxf(__builtin_fabsf(v[j].x), __builtin_fabsf(v[j].y))), fmaxf(__builtin_fabsf(v[j].z), __builtin_fabsf(v[j].w))); if ((j & 3) == 3) __builtin_amdgcn_sched_barrier(0); } \
            mx = wave_max(mx); const float inv = mx > 0.f ? 127.f / mx : 0.f; if (lane == 0) RS[(row)] = mx * (1.f / 127.f); \
            _Pragma("unroll") for (int j = 0; j < 16; ++j) { *(GAS v2u*)(Hb + pg8::blk_off((row), 4 * (lane + 64 * j))) = (v2u){pk2(v[j].x, v[j].y), pk2(v[j].z, v[j].w)}; \
                *(GAS unsigned*)(HQ + pg8::blk8_off((row), 4 * (lane + 64 * j))) = q8pack(v[j].x * inv, v[j].y * inv, v[j].z * inv, v[j].w * inv); } } while (0)
        if (bq < 4) P1_LOADVEC(bq);
        __syncthreads();
        if (bq < 4) for (int r = wl * NWAVES + wave; r < SEQL; r += wgb * NWAVES) { const int row = bq * SEQL + r; P1_ROW(row, x + (size_t)row * DM); }
        __syncthreads();
        P1_LOADVEC(4);
        __syncthreads();
        for (int row = MLAT + gw; row < MTOT; row += NGW) P1_ROW(row, ctx + (size_t)(row - MLAT) * DM);
        __syncthreads();
        { LAS float* scr = (LAS float*)(L + RING_OFF + wave * 16384);
          for (int it = gw; it < 64 * 512; it += NGW) if ((it % 512) < qb8) quant_item<true>(args.in[I_AWIN], 16384, COLMAX, WQ8, CS, scr, it, lane);
        }
        __syncthreads();
#undef P1_ROW
#undef P1_LOADVEC
    }
    SEAM(1);

    if (IN(2)) {
        { pg8::Gemm g{(const pg8::bf16_t*)HQ, (const pg8::bf16_t*)WQ8, 2048, 128u, 32u, 32768u, 1048576u, 128u, 32768u, 1048576u}; pg8::StaticOrder S; S.init(68, n8, G, bx);
          pg8::EpiRope8 E{QH, KH, VH, GT, ROPE, RS, CS};
          pg8::gemm_phase<pg8::EpiRope8, pg8::StaticOrder, PG8_ALIGN, PG8_SP2, true>(L + RING_OFF, g, S, E); }
        { pg8::Gemm g{Hb, WG0 + (size_t)(n8 - 32) * 1048576, 4096, 128u, 32u, 32768u, 2097152u, 128u, 32768u, 2097152u}; pg8::StaticOrder S; S.init(68, 64 - n8, G, G - 1 - bx);
          pg8::EpiRope E{QH, KH, VH, GT, ROPE, n8};
          pg8::gemm_phase<pg8::EpiRope, pg8::StaticOrder, PG8_ALIGN, PG8_SP2>(L + RING_OFF, g, S, E); }
        { const bool reg = (G == 256); const int ntw = reg ? 64 : G, ncw0 = reg ? 64 : 0, ncw = reg ? 160 : G;
          if (bx < ntw) {
        for (int g = 192 + bx; g < 256; g += ntw) {
            LAS f32x2* pw = (LAS f32x2*)L;
            LAS f32x2* Bb = (LAS f32x2*)(L + 17408);
            LAS f32x2* Cc = (LAS f32x2*)(L + 17408 + 16384);
            LAS float* Kt = (LAS float*)(L + 17408 + 32768);
            LAS f32x2* fz = (LAS f32x2*)(L + 17408 + 65536);
            if (tid < 128) {
                const int d = tid >> 6, p = tid & 63; const int gi = (d * 256 + g) * 64 + p;
                const double dt = exp_d((double)args.in[I_SLDT][d * 256 + g]);
                const double Ar = (double)args.in[I_SARE][gi], Ai = (double)args.in[I_SAIM][gi];
                const double mag = exp_d(Ar * dt); double sn, cs; sincos_d(Ai * dt, sn, cs);
                const double ar = mag * cs, ai = mag * sn;
                const double den = Ar * Ar + Ai * Ai;
                const double fr_ = ((ar - 1.0) * Ar + ai * Ai) / den, fi_ = (ai * Ar - (ar - 1.0) * Ai) / den;
                fz[d * 64 + p] = (f32x2){(float)fr_, (float)fi_};
                double pr = 1.0, pi = 0.0;
                for (int n = 0; n <= 16; ++n) { pw[(d * 17 + n) * 64 + p] = (f32x2){(float)pr, (float)pi}; const double t = pr * ar - pi * ai; pi = pr * ai + pi * ar; pr = t; }
                *(GAS f32x2*)(A16 + (size_t)gi * 2) = pw[(d * 17 + 16) * 64 + p];
            }
            __syncthreads();
            for (int e = tid; e < 2048; e += 512) {
                { const int d = e >> 10, p = (e >> 4) & 63, c = e & 15; const size_t gi = ((size_t)(d * 256 + g) * 64 + p) * 16 + c;
                  const float br = args.in[I_SBRE][gi], bi = args.in[I_SBIM][gi]; const f32x2 f = fz[d * 64 + p];
                  Bb[e] = (f32x2){f.x * br - f.y * bi, f.x * bi + f.y * br}; }
                { const int d = e >> 10, c = (e >> 6) & 15, p = e & 63; const size_t gi = ((size_t)(d * 256 + g) * 16 + c) * 64 + p;
                  Cc[e] = (f32x2){args.in[I_SCRE][gi], args.in[I_SCIM][gi]}; }
            }
            __syncthreads();
            {
                const int cp = tid & 15, c = (tid >> 4) & 15, d = tid >> 8; float kacc[16];
#pragma unroll
                for (int t = 0; t < 16; ++t) kacc[t] = 0.f;
                for (int p = 0; p < 64; ++p) { const f32x2 cc = Cc[(d * 16 + c) * 64 + p], bb = Bb[(d * 64 + p) * 16 + cp];
                    const float tr = cc.x * bb.x - cc.y * bb.y, ti = cc.x * bb.y + cc.y * bb.x;
#pragma unroll
                    for (int t = 0; t < 16; ++t) { const f32x2 aa = pw[(d * 17 + t) * 64 + p]; kacc[t] += tr * aa.x - ti * aa.y; } }
#pragma unroll
                for (int t = 0; t < 16; ++t) Kt[((d * 16 + t) * 16 + c) * 16 + cp] = kacc[t];
            }
            __syncthreads();
            const float* Dk = args.in[I_SD] + g * 16;
            for (int e = tid; e < 16384; e += 512) {
                const int ch = e & 63, n = e >> 6, t = n >> 4, c = n & 15; float v[8];
                if (ch < 32) { const int sI = ch >> 1, c0 = (ch & 1) * 8;
#pragma unroll
                    for (int i = 0; i < 8; ++i) v[i] = 0.f;
                    if (sI <= t) { const LAS f32x4* kp = (const LAS f32x4*)(Kt + ((0 * 16 + (t - sI)) * 16 + c) * 16 + c0); const f32x4 a0 = kp[0], a1 = kp[1];
                        v[0] += a0.x; v[1] += a0.y; v[2] += a0.z; v[3] += a0.w; v[4] += a1.x; v[5] += a1.y; v[6] += a1.z; v[7] += a1.w; }
                    if (sI >= t) { const LAS f32x4* kp = (const LAS f32x4*)(Kt + ((1 * 16 + (sI - t)) * 16 + c) * 16 + c0); const f32x4 a0 = kp[0], a1 = kp[1];
                        v[0] += a0.x; v[1] += a0.y; v[2] += a0.z; v[3] += a0.w; v[4] += a1.x; v[5] += a1.y; v[6] += a1.z; v[7] += a1.w; }
                    if (sI == t && (c >> 3) == (ch & 1)) { const float dk = Dk[c];
#pragma unroll
                        for (int i = 0; i < 8; ++i) v[i] += ((c & 7) == i) ? dk : 0.f; }
                } else { const int kk = (ch - 32) * 8, d = kk >> 7, p0 = (kk & 127) >> 1, pwn = d == 0 ? t + 1 : 16 - t;
#pragma unroll
                    for (int i = 0; i < 4; ++i) { const f32x2 cc = Cc[(d * 16 + c) * 64 + p0 + i], aa = pw[(d * 17 + pwn) * 64 + p0 + i]; v[2 * i] = cc.x * aa.x - cc.y * aa.y; v[2 * i + 1] = -(cc.x * aa.y + cc.y * aa.x); } }
                *(GAS v4u*)(W2tab + ((size_t)g * 256 + n) * 512 + 8 * ch) = (v4u){pk2(v[0], v[1]), pk2(v[2], v[3]), pk2(v[4], v[5]), pk2(v[6], v[7])};
            }
            for (int e = tid; e < 8192; e += 512) {
                const int ch = e & 31, n = e >> 5, d = n >> 7, p = (n & 127) >> 1, ri = n & 1, sI = ch >> 1, c0 = (ch & 1) * 8, pwn = d == 0 ? 15 - sI : sI;
                const f32x2 aa = pw[(d * 17 + pwn) * 64 + p]; float v[8];
#pragma unroll
                for (int i = 0; i < 8; ++i) { const f32x2 b = Bb[(d * 64 + p) * 16 + c0 + i]; v[i] = ri ? (aa.x * b.y + aa.y * b.x) : (aa.x * b.x - aa.y * b.y); }
                *(GAS v4u*)(Etab + ((size_t)g * 256 + n) * 256 + 8 * ch) = (v4u){pk2(v[0], v[1]), pk2(v[2], v[3]), pk2(v[4], v[5]), pk2(v[6], v[7])};
            }
            __syncthreads();
        }
          }
          if (bx >= ncw0 && bx < ncw0 + ncw) { LAS float* scr = (LAS float*)(L + RING_OFF + wave * 16384);
              for (int it = (bx - ncw0) * NWAVES + wave; it < 2 * 64 * 128; it += ncw * NWAVES) {
                  if (it < 64 * 128) transpose_item<false>(args.in[I_AWOUT], 4096, 4096, Wout0, scr, it, lane);
                  else colmax_item<false>(args.in[I_SWGLU], 4096, COLMAX2, it - 64 * 128, lane); } } }
    }
    SEAM(2);

    if (IN(3)) {
        { constexpr int NBLK = 32 * 17408 / 32; const int nsw = G * NWAVES;
          for (int blk = bx * NWAVES + wave; blk < NBLK; blk += nsw) {
              v4u kv[8]; const size_t r0 = (size_t)blk * 32 + (lane >> 4);
#pragma unroll
              for (int u = 0; u < 8; ++u) kv[u] = __builtin_nontemporal_load((const v4u*)(KH + (r0 + 4 * u) * 128 + (lane & 15) * 8));
              float m = 0.f;
#pragma unroll
              for (int u = 0; u < 8; ++u) { m = fmaxf(m, fmaxf(fmaxf(__builtin_fabsf(pg8::bflo(kv[u].x)), __builtin_fabsf(pg8::bfhi(kv[u].x))), fmaxf(__builtin_fabsf(pg8::bflo(kv[u].y)), __builtin_fabsf(pg8::bfhi(kv[u].y)))));
                                            m = fmaxf(m, fmaxf(fmaxf(__builtin_fabsf(pg8::bflo(kv[u].z)), __builtin_fabsf(pg8::bfhi(kv[u].z))), fmaxf(__builtin_fabsf(pg8::bflo(kv[u].w)), __builtin_fabsf(pg8::bfhi(kv[u].w))))); }
              m = fmaxf(m, __shfl_xor(m, 1)); m = fmaxf(m, __shfl_xor(m, 2)); m = fmaxf(m, __shfl_xor(m, 4)); m = fmaxf(m, __shfl_xor(m, 8)); m = fmaxf(m, __shfl_xor(m, 16)); m = fmaxf(m, __shfl_xor(m, 32));
              const float inv = m > 0.f ? 127.f / m : 0.f;
#pragma unroll
              for (int u = 0; u < 8; ++u) { v2u o; o.x = q8pack(pg8::bflo(kv[u].x) * inv, pg8::bfhi(kv[u].x) * inv, pg8::bflo(kv[u].y) * inv, pg8::bfhi(kv[u].y) * inv); o.y = q8pack(pg8::bflo(kv[u].z) * inv, pg8::bfhi(kv[u].z) * inv, pg8::bflo(kv[u].w) * inv, pg8::bfhi(kv[u].w) * inv);
                  *(GAS v2u*)(K8 + (r0 + 4 * u) * 128 + (lane & 15) * 8) = o; }
              if (lane == 0) KSC[blk] = m * (1.f / 127.f); } }
        xcd_barrier(bar);
        float* sml = (float*)((char*)lds + ATT_SML_OFF);
        for (int i = 0;; ++i) {
            const long Lu = (long)i * G + bx; if (Lu >= 2176) break;
            int b, h, n, qrow0, seq;
            if (Lu < 2048) { const int xcd = (int)(Lu & 7), k = (int)(Lu >> 3), bh = xcd * 8 + (k >> 5), r = k & 31; b = bh >> 4; h = bh & 15; n = r >> 4; qrow0 = b * 4096 + (r & 15) * 256; seq = 4352; }
            else { const int e = (int)Lu - 2048; b = e >> 5; h = (e >> 1) & 15; n = e & 1; qrow0 = MLAT + b * 256; seq = 256; }
            const size_t hm = (size_t)(h * 2 + n) * 17408, qk0 = hm * 128, v0 = (size_t)h * 17408 * 256; const size_t crow = MLAT + b * 256, lrow = b * 4096;
            att2::attn_unit256q(QH + qk0 + (size_t)qrow0 * 128, K8 + (hm + crow) * 128, K8 + (hm + lrow) * 128, KSC + (hm + crow) / 32, KSC + (hm + lrow) / 32, VH + v0 + crow * 256, VH + v0 + lrow * 256,
                                OB + (size_t)qrow0 * 8192 + n * 4096 + h * 256, seq, (char*)lds + RING_OFF, sml);
        }
        __syncthreads();
    }
    SEAM(3);

    if (IN(4)) {
        const float* lv = args.in[I_ALAM]; const float* sub = args.in[I_ASUB];
        const float d01 = wave_sum(lv[lane] * lv[128 + lane] + lv[64 + lane] * lv[192 + lane]);
        const float d23 = wave_sum(lv[256 + lane] * lv[384 + lane] + lv[320 + lane] * lv[448 + lane]);
        const float lam = __expf(d01) - __expf(d23) + 0.2f;
        const int hl = lane >> 5, cl = (lane & 31) * 8;
        f32x4 sg0 = *(const GAS f32x4*)(sub + cl), sg1 = *(const GAS f32x4*)(sub + cl + 4);
        sg0 = sg0 * 0.8f; sg1 = sg1 * 0.8f;
        for (int row = gw; row < MTOT; row += NGW) {
            const bf16* o0p = OB + (size_t)row * 8192; const bf16* gp = GT + (size_t)row * DM;
            v4u av[8], bv[8], gv[8];
#pragma unroll
            for (int j = 0; j < 8; ++j) { const int col = (2 * j + hl) * 256 + cl;
                av[j] = __builtin_nontemporal_load((const GAS v4u*)(o0p + col)); bv[j] = __builtin_nontemporal_load((const GAS v4u*)(o0p + 4096 + col)); gv[j] = __builtin_nontemporal_load((const GAS v4u*)(gp + col)); }
#pragma unroll
            for (int j = 0; j < 8; ++j) { const int col = (2 * j + hl) * 256 + cl; const v4u a = av[j], b = bv[j], gt = gv[j];
                float o[8];
                o[0] = pg8::bflo(a.x) - lam * pg8::bflo(b.x); o[1] = pg8::bfhi(a.x) - lam * pg8::bfhi(b.x); o[2] = pg8::bflo(a.y) - lam * pg8::bflo(b.y); o[3] = pg8::bfhi(a.y) - lam * pg8::bfhi(b.y);
                o[4] = pg8::bflo(a.z) - lam * pg8::bflo(b.z); o[5] = pg8::bfhi(a.z) - lam * pg8::bfhi(b.z); o[6] = pg8::bflo(a.w) - lam * pg8::bflo(b.w); o[7] = pg8::bfhi(a.w) - lam * pg8::bfhi(b.w);
                float ss = 0.f;
#pragma unroll
                for (int e = 0; e < 8; ++e) ss += o[e] * o[e];
                const float rstd = __builtin_amdgcn_rsqf(half_sum(ss) * (1.f / 256.f) + EPS);
                float gg[8] = {pg8::bflo(gt.x), pg8::bfhi(gt.x), pg8::bflo(gt.y), pg8::bfhi(gt.y), pg8::bflo(gt.z), pg8::bfhi(gt.z), pg8::bflo(gt.w), pg8::bfhi(gt.w)};
#pragma unroll
                for (int e = 0; e < 8; ++e) o[e] = o[e] * rstd * (e < 4 ? sg0[e] : sg1[e - 4]) * (gg[e] * pg8::sigmoidf_fast(gg[e]));
                *(GAS v4u*)(AO + pg8::blk_off(row, col)) = (v4u){pk2(o[0], o[1]), pk2(o[2], o[3]), pk2(o[4], o[5]), pk2(o[6], o[7])}; }
        }
    }
    SEAM(4);

    if (IN(5)) {
        pg8::Gemm g{AO, Wout0, 4096, 128u, 32u, 32768u, 2097152u, 128u, 32768u, 2097152u}; pg8::StaticOrder S; S.init(68, 16, G, bx);
        pg8::EpiStore E{OUT0, 4096, 1};
        pg8::gemm_phase<pg8::EpiStore, pg8::StaticOrder, PG8_ALIGN, PG8_SP2>(L + RING_OFF, g, S, E);
        const int first_free = (G > 64) ? 64 : 0, nfree = G - first_free;
        if (bx >= first_free) {
            LAS float* sv = (LAS float*)L; LAS f32x4* red = (LAS f32x4*)(L + 8192);
            for (int item = 384 + (bx - first_free); item < 768; item += nfree) GEMV_ITEM(item);
            __syncthreads();
            { LAS float* scr = (LAS float*)(L + RING_OFF + wave * 16384); const int nfw = nfree * NWAVES;
              for (int it = (bx - first_free) * NWAVES + wave; it < 64 * 256; it += nfw) transpose_item<false>(args.in[I_SWIN], 4096, 8192, W5in, scr, it, lane); }
        }
    }
    SEAM(5);

    if (IN(6)) {
        const float* npost = args.in[I_NPOST]; const float* npre1 = args.in[I_NPRE] + 4096;
        const int wgb = G >> 2, bq = (wgb > 0) ? vcu / wgb : 4, wl = (wgb > 0) ? vcu % wgb : 0;
        LAS f32x4* Vg = (LAS f32x4*)L; LAS f32x4* Va = Vg + 1024; LAS f32x4* Vs = Va + 1024;
#define P6_LOADVEC(mb) do { const float* gate0_ = MOD + (size_t)(mb) * 12288 + 8192; const float* shift1_ = MOD + (size_t)(5 + (mb)) * 12288; const float* scale1_ = shift1_ + 4096; \
            for (int q = tid; q < 1024; q += NWAVES * 64) { Vg[q] = ((const GAS f32x4*)gate0_)[q] * ((const GAS f32x4*)npost)[q]; Va[q] = ((const GAS f32x4*)npre1)[q] * (((const GAS f32x4*)scale1_)[q] + 1.f); Vs[q] = ((const GAS f32x4*)shift1_)[q]; } } while (0)
#define P6_ROW(row, xr, LAT) do { const bf16* op = OUT0 + (size_t)(row) * DM; \
            unsigned vbase = (unsigned)lane * 16u; asm volatile("" : "+v"(vbase)); \
            const LAS f32x4* Vg_ = (const LAS f32x4*)(L + vbase); const LAS f32x4* Va_ = Vg_ + 1024; const LAS f32x4* Vs_ = Va_ + 1024; \
            v2u ov[16]; float ss = 0.f; \
            _Pragma("unroll") for (int j = 0; j < 16; ++j) { ov[j] = ((const GAS v2u*)op)[lane + 64 * j]; const float a = pg8::bflo(ov[j].x), b = pg8::bfhi(ov[j].x), c = pg8::bflo(ov[j].y), d = pg8::bfhi(ov[j].y); ss += (a * a + b * b) + (c * c + d * d); } \
            f32x4 v[16]; \
            _Pragma("unroll") for (int j = 0; j < 16; ++j) v[j] = ((const GAS f32x4*)(xr))[lane + 64 * j]; \
            const float rstd0 = __builtin_amdgcn_rsqf(wave_sum(ss) * (1.f / DM) + EPS); float ss1 = 0.f; \
            _Pragma("unroll") for (int j = 0; j < 16; ++j) { const f32x4 o4 = {pg8::bflo(ov[j].x), pg8::bfhi(ov[j].x), pg8::bflo(ov[j].y), pg8::bfhi(ov[j].y)}; \
                v[j] = v[j] + Vg_[64 * j] * (o4 * rstd0); ss1 += (v[j].x * v[j].x + v[j].y * v[j].y) + (v[j].z * v[j].z + v[j].w * v[j].w); \
                if (LAT) ((GAS v2u*)(X1B + (size_t)(row) * DM))[lane + 64 * j] = (v2u){pk2(v[j].x, v[j].y), pk2(v[j].z, v[j].w)}; if ((j & 3) == 3) __builtin_amdgcn_sched_barrier(0); } \
            const float rstd1 = __builtin_amdgcn_rsqf(wave_sum(ss1) * (1.f / DM) + EPS); \
            _Pragma("unroll") for (int j = 0; j < 16; ++j) { const f32x4 h = v[j] * rstd1 * Va_[64 * j] + Vs_[64 * j]; *(GAS v2u*)(Hb + pg8::blk_off((row), 4 * (lane + 64 * j))) = (v2u){pk2(h.x, h.y), pk2(h.z, h.w)}; \
                if ((j & 3) == 3) __builtin_amdgcn_sched_barrier(0); } } while (0)
        if (bq < 4) P6_LOADVEC(bq);
        __syncthreads();
        if (bq < 4) for (int r = wl * NWAVES + wave; r < SEQL; r += wgb * NWAVES) { const int row = bq * SEQL + r; P6_ROW(row, x + (size_t)row * DM, true); }
        __syncthreads();
        P6_LOADVEC(4);
        __syncthreads();
        for (int row = MLAT + gw; row < MTOT; row += NGW) P6_ROW(row, ctx + (size_t)(row - MLAT) * DM, false);
        __syncthreads();
#undef P6_ROW
#undef P6_LOADVEC
    }
    SEAM(6);

    if (IN(7)) {
        pg8::Gemm g{Hb, W5in, 4096, 128u, 32u, 32768u, 2097152u, 128u, 32768u, 2097152u}; pg8::OrderP7 S{G, bx};
        pg8::EpiS5In E{XS, SZ};
        pg8::gemm_phase<pg8::EpiS5In, pg8::OrderP7, PG8_ALIGN, PG8_SP2>(L + RING_OFF, g, S, E);
        { const int first_free = (G > 64) ? 64 : 0, nfw = (G - first_free) * NWAVES;
          if (bx >= first_free) {
        for (int g = bx - first_free; g < ((G >= 128) ? 192 : 256); g += G - first_free) {
            LAS f32x2* pw = (LAS f32x2*)L;
            LAS f32x2* Bb = (LAS f32x2*)(L + 17408);
            LAS f32x2* Cc = (LAS f32x2*)(L + 17408 + 16384);
            LAS float* Kt = (LAS float*)(L + 17408 + 32768);
            LAS f32x2* fz = (LAS f32x2*)(L + 17408 + 65536);
            if (tid < 128) {
                const int d = tid >> 6, p = tid & 63; const int gi = (d * 256 + g) * 64 + p;
                const double dt = exp_d((double)args.in[I_SLDT][d * 256 + g]);
                const double Ar = (double)args.in[I_SARE][gi], Ai = (double)args.in[I_SAIM][gi];
                const double mag = exp_d(Ar * dt); double sn, cs; sincos_d(Ai * dt, sn, cs);
                const double ar = mag * cs, ai = mag * sn;
                const double den = Ar * Ar + Ai * Ai;
                const double fr_ = ((ar - 1.0) * Ar + ai * Ai) / den, fi_ = (ai * Ar - (ar - 1.0) * Ai) / den;
                fz[d * 64 + p] = (f32x2){(float)fr_, (float)fi_};
                double pr = 1.0, pi = 0.0;
                for (int n = 0; n <= 16; ++n) { pw[(d * 17 + n) * 64 + p] = (f32x2){(float)pr, (float)pi}; const double t = pr * ar - pi * ai; pi = pr * ai + pi * ar; pr = t; }
                *(GAS f32x2*)(A16 + (size_t)gi * 2) = pw[(d * 17 + 16) * 64 + p];
            }
            __syncthreads();
            for (int e = tid; e < 2048; e += 512) {
                { const int d = e >> 10, p = (e >> 4) & 63, c = e & 15; const size_t gi = ((size_t)(d * 256 + g) * 64 + p) * 16 + c;
                  const float br = args.in[I_SBRE][gi], bi = args.in[I_SBIM][gi]; const f32x2 f = fz[d * 64 + p];
                  Bb[e] = (f32x2){f.x * br - f.y * bi, f.x * bi + f.y * br}; }
                { const int d = e >> 10, c = (e >> 6) & 15, p = e & 63; const size_t gi = ((size_t)(d * 256 + g) * 16 + c) * 64 + p;
                  Cc[e] = (f32x2){args.in[I_SCRE][gi], args.in[I_SCIM][gi]}; }
            }
            __syncthreads();
            {
                const int cp = tid & 15, c = (tid >> 4) & 15, d = tid >> 8; float kacc[16];
#pragma unroll
                for (int t = 0; t < 16; ++t) kacc[t] = 0.f;
                for (int p = 0; p < 64; ++p) { const f32x2 cc = Cc[(d * 16 + c) * 64 + p], bb = Bb[(d * 64 + p) * 16 + cp];
                    const float tr = cc.x * bb.x - cc.y * bb.y, ti = cc.x * bb.y + cc.y * bb.x;
#pragma unroll
                    for (int t = 0; t < 16; ++t) { const f32x2 aa = pw[(d * 17 + t) * 64 + p]; kacc[t] += tr * aa.x - ti * aa.y; } }
#pragma unroll
                for (int t = 0; t < 16; ++t) Kt[((d * 16 + t) * 16 + c) * 16 + cp] = kacc[t];
            }
            __syncthreads();
            const float* Dk = args.in[I_SD] + g * 16;
            for (int e = tid; e < 16384; e += 512) {
                const int ch = e & 63, n = e >> 6, t = n >> 4, c = n & 15; float v[8];
                if (ch < 32) { const int sI = ch >> 1, c0 = (ch & 1) * 8;
#pragma unroll
                    for (int i = 0; i < 8; ++i) v[i] = 0.f;
                    if (sI <= t) { const LAS f32x4* kp = (const LAS f32x4*)(Kt + ((0 * 16 + (t - sI)) * 16 + c) * 16 + c0); const f32x4 a0 = kp[0], a1 = kp[1];
                        v[0] += a0.x; v[1] += a0.y; v[2] += a0.z; v[3] += a0.w; v[4] += a1.x; v[5] += a1.y; v[6] += a1.z; v[7] += a1.w; }
                    if (sI >= t) { const LAS f32x4* kp = (const LAS f32x4*)(Kt + ((1 * 16 + (sI - t)) * 16 + c) * 16 + c0); const f32x4 a0 = kp[0], a1 = kp[1];
                        v[0] += a0.x; v[1] += a0.y; v[2] += a0.z; v[3] += a0.w; v[4] += a1.x; v[5] += a1.y; v[6] += a1.z; v[7] += a1.w; }
                    if (sI == t && (c >> 3) == (ch & 1)) { const float dk = Dk[c];
#pragma unroll
                        for (int i = 0; i < 8; ++i) v[i] += ((c & 7) == i) ? dk : 0.f; }
                } else { const int kk = (ch - 32) * 8, d = kk >> 7, p0 = (kk & 127) >> 1, pwn = d == 0 ? t + 1 : 16 - t;
#pragma unroll
                    for (int i = 0; i < 4; ++i) { const f32x2 cc = Cc[(d * 16 + c) * 64 + p0 + i], aa = pw[(d * 17 + pwn) * 64 + p0 + i]; v[2 * i] = cc.x * aa.x - cc.y * aa.y; v[2 * i + 1] = -(cc.x * aa.y + cc.y * aa.x); } }
                *(GAS v4u*)(W2tab + ((size_t)g * 256 + n) * 512 + 8 * ch) = (v4u){pk2(v[0], v[1]), pk2(v[2], v[3]), pk2(v[4], v[5]), pk2(v[6], v[7])};
            }
            for (int e = tid; e < 8192; e += 512) {
                const int ch = e & 31, n = e >> 5, d = n >> 7, p = (n & 127) >> 1, ri = n & 1, sI = ch >> 1, c0 = (ch & 1) * 8, pwn = d == 0 ? 15 - sI : sI;
                const f32x2 aa = pw[(d * 17 + pwn) * 64 + p]; float v[8];
#pragma unroll
                for (int i = 0; i < 8; ++i) { const f32x2 b = Bb[(d * 64 + p) * 16 + c0 + i]; v[i] = ri ? (aa.x * b.y + aa.y * b.x) : (aa.x * b.x - aa.y * b.y); }
                *(GAS v4u*)(Etab + ((size_t)g * 256 + n) * 256 + 8 * ch) = (v4u){pk2(v[0], v[1]), pk2(v[2], v[3]), pk2(v[4], v[5]), pk2(v[6], v[7])};
            }
            __syncthreads();
        }
              LAS float* scr = (LAS float*)(L + RING_OFF + wave * 16384);
              for (int it = (bx - first_free) * NWAVES + wave; it < 2 * 64 * 128; it += nfw) {
                  if (it < 64 * 128) quant_item<false>(args.in[I_SWGLU], 4096, COLMAX2, WGLU8, CS2, scr, it, lane);
                  else transpose_item<false>(args.in[I_SWOUT], 4096, 4096, W5out, scr, it - 64 * 128, lane); } } }
    }
    SEAM(7);

    if (IN(8)) {
        { pg8::Gemm g{XS, Etab, 256, 1024u, 32u, 128u, 262144u, 512u, 128u, 131072u}; pg8::OrderGrp<5> S{G, vcu};
          pg8::EpiStore E{HLOC, 256, 0};
          pg8::gemm_phase<pg8::EpiStore, pg8::OrderGrp<5>, PG8_ALIGN, PG8_SP2>(L + RING_OFF, g, S, E); }
        asm volatile("s_waitcnt vmcnt(0)" ::: "memory"); __syncthreads();
        for (int g = vcu; g < 256; g += G) {
            const int d = wave & 1, b = wave >> 1, p = lane;
            const f32x2 a = *(const GAS f32x2*)(A16 + ((size_t)(d * 256 + g) * 64 + p) * 2);
            const bf16* hl = HLOC + (size_t)g * 1280 * 256 + d * 128 + 2 * p; bf16* xo = XS + (size_t)g * 1280 * 512 + 256 + d * 128 + 2 * p;
            float hr = 0.f, hi_ = 0.f;
            {   unsigned v[16];
#pragma unroll
                for (int j = 0; j < 16; ++j) { const int cj = d ? 15 - j : j; v[j] = *(const GAS unsigned*)(hl + (size_t)(1024 + b * 16 + cj) * 256); }
#pragma unroll
                for (int j = 0; j < 16; ++j) { const float tr = a.x * hr - a.y * hi_ + pg8::bflo(v[j]), ti = a.x * hi_ + a.y * hr + pg8::bfhi(v[j]); hr = tr; hi_ = ti; } }
            for (int j0 = 0; j0 < 256; j0 += 32) {
                unsigned v[32];
#pragma unroll
                for (int j = 0; j < 32; ++j) { const int cj = d ? 255 - (j0 + j) : (j0 + j); v[j] = *(const GAS unsigned*)(hl + (size_t)(b * 256 + cj) * 256); }
#pragma unroll
                for (int j = 0; j < 32; ++j) { const int cj = d ? 255 - (j0 + j) : (j0 + j);
                    *(GAS unsigned*)(xo + (size_t)(b * 256 + cj) * 512) = pk2(hr, hi_);
                    const float tr = a.x * hr - a.y * hi_ + pg8::bflo(v[j]), ti = a.x * hi_ + a.y * hr + pg8::bfhi(v[j]); hr = tr; hi_ = ti; }
            }
        }
        asm volatile("s_waitcnt vmcnt(0)" ::: "memory"); __syncthreads();
        { pg8::Gemm g{XS, W2tab, 512, 1024u, 32u, 128u, 262144u, 1024u, 128u, 262144u}; pg8::OrderGrp<4> S{G, vcu};
          pg8::EpiS5Out E{YG, TOKMAX};
          pg8::gemm_phase<pg8::EpiS5Out, pg8::OrderGrp<4>, PG8_ALIGN, PG8_SP2>(L + RING_OFF, g, S, E); }
    }
    if (IN(8) && IN(11)) xcd_barrier(bar);


    if (IN(11)) {
        for (int it = bx; it < 1024; it += G) { const int tb = it >> 5, gb = it & 31, g = gb * 8 + wave;
            v4u y0[8], y1[8]; float tm[8];
#pragma unroll
            for (int u = 0; u < 8; ++u) { const int token = tb * 512 + u * 64 + lane; const v4u* yp = (const v4u*)(YG + ((size_t)g * 16384 + token) * 16);
                y0[u] = __builtin_nontemporal_load(yp); y1[u] = __builtin_nontemporal_load(yp + 1); tm[u] = __uint_as_float(TOKMAX[token]); }
#pragma unroll
            for (int u = 0; u < 8; ++u) { const float inv = tm[u] > 0.f ? 127.f / tm[u] : 0.f;
                v4u o; o.x = q8pack(pg8::bflo(y0[u].x) * inv, pg8::bfhi(y0[u].x) * inv, pg8::bflo(y0[u].y) * inv, pg8::bfhi(y0[u].y) * inv); o.y = q8pack(pg8::bflo(y0[u].z) * inv, pg8::bfhi(y0[u].z) * inv, pg8::bflo(y0[u].w) * inv, pg8::bfhi(y0[u].w) * inv);
                o.z = q8pack(pg8::bflo(y1[u].x) * inv, pg8::bfhi(y1[u].x) * inv, pg8::bflo(y1[u].y) * inv, pg8::bfhi(y1[u].y) * inv); o.w = q8pack(pg8::bflo(y1[u].z) * inv, pg8::bfhi(y1[u].z) * inv, pg8::bflo(y1[u].w) * inv, pg8::bfhi(y1[u].w) * inv);
                *(LAS v4u*)(L + RING_OFF + (u * 64 + lane) * 128 + ((wave ^ (lane & 7)) << 4)) = o;
                if (gb == 0 && wave == 0) RS[tb * 512 + u * 64 + lane] = tm[u] * (1.f / 127.f); }
            __syncthreads();
#pragma unroll
            for (int i = 0; i < 8; ++i) { const int row = wave * 64 + i * 8 + (lane >> 3), piece = lane & 7;
                const v4u o = *(const LAS v4u*)(L + RING_OFF + row * 128 + ((piece ^ (row & 7)) << 4));
                *(GAS v4u*)(A8 + pg8::blk8_off(tb * 512 + row, gb * 128) + piece * 16) = o; }
            __syncthreads(); }
        xcd_barrier(bar);
        pg8::Gemm g{(const pg8::bf16_t*)A8, (const pg8::bf16_t*)WGLU8, 2048, 128u, 32u, 32768u, 1048576u, 128u, 32768u, 1048576u}; pg8::StaticOrder S; S.init(64, 16, G, bx);
        pg8::EpiGlu8 E{YG, SZ, Y2, RS, CS2};
        pg8::gemm_phase<pg8::EpiGlu8, pg8::StaticOrder, PG8_ALIGN, PG8_SP2, true>(L + RING_OFF, g, S, E);
    }
    SEAM(11);

    if (IN(12)) {
        pg8::Gemm g{Y2, W5out, 4096, 128u, 32u, 32768u, 2097152u, 128u, 32768u, 2097152u}; pg8::StaticOrder S; S.init(64, 16, G, bx);
        pg8::EpiStore E{OUT1, 4096, 1};
        pg8::gemm_phase<pg8::EpiStore, pg8::StaticOrder, PG8_ALIGN, PG8_SP2>(L + RING_OFF, g, S, E);
    }
    SEAM(12);

    if (IN(13)) {
        const float* npost1 = args.in[I_NPOST] + 4096;
        const int wgb = G >> 2, bq = (wgb > 0) ? vcu / wgb : 4, wl = (wgb > 0) ? vcu % wgb : 0;
        LAS f32x4* Vg = (LAS f32x4*)L;
        if (bq < 4) { const float* gate1 = MOD + (size_t)(5 + bq) * 12288 + 8192;
            for (int q = tid; q < 1024; q += NWAVES * 64) Vg[q] = ((const GAS f32x4*)gate1)[q] * ((const GAS f32x4*)npost1)[q]; }
        __syncthreads();
        if (bq < 4) for (int r = wl * NWAVES + wave; r < SEQL; r += wgb * NWAVES) {
            const int row = bq * SEQL + r; const bf16* op = OUT1 + (size_t)row * DM; float* xo = args.out + (size_t)row * DM;
            unsigned vbase = (unsigned)lane * 16u; asm volatile("" : "+v"(vbase));
            const LAS f32x4* Vg_ = (const LAS f32x4*)(L + vbase);
            v2u ov[16]; float ss = 0.f;
#pragma unroll
            for (int j = 0; j < 16; ++j) { ov[j] = ((const GAS v2u*)op)[lane + 64 * j]; const float a = pg8::bflo(ov[j].x), b = pg8::bfhi(ov[j].x), c = pg8::bflo(ov[j].y), d = pg8::bfhi(ov[j].y); ss += (a * a + b * b) + (c * c + d * d); }
            v2u xv[16]; const bf16* x1p = X1B + (size_t)row * DM;
#pragma unroll
            for (int j = 0; j < 16; ++j) xv[j] = ((const GAS v2u*)x1p)[lane + 64 * j];
            const float rstd = __builtin_amdgcn_rsqf(wave_sum(ss) * (1.f / DM) + EPS);
#pragma unroll
            for (int j = 0; j < 16; ++j) { const f32x4 o4 = {pg8::bflo(ov[j].x), pg8::bfhi(ov[j].x), pg8::bflo(ov[j].y), pg8::bfhi(ov[j].y)};
                const f32x4 x4 = {pg8::bflo(xv[j].x), pg8::bfhi(xv[j].x), pg8::bflo(xv[j].y), pg8::bfhi(xv[j].y)};
                ((GAS f32x4*)xo)[lane + 64 * j] = x4 + Vg_[64 * j] * (o4 * rstd); if ((j & 3) == 3) __builtin_amdgcn_sched_barrier(0); }
        }
    }
#undef IN
#undef SEAM
}

extern "C" void kernel_launch(void* const* d_in, const int* in_sizes, int n_in, void* d_out, int out_size, void* d_ws, size_t ws_size, hipStream_t stream) {
    static int grid = 0;
    if (grid == 0) {
        if (n_in != 23 || out_size != MLAT * DM || ws_size < WS_END) { fprintf(stderr, "kernel_launch: unexpected shapes: n_in %d out %d ws %zu (need %zu)\n", n_in, out_size, ws_size, (size_t)WS_END); grid = -1; return; }
        int dev = 0, cus = 0, per_cu = 0;
        if (hipGetDevice(&dev) != hipSuccess || hipDeviceGetAttribute(&cus, hipDeviceAttributeMultiprocessorCount, dev) != hipSuccess) { grid = -1; return; }
        if (hipFuncSetAttribute((const void*)fwd_kernel, hipFuncAttributeMaxDynamicSharedMemorySize, LDS_BYTES) != hipSuccess) { fprintf(stderr, "kernel_launch: hipFuncSetAttribute failed\n"); grid = -1; return; }
        if (hipOccupancyMaxActiveBlocksPerMultiprocessor(&per_cu, (const void*)fwd_kernel, NWAVES * 64, LDS_BYTES) != hipSuccess || per_cu < 1) { fprintf(stderr, "kernel_launch: occupancy query says %d\n", per_cu); }
        (void)hipGetLastError();
        grid = cus;
    }
    if (grid < 0) return;
    if (hipMemsetAsync((char*)d_ws + WS_CTL, 0, CTL_ZERO_BYTES, stream) != hipSuccess) return;
    Args a{};
    for (int i = 0; i < 23; ++i) a.in[i] = (const float*)d_in[i];
    a.out = (float*)d_out; a.ws = (unsigned char*)d_ws;
#if MK_PER_PHASE
    for (int p = 0; p < MK_LAST_PHASE; ++p) { a.ph_lo = p; a.ph_hi = p + 1; hipLaunchKernelGGL(fwd_kernel, dim3(grid), dim3(NWAVES * 64), LDS_BYTES, stream, a); }
#else
    a.ph_lo = 0; a.ph_hi = MK_LAST_PHASE;
    hipLaunchKernelGGL(fwd_kernel, dim3(grid), dim3(NWAVES * 64), LDS_BYTES, stream, a);
#endif
    const hipError_t le = hipPeekAtLastError();
    if (le != hipSuccess) fprintf(stderr, "kernel_launch: launch failed: %s\n", hipGetErrorName(le));
}
```

```cpp
#include <hip/hip_runtime.h>
#include <cstdio>
#include <cstdint>
#include <type_traits>

#ifndef MK_PER_PHASE
#define MK_PER_PHASE 0
#endif
#ifndef MK_LAST_PHASE
#define MK_LAST_PHASE 14
#endif

namespace pg8 {
#define PG8_LAS __attribute__((address_space(3)))
typedef unsigned short bf16_t;
typedef short bf16x8 __attribute__((ext_vector_type(8)));
typedef float f32x4 __attribute__((ext_vector_type(4)));
typedef unsigned u32x4 __attribute__((ext_vector_type(4)));
typedef int i32x4 __attribute__((ext_vector_type(4)));
constexpr int BM = 256, BK = 64, HALF = 128, HTB = HALF * BK * 2, STAGE_BYTES = 8 * HTB, NXCD = 8, WGM = 8;

__host__ __device__ __forceinline__ int lds_byte(int r, int c) { const int st = (r >> 4) * 2 + (c >> 5), rr = r & 15, cc = c & 31, ob = rr * 64 + cc * 2; return st * 1024 + (ob ^ (((ob >> 9) & 1) << 5)); }
__host__ __device__ __forceinline__ void stage_rc(int b, int& R, int& C) { const int st = b / 1024, sb = b % 1024, swz = sb ^ (((sb >> 9) & 1) << 5); R = (st >> 1) * 16 + swz / 64; C = (st & 1) * 32 + (swz % 64) / 2; }
__host__ __device__ __forceinline__ int perm32(int rho) { const int n = rho >> 4, i = rho & 15; return 8 * (i >> 2) + 4 * n + (i & 3); }

struct Unit { int pm, pn; };
struct Gemm { const bf16_t* A; const bf16_t* Bt; int K; unsigned a_row, a_cg, a_kt, a_tile, b_row, b_kt, b_tile; };
__host__ __device__ __forceinline__ size_t blk8_off(int r, int c) { return ((size_t)((r >> 8) * 32 + (c >> 7)) << 15) + (size_t)(((r & 255) << 7) + (c & 127)); }
__host__ __device__ __forceinline__ size_t blk_off(int r, int c) { return ((size_t)((r >> 8) * 64 + (c >> 6)) << 14) + (size_t)(((r & 255) << 6) + (c & 63)); }

__host__ __device__ __forceinline__ void static_map(int L, int nM, int nN, int& pm, int& pn) {
    const int nwg = nM * nN; int wgid = L;
    { const int q = nwg / NXCD, r = nwg % NXCD, xcd = wgid % NXCD, off = wgid / NXCD; wgid = (xcd < r ? xcd * (q + 1) : r * (q + 1) + (xcd - r) * q) + off; }
    const int nig = WGM * nN, gid = wgid / nig, fm = gid * WGM, gsz = (nM - fm) < WGM ? (nM - fm) : WGM;
    pm = fm + ((wgid % nig) % gsz); pn = (wgid % nig) / gsz;
}
struct StaticOrder {
    int nM, nN, nwg, G, c;
    __host__ __device__ void init(int nM_, int nN_, int G_, int c_) { nM = nM_; nN = nN_; nwg = nM * nN; G = G_; c = c_; }
    __host__ __device__ bool next(int i, Unit& u) const { const long L = (long)i * G + c; if (L >= nwg) return false; static_map((int)L, nM, nN, u.pm, u.pn); return true; }
    __device__ __forceinline__ void a_ready(const Unit&) const {}
    __device__ __forceinline__ void done(const Unit&) const {}
};
struct OrderP7 {
    int G, c;
    __host__ __device__ bool next(int i, Unit& u) const { const long L = (long)i * G + c; if (L >= 2112) return false;
        if (L < 2048) static_map((int)L, 64, 32, u.pm, u.pn); else { const int e = (int)L - 2048; u.pm = 64 + (e & 3); u.pn = e >> 2; } return true; }
    __device__ __forceinline__ void a_ready(const Unit&) const {}
    __device__ __forceinline__ void done(const Unit&) const {}
};
template <int RT> struct OrderGrp {
    int G, c;
    __host__ __device__ bool next(int i, Unit& u) const { const int g = c + (i / RT) * G, rt = i % RT; if (g >= 256) return false; u.pm = g * 5 + rt; u.pn = g; return true; }
    __device__ __forceinline__ void a_ready(const Unit&) const {}
    __device__ __forceinline__ void done(const Unit&) const {}
};
template <int RT> struct OrderS5 {
    int G, c;
    __host__ __device__ bool next(int i, Unit& u) const { const long L = (long)i * G + c; if (L >= 256 * RT) return false; const int g = (int)L / RT, rt = (int)L % RT; u.pm = g * 5 + rt; u.pn = g; return true; }
    __device__ __forceinline__ void a_ready(const Unit&) const {}
    __device__ __forceinline__ void done(const Unit&) const {}
};

__device__ __forceinline__ unsigned cvt_pk_bf16(float lo, float hi) { unsigned r; asm("v_cvt_pk_bf16_f32 %0, %1, %2" : "=v"(r) : "v"(lo), "v"(hi)); return r; }
__device__ __forceinline__ float bflo(unsigned w) { return __uint_as_float(w << 16); }
__device__ __forceinline__ float bfhi(unsigned w) { return __uint_as_float(w & 0xffff0000u); }
__device__ __forceinline__ u32x4 pack8(const f32x4& v0, const f32x4& v1) { u32x4 w; w.x = cvt_pk_bf16(v0[0], v0[1]); w.y = cvt_pk_bf16(v0[2], v0[3]); w.z = cvt_pk_bf16(v1[0], v1[1]); w.w = cvt_pk_bf16(v1[2], v1[3]); return w; }
__device__ __forceinline__ float sigmoidf_fast(float v) { return __builtin_amdgcn_rcpf(1.f + __builtin_amdgcn_exp2f(-1.4426950408889634f * v)); }

struct EpiStore {
    static constexpr bool PERM = true, AFTER_DRAIN = false;
    bf16_t* O; int ldc; int use_pn;
    __device__ __forceinline__ void operator()(const f32x4 (&acc)[2][2][4][2], const Unit& u, int wr, int wc, int fr, int fq) const {
        const int row0 = u.pm * BM + wr * 64 + fr, col0 = (use_pn ? u.pn * BM : 0) + wc * 32 + 8 * fq;
#pragma unroll
        for (int ai = 0; ai < 2; ++ai)
#pragma unroll
            for (int m = 0; m < 4; ++m) { bf16_t* rowp = O + (size_t)(row0 + ai * HALF + m * 16) * ldc + col0;
#pragma unroll
                for (int bj = 0; bj < 2; ++bj) *(u32x4*)(rowp + bj * HALF) = pack8(acc[ai][bj][m][0], acc[ai][bj][m][1]); }
    }
};
struct EpiRope {
    static constexpr bool PERM = true, AFTER_DRAIN = false;
    bf16_t* QH; bf16_t* KH; bf16_t* VH; bf16_t* GT; const float* rope; int pn_off;
    __device__ __forceinline__ void operator()(const f32x4 (&acc)[2][2][4][2], const Unit& u, int wr, int wc, int fr, int fq) const {
        const int row0 = u.pm * BM + wr * 64 + fr, sec = (u.pn + pn_off) >> 4, h = (u.pn + pn_off) & 15, cw = wc * 32 + 8 * fq;
        const bool do_rope = (u.pm < 64) && (sec < 2);
        const int axis = wc >> 1, f0 = (wc & 1) * 16 + 4 * fq;
        bf16_t* base; size_t rstride, bjstride;
        if (sec < 2) { base = (sec == 0 ? QH : KH) + (size_t)(h * 2) * 17408 * 128; rstride = 128; bjstride = (size_t)17408 * 128; }
        else if (sec == 2) { base = VH + (size_t)h * 17408 * 256; rstride = 256; bjstride = 128; }
        else { base = GT + h * 256; rstride = 4096; bjstride = 128; }
#pragma unroll
        for (int ai = 0; ai < 2; ++ai)
#pragma unroll
            for (int m = 0; m < 4; ++m) { const int row = row0 + ai * HALF + m * 16; bf16_t* rowp = base + (size_t)row * rstride + cw;
                f32x4 c0 = {1.f, 0.f, 1.f, 0.f}, c1 = {1.f, 0.f, 1.f, 0.f};
                if (do_rope) { const int t = row & 4095, pos = axis ? (t & 63) : (t >> 6); const f32x4* tp = (const f32x4*)(rope + (pos * 32 + f0) * 2); c0 = tp[0]; c1 = tp[1]; }
#pragma unroll
                for (int bj = 0; bj < 2; ++bj) { const f32x4 a = acc[ai][bj][m][0], b = acc[ai][bj][m][1]; f32x4 v0, v1;
                    v0[0] = a[0] * c0[0] - a[1] * c0[1]; v0[1] = a[1] * c0[0] + a[0] * c0[1]; v0[2] = a[2] * c0[2] - a[3] * c0[3]; v0[3] = a[3] * c0[2] + a[2] * c0[3];
                    v1[0] = b[0] * c1[0] - b[1] * c1[1]; v1[1] = b[1] * c1[0] + b[0] * c1[1]; v1[2] = b[2] * c1[2] - b[3] * c1[3]; v1[3] = b[3] * c1[2] + b[2] * c1[3];
                    *(u32x4*)(rowp + bj * bjstride) = pack8(v0, v1); } }
    }
};
struct EpiRope8 {
    static constexpr bool PERM = true, AFTER_DRAIN = false;
    bf16_t* QH; bf16_t* KH; bf16_t* VH; bf16_t* GT; const float* rope; const float* RS; const float* CS;
    __device__ __forceinline__ void operator()(const i32x4 (&acc)[2][2][4][2], const Unit& u, int wr, int wc, int fr, int fq) const {
        const int row0 = u.pm * BM + wr * 64 + fr, sec = u.pn >> 4, h = u.pn & 15, cw = wc * 32 + 8 * fq;
        const bool do_rope = (u.pm < 64) && (sec < 2);
        const int axis = wc >> 1, f0 = (wc & 1) * 16 + 4 * fq;
        f32x4 csv[2][2];
#pragma unroll
        for (int bj = 0; bj < 2; ++bj)
#pragma unroll
            for (int n = 0; n < 2; ++n) csv[bj][n] = *(const f32x4*)(CS + u.pn * BM + bj * HALF + cw + 4 * n);
        bf16_t* base; size_t rstride, bjstride;
        if (sec < 2) { base = (sec == 0 ? QH : KH) + (size_t)(h * 2) * 17408 * 128; rstride = 128; bjstride = (size_t)17408 * 128; }
        else if (sec == 2) { base = VH + (size_t)h * 17408 * 256; rstride = 256; bjstride = 128; }
        else { base = GT + h * 256; rstride = 4096; bjstride = 128; }
        if (!do_rope) {
#pragma unroll
            for (int ai = 0; ai < 2; ++ai)
#pragma unroll
                for (int m = 0; m < 4; ++m) { const int row = row0 + ai * HALF + m * 16; bf16_t* rowp = base + (size_t)row * rstride + cw; const float rsv = RS[row];
#pragma unroll
                    for (int bj = 0; bj < 2; ++bj) *(u32x4*)(rowp + bj * bjstride) = pack8(__builtin_convertvector(acc[ai][bj][m][0], f32x4) * (csv[bj][0] * rsv), __builtin_convertvector(acc[ai][bj][m][1], f32x4) * (csv[bj][1] * rsv)); }
            return;
        }
#pragma unroll
        for (int ai = 0; ai < 2; ++ai)
#pragma unroll
            for (int m = 0; m < 4; ++m) { const int row = row0 + ai * HALF + m * 16; bf16_t* rowp = base + (size_t)row * rstride + cw; const float rsv = RS[row];
                f32x4 c0 = {1.f, 0.f, 1.f, 0.f}, c1 = {1.f, 0.f, 1.f, 0.f};
                if (do_rope) { const int t = row & 4095, pos = axis ? (t & 63) : (t >> 6); const f32x4* tp = (const f32x4*)(rope + (pos * 32 + f0) * 2); c0 = tp[0]; c1 = tp[1]; }
#pragma unroll
                for (int bj = 0; bj < 2; ++bj) { const f32x4 a = __builtin_convertvector(acc[ai][bj][m][0], f32x4) * (csv[bj][0] * rsv), b = __builtin_convertvector(acc[ai][bj][m][1], f32x4) * (csv[bj][1] * rsv); f32x4 v0, v1;
                    v0[0] = a[0] * c0[0] - a[1] * c0[1]; v0[1] = a[1] * c0[0] + a[0] * c0[1]; v0[2] = a[2] * c0[2] - a[3] * c0[3]; v0[3] = a[3] * c0[2] + a[2] * c0[3];
                    v1[0] = b[0] * c1[0] - b[1] * c1[1]; v1[1] = b[1] * c1[0] + b[0] * c1[1]; v1[2] = b[2] * c1[2] - b[3] * c1[3]; v1[3] = b[3] * c1[2] + b[2] * c1[3];
                    *(u32x4*)(rowp + bj * bjstride) = pack8(v0, v1); } }
    }
};
struct EpiS5In {
    static constexpr bool PERM = true, AFTER_DRAIN = false;
    bf16_t* XS; bf16_t* SZ;
    __device__ __forceinline__ void operator()(const f32x4 (&acc)[2][2][4][2], const Unit& u, int wr, int wc, int fr, int fq) const {
        const int row0 = u.pm * BM + wr * 64 + fr, col0 = u.pn * BM + wc * 32 + 8 * fq;
        if (u.pn < 16) {
#pragma unroll
            for (int ai = 0; ai < 2; ++ai)
#pragma unroll
                for (int m = 0; m < 4; ++m) { const int row = row0 + ai * HALF + m * 16; const int xsrow = (row < 16384) ? (row >> 4) : (1024 + ((row - 16384) >> 4)), tt = row & 15;
#pragma unroll
                    for (int bj = 0; bj < 2; ++bj) { const int col = col0 + bj * HALF, g = col >> 4, half = col & 15;
                        *(u32x4*)((char*)XS + (size_t)g * (1280u * 1024u) + (size_t)xsrow * 1024 + tt * 32 + half * 2) = pack8(acc[ai][bj][m][0], acc[ai][bj][m][1]); } }
        } else {
#pragma unroll
            for (int ai = 0; ai < 2; ++ai)
#pragma unroll
                for (int m = 0; m < 4; ++m) { bf16_t* rowp = SZ + (size_t)(row0 + ai * HALF + m * 16) * 4096 + (col0 - 4096);
#pragma unroll
                    for (int bj = 0; bj < 2; ++bj) { f32x4 a = acc[ai][bj][m][0], b = acc[ai][bj][m][1];
#pragma unroll
                        for (int e = 0; e < 4; ++e) { a[e] = a[e] * sigmoidf_fast(a[e]); b[e] = b[e] * sigmoidf_fast(b[e]); }
                        *(u32x4*)(rowp + bj * HALF) = pack8(a, b); } }
        }
    }
};
struct EpiS5Out {
    static constexpr bool PERM = true, AFTER_DRAIN = false;
    bf16_t* YG; unsigned* tokmax;
    __device__ __forceinline__ void operator()(const f32x4 (&acc)[2][2][4][2], const Unit& u, int wr, int wc, int fr, int fq) const {
        const int g = u.pn, rt = u.pm - 5 * g; const int row0 = (g * 4 + rt) * BM + wr * 64 + fr, col0 = wc * 32 + 8 * fq;
#pragma unroll
        for (int ai = 0; ai < 2; ++ai)
#pragma unroll
            for (int m = 0; m < 4; ++m) { bf16_t* rowp = YG + (size_t)(row0 + ai * HALF + m * 16) * 256 + col0;
#pragma unroll
                for (int bj = 0; bj < 2; ++bj) { f32x4 a = acc[ai][bj][m][0], b = acc[ai][bj][m][1];
#pragma unroll
                    for (int e = 0; e < 4; ++e) { const float za = 1.5957691216057308f * (a[e] + 0.044715f * a[e] * a[e] * a[e]); a[e] = a[e] * sigmoidf_fast(za);
                                                  const float zb = 1.5957691216057308f * (b[e] + 0.044715f * b[e] * b[e] * b[e]); b[e] = b[e] * sigmoidf_fast(zb); }
                    *(u32x4*)(rowp + bj * HALF) = pack8(a, b);
                    float mx = fmaxf(fmaxf(fmaxf(__builtin_fabsf(a[0]), __builtin_fabsf(a[1])), fmaxf(__builtin_fabsf(a[2]), __builtin_fabsf(a[3]))), fmaxf(fmaxf(__builtin_fabsf(b[0]), __builtin_fabsf(b[1])), fmaxf(__builtin_fabsf(b[2]), __builtin_fabsf(b[3]))));
                    mx = fmaxf(mx, __shfl_xor(mx, 16));
                    if ((fq & 1) == 0) (void)__hip_atomic_fetch_max(tokmax + ((rt * BM + wr * 64 + fr + ai * HALF + m * 16) * 16 + wc * 2 + (fq >> 1) + bj * 8), __float_as_uint(mx), __ATOMIC_RELAXED, __HIP_MEMORY_SCOPE_AGENT); } }
    }
};
struct EpiGlu {
    static constexpr bool PERM = true, AFTER_DRAIN = false;
    const bf16_t* YG; const bf16_t* SZ; bf16_t* Y2;
    __device__ __forceinline__ void operator()(const f32x4 (&acc)[2][2][4][2], const Unit& u, int wr, int wc, int fr, int fq) const {
        const int row0 = u.pm * BM + wr * 64 + fr, col0 = u.pn * BM + wc * 32 + 8 * fq;
#pragma unroll
        for (int ai = 0; ai < 2; ++ai)
#pragma unroll
            for (int m = 0; m < 4; ++m) { const int row = row0 + ai * HALF + m * 16;
#pragma unroll
                for (int bj = 0; bj < 2; ++bj) { const int col = col0 + bj * HALF;
                    const u32x4 yv = *(const u32x4*)((const char*)YG + (size_t)(col >> 4) * (16384u * 32u) + (size_t)row * 32 + (col & 15) * 2);
                    const u32x4 sv = *(const u32x4*)(SZ + (size_t)row * 4096 + col);
                    const f32x4 a = acc[ai][bj][m][0], b = acc[ai][bj][m][1]; f32x4 v0, v1;
                    v0[0] = bflo(yv.x) * bflo(sv.x) * sigmoidf_fast(a[0]); v0[1] = bfhi(yv.x) * bfhi(sv.x) * sigmoidf_fast(a[1]);
                    v0[2] = bflo(yv.y) * bflo(sv.y) * sigmoidf_fast(a[2]); v0[3] = bfhi(yv.y) * bfhi(sv.y) * sigmoidf_fast(a[3]);
                    v1[0] = bflo(yv.z) * bflo(sv.z) * sigmoidf_fast(b[0]); v1[1] = bfhi(yv.z) * bfhi(sv.z) * sigmoidf_fast(b[1]);
                    v1[2] = bflo(yv.w) * bflo(sv.w) * sigmoidf_fast(b[2]); v1[3] = bfhi(yv.w) * bfhi(sv.w) * sigmoidf_fast(b[3]);
                    *(u32x4*)(Y2 + blk_off(row, col)) = pack8(v0, v1); } }
    }
};
struct EpiGlu8 {
    static constexpr bool PERM = true, AFTER_DRAIN = false;
    const bf16_t* YG; const bf16_t* SZ; bf16_t* Y2; const float* RS; const float* CS;
    __device__ __forceinline__ void operator()(const i32x4 (&acc)[2][2][4][2], const Unit& u, int wr, int wc, int fr, int fq) const {
        const int row0 = u.pm * BM + wr * 64 + fr, col0 = u.pn * BM + wc * 32 + 8 * fq;
        f32x4 csv[2][2];
#pragma unroll
        for (int bj = 0; bj < 2; ++bj)
#pragma unroll
            for (int n = 0; n < 2; ++n) csv[bj][n] = *(const f32x4*)(CS + col0 + bj * HALF + 4 * n);
#pragma unroll
        for (int am = 0; am < 4; ++am) { const int ai = am >> 1, mb = (am & 1) * 2;
            u32x4 yv[2][2], sv[2][2]; float rsv[2];
#pragma unroll
            for (int m = 0; m < 2; ++m) { const int row = row0 + ai * HALF + (mb + m) * 16; rsv[m] = RS[row];
#pragma unroll
                for (int bj = 0; bj < 2; ++bj) { const int col = col0 + bj * HALF;
                    yv[m][bj] = *(const u32x4*)((const char*)YG + (size_t)(col >> 4) * (16384u * 32u) + (size_t)row * 32 + (col & 15) * 2);
                    sv[m][bj] = *(const u32x4*)(SZ + (size_t)row * 4096 + col); } }
#pragma unroll
            for (int m = 0; m < 2; ++m) { const int row = row0 + ai * HALF + (mb + m) * 16;
#pragma unroll
                for (int bj = 0; bj < 2; ++bj) { const int col = col0 + bj * HALF; const u32x4 y = yv[m][bj], z = sv[m][bj];
                    const f32x4 a = __builtin_convertvector(acc[ai][bj][mb + m][0], f32x4) * (csv[bj][0] * rsv[m]), b = __builtin_convertvector(acc[ai][bj][mb + m][1], f32x4) * (csv[bj][1] * rsv[m]); f32x4 v0, v1;
                    v0[0] = bflo(y.x) * bflo(z.x) * sigmoidf_fast(a[0]); v0[1] = bfhi(y.x) * bfhi(z.x) * sigmoidf_fast(a[1]);
                    v0[2] = bflo(y.y) * bflo(z.y) * sigmoidf_fast(a[2]); v0[3] = bfhi(y.y) * bfhi(z.y) * sigmoidf_fast(a[3]);
                    v1[0] = bflo(y.z) * bflo(z.z) * sigmoidf_fast(b[0]); v1[1] = bfhi(y.z) * bfhi(z.z) * sigmoidf_fast(b[1]);
                    v1[2] = bflo(y.w) * bflo(z.w) * sigmoidf_fast(b[2]); v1[3] = bfhi(y.w) * bfhi(z.w) * sigmoidf_fast(b[3]);
                    *(u32x4*)(Y2 + blk_off(row, col)) = pack8(v0, v1); } }
        }
    }
};

template <class Epi, class Sched, bool ALIGN_EPI = false, bool SP2 = false, bool I8 = false>
__device__ __forceinline__ void gemm_phase(PG8_LAS unsigned char* lds, const Gemm g, const Sched& S, const Epi& E) {
    const int tid = threadIdx.x, wid = __builtin_amdgcn_readfirstlane(tid >> 6), lane = tid & 63, wr = wid >> 2, wc = wid & 3, fr = lane & 15, fq = lane >> 4;
    const int K = g.K, nt = K / BK;
    unsigned voffA[2], voffB[2];
#pragma unroll
    for (int i = 0; i < 2; ++i) { int R, C; stage_rc(tid * 16 + i * 8192, R, C); const int Rb = Epi::PERM ? ((R & ~31) + perm32(R & 31)) : R;
        voffA[i] = (unsigned)R * g.a_row + (unsigned)(C >> 4) * g.a_cg + (unsigned)(C & 15) * 2u; voffB[i] = (unsigned)Rb * g.b_row + (unsigned)C * 2u; }
    const size_t kstepA = (size_t)g.a_kt, kstepB = (size_t)g.b_kt;
    const size_t hstepA = (size_t)HALF * g.a_row, hstepB = (size_t)HALF * g.b_row;
    const size_t tstepA = (size_t)g.a_tile, tstepB = (size_t)g.b_tile;
    const unsigned ldsw = (unsigned)wid * 1024u;
    const int aoff = lds_byte(wr * 64 + fr, fq * 8), boff = lds_byte(wc * 32 + fr, fq * 8);
#define PG8_SA(b, h) (((b) * 2 + (h)) * HTB)
#define PG8_SB(b, h) ((4 + (b) * 2 + (h)) * HTB)
#define PG8_STAGE(bufoff, gbase, voff) do { _Pragma("unroll") for (int _i = 0; _i < 2; ++_i) \
        __builtin_amdgcn_global_load_lds((const unsigned*)((const char*)(gbase) + (voff)[_i]), (PG8_LAS unsigned*)(lds + (bufoff) + ldsw + _i * 8192), 16, 0, 0); } while (0)
#define PG8_LDA(dst, b, h) do { _Pragma("unroll") for (int m = 0; m < 4; ++m) _Pragma("unroll") for (int k = 0; k < 2; ++k) dst[m][k] = *(const PG8_LAS bf16x8*)(lds + PG8_SA(b, h) + aoff + m * 2048 + k * 1024); } while (0)
#define PG8_LDB(dst, b, h) do { _Pragma("unroll") for (int n = 0; n < 2; ++n) _Pragma("unroll") for (int k = 0; k < 2; ++k) dst[n][k] = *(const PG8_LAS bf16x8*)(lds + PG8_SB(b, h) + boff + n * 2048 + k * 1024); } while (0)
#define PG8_MMA(ai, bj, At, Bt) do { __builtin_amdgcn_s_setprio(1); _Pragma("unroll") for (int m = 0; m < 4; ++m) _Pragma("unroll") for (int n = 0; n < 2; ++n) _Pragma("unroll") for (int k = 0; k < 2; ++k) \
        { if constexpr (I8) acc[ai][bj][m][n] = __builtin_amdgcn_mfma_i32_16x16x64_i8(__builtin_bit_cast(i32x4, Bt[n][k]), __builtin_bit_cast(i32x4, At[m][k]), acc[ai][bj][m][n], 0, 0, 0); \
          else acc[ai][bj][m][n] = __builtin_amdgcn_mfma_f32_16x16x32_bf16(Bt[n][k], At[m][k], acc[ai][bj][m][n], 0, 0, 0); } __builtin_amdgcn_s_setprio(0); } while (0)
#define PG8_WAIT_V(n) asm volatile("s_waitcnt vmcnt(" #n ")" ::: "memory")
#define PG8_WAIT_L(n) asm volatile("s_waitcnt lgkmcnt(" #n ")" ::: "memory")
#define PG8_BAR __builtin_amdgcn_s_barrier()
#define PG8_SCHED __builtin_amdgcn_sched_barrier(0)
    Unit cur, nxt; int ui = 0;
    if (!S.next(0, cur)) return;
    typedef typename std::conditional<I8, i32x4, f32x4>::type acc_t;
    acc_t acc[2][2][4][2];
#pragma unroll
    for (int a = 0; a < 2; ++a)
#pragma unroll
        for (int b = 0; b < 2; ++b)
#pragma unroll
            for (int m = 0; m < 4; ++m)
#pragma unroll
                for (int n = 0; n < 2; ++n) acc[a][b][m][n] = acc_t{};
    bf16x8 At[4][2], B0[2][2], B1[2][2];
    const char* cA = (const char*)g.A + (size_t)cur.pm * tstepA; const char* cB = (const char*)g.Bt + (size_t)cur.pn * tstepB;
    S.a_ready(cur);
    if constexpr (SP2) {
        PG8_STAGE(PG8_SB(0, 0), cB, voffB); PG8_STAGE(PG8_SB(0, 1), cB + hstepB, voffB); PG8_STAGE(PG8_SA(0, 0), cA, voffA); PG8_STAGE(PG8_SA(0, 1), cA + hstepA, voffA);
        if (wr == 1) PG8_BAR;
        PG8_WAIT_V(2); PG8_BAR;
        PG8_STAGE(PG8_SB(1, 0), cB + kstepB, voffB); PG8_STAGE(PG8_SA(1, 0), cA + kstepA, voffA); PG8_STAGE(PG8_SB(1, 1), cB + hstepB + kstepB, voffB);
        PG8_WAIT_V(6); PG8_BAR;
    } else {
        PG8_STAGE(PG8_SB(0, 0), cB, voffB); PG8_STAGE(PG8_SA(0, 0), cA, voffA); PG8_STAGE(PG8_SB(0, 1), cB + hstepB, voffB); PG8_STAGE(PG8_SA(0, 1), cA + hstepA, voffA);
        if (wr == 1) PG8_BAR;
        PG8_WAIT_V(4); PG8_BAR;
        PG8_STAGE(PG8_SB(1, 0), cB + kstepB, voffB); PG8_STAGE(PG8_SA(1, 0), cA + kstepA, voffA); PG8_STAGE(PG8_SB(1, 1), cB + hstepB + kstepB, voffB);
        PG8_WAIT_V(6); PG8_BAR;
    }
    for (;;) {
        const bool has_next = S.next(ui + 1, nxt);
        const char* nA = has_next ? (const char*)g.A + (size_t)nxt.pm * tstepA : cA; const char* nB = has_next ? (const char*)g.Bt + (size_t)nxt.pn * tstepB : cB;
#pragma unroll 1
        for (int t = 0; t < nt; t += 2) {
            const bool last = (t == nt - 2);
            const char* a1 = cA + (size_t)(t + 1) * kstepA;
            const char* a2 = last ? nA : cA + (size_t)(t + 2) * kstepA; const char* b2 = last ? nB : cB + (size_t)(t + 2) * kstepB;
            const char* a3 = a2 + kstepA; const char* b3 = b2 + kstepB;
            if (last && has_next) S.a_ready(nxt);
            if constexpr (SP2) {
            PG8_LDB(B0, 0, 0); PG8_LDB(B1, 0, 1); PG8_SCHED; PG8_LDA(At, 0, 0); PG8_STAGE(PG8_SA(1, 1), a1 + hstepA, voffA);
            PG8_WAIT_V(8); PG8_WAIT_L(0); PG8_BAR; PG8_MMA(0, 0, At, B0); PG8_MMA(0, 1, At, B1); PG8_BAR; PG8_SCHED;
            PG8_LDA(At, 0, 1); PG8_STAGE(PG8_SB(0, 0), b2, voffB); PG8_STAGE(PG8_SB(0, 1), b2 + hstepB, voffB); PG8_STAGE(PG8_SA(0, 0), a2, voffA);
            PG8_WAIT_V(8); PG8_WAIT_L(0); PG8_BAR; PG8_MMA(1, 0, At, B0); PG8_MMA(1, 1, At, B1); PG8_BAR; PG8_SCHED;
            PG8_LDB(B0, 1, 0); PG8_LDB(B1, 1, 1); PG8_SCHED; PG8_LDA(At, 1, 0); PG8_STAGE(PG8_SA(0, 1), a2 + hstepA, voffA);
            PG8_WAIT_V(8); PG8_WAIT_L(0); PG8_BAR; PG8_MMA(0, 0, At, B0); PG8_MMA(0, 1, At, B1); PG8_BAR; PG8_SCHED;
            PG8_LDA(At, 1, 1); PG8_STAGE(PG8_SB(1, 0), b3, voffB); PG8_STAGE(PG8_SB(1, 1), b3 + hstepB, voffB); PG8_STAGE(PG8_SA(1, 0), a3, voffA);
            PG8_WAIT_V(8); PG8_WAIT_L(0); PG8_BAR; PG8_MMA(1, 0, At, B0); PG8_MMA(1, 1, At, B1); PG8_BAR; PG8_SCHED;
            } else {
            PG8_LDB(B0, 0, 0); PG8_SCHED; PG8_LDA(At, 0, 0); PG8_STAGE(PG8_SA(1, 1), a1 + hstepA, voffA);
            PG8_WAIT_L(8); PG8_BAR; PG8_WAIT_L(0); PG8_MMA(0, 0, At, B0); PG8_BAR; PG8_SCHED;
            PG8_LDB(B1, 0, 1); PG8_STAGE(PG8_SB(0, 0), b2, voffB);
            PG8_BAR; PG8_WAIT_L(0); PG8_MMA(0, 1, At, B1); PG8_BAR;
            PG8_LDA(At, 0, 1); PG8_STAGE(PG8_SA(0, 0), a2, voffA);
            PG8_BAR; PG8_WAIT_L(0); PG8_MMA(1, 0, At, B0); PG8_BAR; PG8_SCHED;
            PG8_STAGE(PG8_SB(0, 1), b2 + hstepB, voffB);
            PG8_WAIT_V(6); PG8_BAR; PG8_MMA(1, 1, At, B1); PG8_BAR;
            PG8_LDB(B0, 1, 0); PG8_SCHED; PG8_LDA(At, 1, 0); PG8_STAGE(PG8_SA(0, 1), a2 + hstepA, voffA);
            PG8_WAIT_L(8); PG8_BAR; PG8_WAIT_L(0); PG8_MMA(0, 0, At, B0); PG8_BAR; PG8_SCHED;
            PG8_LDB(B1, 1, 1); PG8_STAGE(PG8_SB(1, 0), b3, voffB);
            PG8_BAR; PG8_WAIT_L(0); PG8_MMA(0, 1, At, B1); PG8_BAR;
            PG8_LDA(At, 1, 1); PG8_STAGE(PG8_SA(1, 0), a3, voffA);
            PG8_BAR; PG8_WAIT_L(0); PG8_MMA(1, 0, At, B0); PG8_BAR; PG8_SCHED;
            PG8_STAGE(PG8_SB(1, 1), b3 + hstepB, voffB);
            PG8_WAIT_V(6); PG8_BAR; PG8_MMA(1, 1, At, B1); PG8_BAR;
            }
        }
        if constexpr (ALIGN_EPI) { if (wr == 0) PG8_BAR; }
        asm volatile("s_nop 15\n\ts_nop 7" ::: "memory");
        if constexpr (!Epi::AFTER_DRAIN) { E(acc, cur, wr, wc, fr, fq); S.done(cur); }
        if (!has_next) break;
#pragma unroll
        for (int a = 0; a < 2; ++a)
#pragma unroll
            for (int b = 0; b < 2; ++b)
#pragma unroll
                for (int m = 0; m < 4; ++m)
#pragma unroll
                    for (int n = 0; n < 2; ++n) acc[a][b][m][n] = acc_t{};
        cur = nxt; cA = nA; cB = nB; ++ui;
        if constexpr (ALIGN_EPI) { if (wr == 1) PG8_BAR; }
    }
    PG8_WAIT_V(0);
    if constexpr (!ALIGN_EPI) { if (wr == 0) PG8_BAR; }
    PG8_BAR;
#undef PG8_SA
#undef PG8_SB
#undef PG8_STAGE
#undef PG8_LDA
#undef PG8_LDB
#undef PG8_MMA
#undef PG8_WAIT_V
#undef PG8_WAIT_L
#undef PG8_BAR
#undef PG8_SCHED
}
}
#define PG8_SP2 true
#define PG8_ALIGN true

namespace att {
typedef unsigned short bf16;
constexpr int D = 128, NW = 8, QBLK = 32, KVBLK = 64, CTXN = 256;
constexpr float SCALE = 0.088388347648318440f;
constexpr float THR = 8.f;
constexpr int SDEPTH = 2;
constexpr long LDQ = 128, LDK = 128, LDV = 256, LDO = 8192;
constexpr size_t SHM_V = KVBLK * D * 2, SHM_K = KVBLK * D * 2, SHM_ATTN = 2 * SHM_V + 2 * SHM_K + NW * 64 * 4;
using bf16x8 = __attribute__((ext_vector_type(8))) short;
using s16x4  = __attribute__((ext_vector_type(4))) short;
using f32x16 = __attribute__((ext_vector_type(16))) float;
using u32x4  = __attribute__((ext_vector_type(4))) unsigned;
#define KSWZ(row, colB) ((row) * 256 + ((colB) ^ (((row) & 7) << 4)))
#define SBAR() __builtin_amdgcn_sched_barrier(0)
__device__ __forceinline__ int crow(int r, int hi) { return (r & 3) + 8 * (r >> 2) + 4 * hi; }
__device__ __forceinline__ unsigned cvtpk(float lo, float hi) { unsigned r; asm volatile("v_cvt_pk_bf16_f32 %0, %1, %2" : "=v"(r) : "v"(lo), "v"(hi)); return r; }

__device__ __forceinline__ void partialSM(f32x16& p0, f32x16& p1, float& m_reg, float& mn, float& alpha) {
  constexpr float C = SCALE * 1.4426950408889634f;
  float pmax = p0[0]; for (int r = 1; r < 16; ++r) pmax = fmaxf(pmax, p0[r]); for (int r = 0; r < 16; ++r) pmax = fmaxf(pmax, p1[r]);
  { auto rr = __builtin_amdgcn_permlane32_swap(__float_as_uint(pmax), __float_as_uint(pmax), false, false);
    pmax = fmaxf(__uint_as_float(rr[0]), __uint_as_float(rr[1])); }
  if (__builtin_expect(__all(pmax - m_reg <= THR / SCALE), 1)) { mn = m_reg; alpha = 1.f; }
  else { mn = fmaxf(m_reg, pmax); alpha = __builtin_amdgcn_exp2f((m_reg - mn) * C); m_reg = mn; }
  float mnC = -mn * C;
  for (int r = 0; r < 16; ++r) p0[r] = fmaf(p0[r], C, mnC); for (int r = 0; r < 16; ++r) p1[r] = fmaf(p1[r], C, mnC);
  for (int r = 0; r < 16; ++r) p0[r] = __builtin_amdgcn_exp2f(p0[r]);
}
__device__ __forceinline__ void finishSM(f32x16& p0, f32x16& p1, float alpha, float& l_reg, bf16x8& pa0, bf16x8& pa1, bf16x8& pa2, bf16x8& pa3) {
  for (int r = 0; r < 16; ++r) p1[r] = __builtin_amdgcn_exp2f(p1[r]);
  float ps = 0; for (int r = 0; r < 16; ++r) ps += p0[r]; for (int r = 0; r < 16; ++r) ps += p1[r];
  { auto rr = __builtin_amdgcn_permlane32_swap(__float_as_uint(ps), __float_as_uint(ps), false, false);
    ps = __uint_as_float(rr[0]) + __uint_as_float(rr[1]); }
  l_reg = l_reg * alpha + ps;
#define PK4(P, BASE, OUT) do { unsigned a0 = cvtpk(P[BASE + 0], P[BASE + 1]), a1 = cvtpk(P[BASE + 2], P[BASE + 3]);   \
    unsigned b0 = cvtpk(P[BASE + 4], P[BASE + 5]), b1 = cvtpk(P[BASE + 6], P[BASE + 7]);                              \
    auto r0 = __builtin_amdgcn_permlane32_swap(a0, b0, false, false); auto r1 = __builtin_amdgcn_permlane32_swap(a1, b1, false, false); \
    u32x4 w = {r0[0], r1[0], r0[1], r1[1]}; OUT = *reinterpret_cast<bf16x8*>(&w); } while (0)
  PK4(p0, 0, pa0); PK4(p0, 8, pa1); PK4(p1, 0, pa2); PK4(p1, 8, pa3);
#undef PK4
}
__device__ __forceinline__ void qkt(f32x16& p0, f32x16& p1, const bf16* Ks, const bf16x8* qr, int r32, int hi) {
  p0 = f32x16{}; p1 = f32x16{};
  for (int d0 = 0; d0 < 8; ++d0) { int cb = (d0 * 16 + hi * 8) * 2;
    bf16x8 b0 = *reinterpret_cast<const bf16x8*>((const char*)Ks + KSWZ(r32, cb));
    bf16x8 b1 = *reinterpret_cast<const bf16x8*>((const char*)Ks + KSWZ(32 + r32, cb));
    p0 = __builtin_amdgcn_mfma_f32_32x32x16_bf16(b0, qr[d0], p0, 0, 0, 0);
    p1 = __builtin_amdgcn_mfma_f32_32x32x16_bf16(b1, qr[d0], p1, 0, 0, 0); }
}
__device__ __forceinline__ int v_st(int k, int c) { const int kk = (k & ~0xC) | ((k & 4) << 1) | ((k & 8) >> 1); return ((kk >> 3) * 4 + (c >> 5)) * 512 + ((kk & 7) * 32 + (c & 31)) * 2; }
__device__ __forceinline__ int v_rd_base(int lane) { return ((lane & 3) << 3) | (((lane >> 2) & 3) << 6) | (((lane >> 4) & 1) << 5) | (((lane >> 5) & 1) << 8); }
constexpr int v_rd_off(int d0, int ks, int half) { return d0 * 512 + ks * 4096 + half * 2048; }
template <int OFF> __device__ __forceinline__ s16x4 tr_read(int vb) {
  s16x4 r; asm volatile("ds_read_b64_tr_b16 %0, %1 offset:%2" : "=&v"(r) : "v"(vb), "i"(OFF) : "memory"); return r;
}
template <int D0> __device__ __forceinline__ void pv_one(f32x16& od, int vb, bf16x8 pa0, bf16x8 pa1, bf16x8 pa2, bf16x8 pa3) {
  const s16x4 l0 = tr_read<v_rd_off(D0, 0, 0)>(vb), h0 = tr_read<v_rd_off(D0, 0, 1)>(vb), l1 = tr_read<v_rd_off(D0, 1, 0)>(vb), h1 = tr_read<v_rd_off(D0, 1, 1)>(vb);
  const s16x4 l2 = tr_read<v_rd_off(D0, 2, 0)>(vb), h2 = tr_read<v_rd_off(D0, 2, 1)>(vb), l3 = tr_read<v_rd_off(D0, 3, 0)>(vb), h3 = tr_read<v_rd_off(D0, 3, 1)>(vb);
  asm volatile("s_waitcnt lgkmcnt(0)" ::: "memory"); SBAR();
#define PK(L, H) (bf16x8){L[0], L[1], L[2], L[3], H[0], H[1], H[2], H[3]}
  od = __builtin_amdgcn_mfma_f32_32x32x16_bf16(pa0, PK(l0, h0), od, 0, 0, 0);
  od = __builtin_amdgcn_mfma_f32_32x32x16_bf16(pa1, PK(l1, h1), od, 0, 0, 0);
  od = __builtin_amdgcn_mfma_f32_32x32x16_bf16(pa2, PK(l2, h2), od, 0, 0, 0);
  od = __builtin_amdgcn_mfma_f32_32x32x16_bf16(pa3, PK(l3, h3), od, 0, 0, 0);
#undef PK
}
__device__ __forceinline__ void pv_d0(f32x16* o, int vb, bf16x8 pa0, bf16x8 pa1, bf16x8 pa2, bf16x8 pa3) {
  pv_one<0>(o[0], vb, pa0, pa1, pa2, pa3); pv_one<1>(o[1], vb, pa0, pa1, pa2, pa3); pv_one<2>(o[2], vb, pa0, pa1, pa2, pa3); pv_one<3>(o[3], vb, pa0, pa1, pa2, pa3);
}
__device__ __forceinline__ void attn_dense_body(const bf16* __restrict__ Qb, const bf16* __restrict__ Kc, const bf16* __restrict__ Kl, const bf16* __restrict__ Vc, const bf16* __restrict__ Vl,
                                                bf16* __restrict__ Ob, int seq, char* lds) {
  const int tid = threadIdx.x, wid = tid >> 6, lane = tid & 63, r32 = lane & 31, hi = lane >> 5;
  bf16* V_lds = (bf16*)lds; bf16* K_lds = (bf16*)(lds + 2 * SHM_V);
  float* ws = (float*)(lds + 2 * SHM_V + 2 * SHM_K) + wid * 64; float* li_l = ws; float* al_l = ws + 32;
  float m_reg = -1e30f, l_reg = 0; f32x16 o[4] = {}; bf16x8 qr[8];
  const bf16* Qw = Qb + (long)(wid * QBLK + r32) * LDQ + hi * 8;
#pragma unroll
  for (int d0 = 0; d0 < 8; ++d0) qr[d0] = *reinterpret_cast<const bf16x8*>(Qw + d0 * 16);
  const int sr = tid >> 4, sc = (tid & 15) * 8, vst0 = v_st(sr, sc), vst1 = v_st(32 + sr, sc);
  const int vb0 = (int)(uintptr_t)V_lds + v_rd_base(lane);
  struct { bf16x8 vs0, vs1, ks0, ks1; } sr_[SDEPTH];
#define SLOAD(i, k0) do { const bf16* kb_ = ((k0) < CTXN) ? Kc + (long)(k0) * LDK : Kl + (long)((k0) - CTXN) * LDK; const bf16* vb_ = ((k0) < CTXN) ? Vc + (long)(k0) * LDV : Vl + (long)((k0) - CTXN) * LDV; \
    sr_[i].vs0 = *reinterpret_cast<const bf16x8*>(&vb_[(long)sr * LDV + sc]); sr_[i].vs1 = *reinterpret_cast<const bf16x8*>(&vb_[(long)(32 + sr) * LDV + sc]); \
    sr_[i].ks0 = *reinterpret_cast<const bf16x8*>(&kb_[(long)sr * LDK + sc]); sr_[i].ks1 = *reinterpret_cast<const bf16x8*>(&kb_[(long)(32 + sr) * LDK + sc]); } while (0)
#define SWRITE(b, i) do { *(bf16x8*)((char*)V_lds + (b) * SHM_V + vst0) = sr_[i].vs0;          \
    *(bf16x8*)((char*)V_lds + (b) * SHM_V + vst1) = sr_[i].vs1; int kc = sc * 2;               \
    *(bf16x8*)((char*)K_lds + (b) * SHM_K + KSWZ(sr, kc)) = sr_[i].ks0;                       \
    *(bf16x8*)((char*)K_lds + (b) * SHM_K + KSWZ(32 + sr, kc)) = sr_[i].ks1; } while (0)
#define SWAIT() do { if constexpr (SDEPTH == 2) asm volatile("s_waitcnt vmcnt(4)" ::: "memory"); else asm volatile("s_waitcnt vmcnt(0)" ::: "memory"); } while (0)
#define RESC(a) do { if (__any((a) < 1.f)) { if (hi == 0) al_l[r32] = (a); asm volatile("s_waitcnt lgkmcnt(0)" ::: "memory"); \
    for (int d = 0; d < 4; ++d) for (int r = 0; r < 16; ++r) o[d][r] *= al_l[crow(r, hi)]; } } while (0)
  f32x16 pA0, pA1, pB0, pB1; float mnA, mnB, alA, alB; bf16x8 pa0, pa1, pa2, pa3; const int NT = seq / KVBLK;
  constexpr int SE = 0, SO = SDEPTH - 1;
  SLOAD(SE, 0); asm volatile("s_waitcnt vmcnt(0)" ::: "memory"); SWRITE(0, SE); __syncthreads();
  qkt(pA0, pA1, K_lds, qr, r32, hi); partialSM(pA0, pA1, m_reg, mnA, alA);
  SLOAD(SO, KVBLK); if constexpr (SDEPTH == 2) { if (2 < NT) SLOAD(SE, 2 * KVBLK); }
  SWAIT(); SWRITE(1, SO); __syncthreads();
  for (int j = 1; j + 1 < NT; j += 2) {
    SBAR(); qkt(pB0, pB1, (bf16*)((char*)K_lds + SHM_K), qr, r32, hi);
    finishSM(pA0, pA1, alA, l_reg, pa0, pa1, pa2, pa3); SBAR();
    SLOAD(SO, (j + SDEPTH) * KVBLK); SBAR();
    pv_d0(o, vb0, pa0, pa1, pa2, pa3); partialSM(pB0, pB1, m_reg, mnB, alB);
    __syncthreads(); SWAIT(); SWRITE(0, SE);
    RESC(alB); __syncthreads();
    SBAR(); qkt(pA0, pA1, K_lds, qr, r32, hi);
    finishSM(pB0, pB1, alB, l_reg, pa0, pa1, pa2, pa3); SBAR();
    if (SDEPTH == 1 || j + 3 < NT) SLOAD(SE, (j + 1 + SDEPTH) * KVBLK); SBAR();
    pv_d0(o, vb0 + (int)SHM_V, pa0, pa1, pa2, pa3); partialSM(pA0, pA1, m_reg, mnA, alA);
    __syncthreads(); SWAIT(); SWRITE(1, SO);
    RESC(alA); __syncthreads();
  }
  SBAR(); qkt(pB0, pB1, (bf16*)((char*)K_lds + SHM_K), qr, r32, hi);
  finishSM(pA0, pA1, alA, l_reg, pa0, pa1, pa2, pa3); SBAR();
  pv_d0(o, vb0, pa0, pa1, pa2, pa3); partialSM(pB0, pB1, m_reg, mnB, alB);
  __syncthreads(); RESC(alB);
  finishSM(pB0, pB1, alB, l_reg, pa0, pa1, pa2, pa3); SBAR();
  pv_d0(o, vb0 + (int)SHM_V, pa0, pa1, pa2, pa3);
  if (hi == 0) li_l[r32] = l_reg; asm volatile("s_waitcnt lgkmcnt(0)" ::: "memory");
  float rli[16];
#pragma unroll
  for (int r = 0; r < 16; ++r) rli[r] = __builtin_amdgcn_rcpf(li_l[crow(r, hi)]);
  bf16* Ow = Ob + (long)(wid * QBLK) * LDO;
#pragma unroll
  for (int r = 0; r < 16; ++r) { int orow = crow(r, hi);
    for (int d0 = 0; d0 < 4; ++d0) { const unsigned w = cvtpk(o[d0][r] * rli[r], 0.f); Ow[(long)orow * LDO + d0 * 32 + r32] = (bf16)(w & 0xffffu); } }
#undef SLOAD
#undef SWRITE
#undef SWAIT
#undef RESC
}
}


namespace att2 {
typedef unsigned short bf16;
using bf16x8 = __attribute__((ext_vector_type(8))) short;
using s16x4  = __attribute__((ext_vector_type(4))) short;
using f32x16 = __attribute__((ext_vector_type(16))) float;
using u32x4  = __attribute__((ext_vector_type(4))) unsigned;
typedef short v4i16_t __attribute__((ext_vector_type(4)));
typedef __attribute__((address_space(3))) const char* lds_cptr;
constexpr int KBUF = 16384, VBUF = 32768, LDS_K = 0, LDS_V = 2 * KBUF, RING = LDS_V + 3 * VBUF;
constexpr int CTXN = 256, LDO = 8192;
constexpr float SCALE = 0.088388347648318440f, THR = 8.f, C = SCALE * 1.4426950408889634f;
#define A2_WAIT_BAR(N) asm volatile("s_waitcnt vmcnt(" #N ") lgkmcnt(0)\n\ts_barrier" ::: "memory")
__device__ __forceinline__ void glds16(const void* gsrc, unsigned lds_dst) { unsigned keep;
  asm volatile("s_mov_b32 %0, m0\n\ts_mov_b32 m0, %2\n\ts_nop 0\n\tglobal_load_lds_dwordx4 %1, off\n\ts_mov_b32 m0, %0" : "=&s"(keep) : "v"(gsrc), "s"(lds_dst) : "memory"); }
__device__ __forceinline__ int crow(int r, int hi) { return (r & 3) + 8 * (r >> 2) + 4 * hi; }
__device__ __forceinline__ unsigned cvtpk(float lo, float hi) { unsigned r; asm volatile("v_cvt_pk_bf16_f32 %0, %1, %2" : "=v"(r) : "v"(lo), "v"(hi)); return r; }
__device__ __forceinline__ s16x4 vtr(lds_cptr p) { return __builtin_bit_cast(s16x4, __builtin_amdgcn_ds_read_tr16_b64_v4i16((__attribute__((address_space(3))) v4i16_t*)p)); }
__device__ __forceinline__ int v_rd_base(int lane) { return ((lane & 3) << 3) | (((lane >> 2) & 3) << 6) | (((lane >> 4) & 1) << 5) | (((lane >> 5) & 1) << 8); }

__device__ __forceinline__ void qkt(f32x16& p, lds_cptr kb, const bf16x8* qr, int krow, int hi) {
  p = f32x16{};
#pragma unroll
  for (int d0 = 0; d0 < 8; ++d0) { const int cb = d0 * 32 + hi * 16;
    const bf16x8 kf = *(const __attribute__((address_space(3))) bf16x8*)(kb + krow * 256 + (cb ^ ((krow & 7) << 4)));
    p = __builtin_amdgcn_mfma_f32_32x32x16_bf16(kf, qr[d0], p, 0, 0, 0); }
}
__device__ __forceinline__ void pv(f32x16* o, lds_cptr vp, bf16x8 pa0, bf16x8 pa1) {
#define A2_PK(L, H) (bf16x8){L[0], L[1], L[2], L[3], H[0], H[1], H[2], H[3]}
#pragma unroll
  for (int d0 = 0; d0 < 8; ++d0) {
    const s16x4 l0 = vtr(vp + d0 * 512), h0 = vtr(vp + d0 * 512 + 4096), l1 = vtr(vp + d0 * 512 + 8192), h1 = vtr(vp + d0 * 512 + 8192 + 4096);
    o[d0] = __builtin_amdgcn_mfma_f32_32x32x16_bf16(pa0, A2_PK(l0, h0), o[d0], 0, 0, 0);
    o[d0] = __builtin_amdgcn_mfma_f32_32x32x16_bf16(pa1, A2_PK(l1, h1), o[d0], 0, 0, 0); }
#undef A2_PK
}
__device__ __forceinline__ void softmax_step(f32x16& p, float& m_reg, float& l_reg, float& alpha, bf16x8& pa0, bf16x8& pa1) {
  float pmax = p[0];
#pragma unroll
  for (int r = 1; r < 16; ++r) pmax = fmaxf(pmax, p[r]);
  { auto rr = __builtin_amdgcn_permlane32_swap(__float_as_uint(pmax), __float_as_uint(pmax), false, false); pmax = fmaxf(__uint_as_float(rr[0]), __uint_as_float(rr[1])); }
  const bool keep = __all(pmax - m_reg <= THR / SCALE);
  const float mn = keep ? m_reg : fmaxf(m_reg, pmax);
  alpha = keep ? 1.f : __builtin_amdgcn_exp2f((m_reg - mn) * C);
  m_reg = mn;
  const float mnC = -mn * C;
#pragma unroll
  for (int r = 0; r < 16; ++r) p[r] = __builtin_amdgcn_exp2f(fmaf(p[r], C, mnC));
  float ps = 0.f;
#pragma unroll
  for (int r = 0; r < 16; ++r) ps += p[r];
  { auto rr = __builtin_amdgcn_permlane32_swap(__float_as_uint(ps), __float_as_uint(ps), false, false); ps = __uint_as_float(rr[0]) + __uint_as_float(rr[1]); }
  l_reg = l_reg * alpha + ps;
#define A2_PK4(P, BASE, OUT) do { unsigned a0 = cvtpk(P[BASE + 0], P[BASE + 1]), a1 = cvtpk(P[BASE + 2], P[BASE + 3]);   \
    unsigned b0 = cvtpk(P[BASE + 4], P[BASE + 5]), b1 = cvtpk(P[BASE + 6], P[BASE + 7]);                              \
    auto r0 = __builtin_amdgcn_permlane32_swap(a0, b0, false, false); auto r1 = __builtin_amdgcn_permlane32_swap(a1, b1, false, false); \
    u32x4 w = {r0[0], r1[0], r0[1], r1[1]}; OUT = __builtin_bit_cast(bf16x8, w); } while (0)
  A2_PK4(p, 0, pa0); A2_PK4(p, 8, pa1);
#undef A2_PK4
}

__device__ __forceinline__ void attn_unit(const bf16* __restrict__ Qb, const bf16* __restrict__ Kc, const bf16* __restrict__ Kl, const bf16* __restrict__ Vc, const bf16* __restrict__ Vl,
                                          bf16* __restrict__ Ob, int seq, char* shm, float* sml) {
  int tid = threadIdx.x; asm volatile("" : "+v"(tid));
  const int lane = tid & 63, r32 = lane & 31, hi = lane >> 5; const int wid = __builtin_amdgcn_readfirstlane(tid >> 6), rg = wid & 3, kh = wid >> 2;
  const unsigned lds0 = (unsigned)(uintptr_t)shm; const lds_cptr shm3 = (lds_cptr)shm;
  float* wsf = sml + wid * 128; float* wsp = sml + (wid ^ 4) * 128;
  unsigned koff[2], voff[4];
#pragma unroll
  for (int i = 0; i < 2; ++i) { const int q = wid * 2 + i, row = 4 * q + (lane >> 4); koff[i] = (unsigned)(row * 256 + (((lane & 15) << 4) ^ ((row & 7) << 4))); }
#pragma unroll
  for (int i = 0; i < 4; ++i) { const int q = wid * 4 + i, st = 2 * q + (lane >> 5), kk = (st >> 3) * 8 + ((lane & 31) >> 2), k = (kk & ~0xC) | ((kk & 4) << 1) | ((kk & 8) >> 1), c = (st & 7) * 32 + (lane & 3) * 8;
    voff[i] = (unsigned)(k * 512 + c * 2); }
  const unsigned kdst = lds0 + LDS_K + wid * 2048, vdst = lds0 + LDS_V + wid * 4096;
#define A2_DMA(t, kslot, vslot) do { const int k0_ = (t) * 64; \
    const char* kt_ = (k0_ < CTXN) ? (const char*)Kc + (size_t)k0_ * 256 : (const char*)Kl + (size_t)(k0_ - CTXN) * 256; \
    const char* vt_ = (k0_ < CTXN) ? (const char*)Vc + (size_t)k0_ * 512 : (const char*)Vl + (size_t)(k0_ - CTXN) * 512; \
    _Pragma("unroll") for (int i_ = 0; i_ < 2; ++i_) glds16(kt_ + koff[i_], (unsigned)__builtin_amdgcn_readfirstlane(kdst + i_ * 1024 + (kslot))); \
    _Pragma("unroll") for (int i_ = 0; i_ < 4; ++i_) glds16(vt_ + voff[i_], (unsigned)__builtin_amdgcn_readfirstlane(vdst + i_ * 1024 + (vslot))); } while (0)
  const int NT = seq / 64;
  bf16x8 qr[8];
  { const bf16* Qw = Qb + (size_t)(rg * 32 + r32) * 128 + hi * 8;
#pragma unroll
    for (int d0 = 0; d0 < 8; ++d0) qr[d0] = *reinterpret_cast<const bf16x8*>(Qw + d0 * 16); }
  if (kh) __builtin_amdgcn_s_setprio(1);
  { const char* k0p = (const char*)Kc; const char* v0p = (const char*)Vc;
#pragma unroll
    for (int i = 0; i < 2; ++i) glds16(k0p + koff[i], (unsigned)__builtin_amdgcn_readfirstlane(kdst + i * 1024));
#pragma unroll
    for (int i = 0; i < 2; ++i) glds16(k0p + 64 * 256 + koff[i], (unsigned)__builtin_amdgcn_readfirstlane(kdst + KBUF + i * 1024));
#pragma unroll
    for (int i = 0; i < 4; ++i) glds16(v0p + voff[i], (unsigned)__builtin_amdgcn_readfirstlane(vdst + i * 1024)); }
  const int krow = kh * 32 + r32, kx = (krow & 7) << 4;
  const lds_cptr kp0 = shm3 + LDS_K + krow * 256, vp0 = shm3 + LDS_V + v_rd_base(lane) + kh * 16384;
  float m_reg = -1e30f, l_reg = 0.f, alpha = 1.f; f32x16 o[8];
#pragma unroll
  for (int d = 0; d < 8; ++d) o[d] = f32x16{};
  f32x16 pA, pB; bf16x8 pa0, pa1;
#define A2_SB() __builtin_amdgcn_sched_barrier(0)
#define A2_PK(L, H) (bf16x8){L[0], L[1], L[2], L[3], H[0], H[1], H[2], H[3]}
#define A2_KLD(d0) (*(const __attribute__((address_space(3))) bf16x8*)(kb + ((((d0) * 32 + hi * 16)) ^ kx)))
#define A2_VLDA(S, d0) do { S##0 = vtr(vp + (d0) * 512); S##1 = vtr(vp + (d0) * 512 + 4096); } while (0)
#define A2_VLDB(S, d0) do { S##0 = vtr(vp + (d0) * 512 + 8192); S##1 = vtr(vp + (d0) * 512 + 12288); } while (0)
#define A2_PVA(d0, S) o[d0] = __builtin_amdgcn_mfma_f32_32x32x16_bf16(pa0, A2_PK(S##0, S##1), o[d0], 0, 0, 0)
#define A2_PVB(d0, S) o[d0] = __builtin_amdgcn_mfma_f32_32x32x16_bf16(pa1, A2_PK(S##0, S##1), o[d0], 0, 0, 0)
#define A2_MAX3(a, b, c) fmaxf(fmaxf((a), (b)), (c))
#define A2_E4(P, i) do { P[i] = __builtin_amdgcn_exp2f(fmaf(P[i], C, mnC)); P[(i) + 1] = __builtin_amdgcn_exp2f(fmaf(P[(i) + 1], C, mnC)); \
    P[(i) + 2] = __builtin_amdgcn_exp2f(fmaf(P[(i) + 2], C, mnC)); P[(i) + 3] = __builtin_amdgcn_exp2f(fmaf(P[(i) + 3], C, mnC)); } while (0)
#define A2_PACK(P, BASE, OUT) do { unsigned a0 = cvtpk(P[BASE + 0], P[BASE + 1]), a1 = cvtpk(P[BASE + 2], P[BASE + 3]);   \
    unsigned b0 = cvtpk(P[BASE + 4], P[BASE + 5]), b1 = cvtpk(P[BASE + 6], P[BASE + 7]);                              \
    auto r0 = __builtin_amdgcn_permlane32_swap(a0, b0, false, false); auto r1 = __builtin_amdgcn_permlane32_swap(a1, b1, false, false); \
    u32x4 w = {r0[0], r1[0], r0[1], r1[1]}; OUT = __builtin_bit_cast(bf16x8, w); } while (0)
#define A2_STEP(PC, PN, KRD, KST, VRD, VST, j) do { \
    A2_WAIT_BAR(0); \
    const int tk_ = ((j) + 2 < NT) ? (j) + 2 : NT - 1, tv_ = ((j) + 1 < NT) ? (j) + 1 : NT - 1; \
    const char* ktn = (tk_ * 64 < CTXN) ? (const char*)Kc + (size_t)(tk_ * 64) * 256 : (const char*)Kl + (size_t)(tk_ * 64 - CTXN) * 256; \
    const char* vtn = (tv_ * 64 < CTXN) ? (const char*)Vc + (size_t)(tv_ * 64) * 512 : (const char*)Vl + (size_t)(tv_ * 64 - CTXN) * 512; \
    const unsigned kdn = (unsigned)__builtin_amdgcn_readfirstlane(kdst + (KST)), vdn = (unsigned)__builtin_amdgcn_readfirstlane(vdst + (VST)); \
    const lds_cptr kb = kp0 + (KRD); const lds_cptr vp = vp0 + (VRD); \
    bf16x8 ka, kc; s16x4 va0, va1, vb0, vb1; \
    ka = A2_KLD(0); kc = A2_KLD(1); A2_SB(); \
    PN = __builtin_amdgcn_mfma_f32_32x32x16_bf16(ka, qr[0], f32x16{}, 0, 0, 0); ka = A2_KLD(2); glds16(ktn + koff[0], kdn); \
    const float x1_ = A2_MAX3(PC[0], PC[1], PC[2]), x2_ = A2_MAX3(PC[3], PC[4], PC[5]), x3_ = A2_MAX3(PC[6], PC[7], PC[8]), x4_ = A2_MAX3(PC[9], PC[10], PC[11]), x5_ = A2_MAX3(PC[12], PC[13], PC[14]); A2_SB(); \
    PN = __builtin_amdgcn_mfma_f32_32x32x16_bf16(kc, qr[1], PN, 0, 0, 0); kc = A2_KLD(3); glds16(ktn + koff[1], kdn + 1024); \
    float pmax = fmaxf(A2_MAX3(x1_, x2_, x3_), A2_MAX3(x4_, x5_, PC[15])); \
    { auto rr = __builtin_amdgcn_permlane32_swap(__float_as_uint(pmax), __float_as_uint(pmax), false, false); pmax = fmaxf(__uint_as_float(rr[0]), __uint_as_float(rr[1])); } A2_SB(); \
    PN = __builtin_amdgcn_mfma_f32_32x32x16_bf16(ka, qr[2], PN, 0, 0, 0); ka = A2_KLD(4); glds16(vtn + voff[0], vdn); \
    const float mn = (pmax - m_reg > THR / SCALE) ? fmaxf(m_reg, pmax) : m_reg; \
    alpha = __builtin_amdgcn_exp2f((m_reg - mn) * C); m_reg = mn; const float mnC = -mn * C; A2_SB(); \
    PN = __builtin_amdgcn_mfma_f32_32x32x16_bf16(kc, qr[3], PN, 0, 0, 0); kc = A2_KLD(5); glds16(vtn + voff[1], vdn + 1024); A2_E4(PC, 0); A2_SB(); \
    PN = __builtin_amdgcn_mfma_f32_32x32x16_bf16(ka, qr[4], PN, 0, 0, 0); ka = A2_KLD(6); glds16(vtn + voff[2], vdn + 2048); A2_E4(PC, 4); float sa = PC[0] + PC[1], sb = PC[2] + PC[3]; A2_SB(); \
    PN = __builtin_amdgcn_mfma_f32_32x32x16_bf16(kc, qr[5], PN, 0, 0, 0); kc = A2_KLD(7); glds16(vtn + voff[3], vdn + 3072); A2_E4(PC, 8); sa += PC[4]; sb += PC[5]; sa += PC[6]; sb += PC[7]; A2_SB(); \
    PN = __builtin_amdgcn_mfma_f32_32x32x16_bf16(ka, qr[6], PN, 0, 0, 0); A2_VLDA(va, 0); A2_E4(PC, 12); sa += PC[8]; sb += PC[9]; sa += PC[10]; sb += PC[11]; A2_SB(); \
    PN = __builtin_amdgcn_mfma_f32_32x32x16_bf16(kc, qr[7], PN, 0, 0, 0); A2_VLDA(vb, 1); sa += PC[12]; sb += PC[13]; sa += PC[14]; sb += PC[15]; float ps = sa + sb; \
    { auto rr = __builtin_amdgcn_permlane32_swap(__float_as_uint(ps), __float_as_uint(ps), false, false); ps = __uint_as_float(rr[0]) + __uint_as_float(rr[1]); } \
    l_reg = l_reg * alpha + ps; A2_PACK(PC, 0, pa0); A2_SB(); \
    if (__any(alpha < 1.f)) { if (hi == 0) wsf[r32] = alpha; asm volatile("s_waitcnt lgkmcnt(0)" ::: "memory"); \
      _Pragma("unroll") for (int r = 0; r < 16; ++r) { const float a_ = wsf[crow(r, hi)]; \
        _Pragma("unroll") for (int d = 0; d < 8; ++d) o[d][r] *= a_; } } \
    A2_PVA(0, va); A2_VLDA(va, 2); { unsigned a0 = cvtpk(PC[8], PC[9]), a1 = cvtpk(PC[10], PC[11]), b0 = cvtpk(PC[12], PC[13]), b1 = cvtpk(PC[14], PC[15]); \
      auto r0 = __builtin_amdgcn_permlane32_swap(a0, b0, false, false); auto r1 = __builtin_amdgcn_permlane32_swap(a1, b1, false, false); u32x4 w = {r0[0], r1[0], r0[1], r1[1]}; pa1 = __builtin_bit_cast(bf16x8, w); } A2_SB(); \
    A2_PVA(1, vb); A2_VLDA(vb, 3); A2_SB(); A2_PVA(2, va); A2_VLDA(va, 4); A2_SB(); A2_PVA(3, vb); A2_VLDA(vb, 5); A2_SB(); \
    A2_PVA(4, va); A2_VLDA(va, 6); A2_SB(); A2_PVA(5, vb); A2_VLDA(vb, 7); A2_SB(); A2_PVA(6, va); A2_VLDB(va, 0); A2_SB(); A2_PVA(7, vb); A2_VLDB(vb, 1); A2_SB(); \
    A2_PVB(0, va); A2_VLDB(va, 2); A2_SB(); A2_PVB(1, vb); A2_VLDB(vb, 3); A2_SB(); A2_PVB(2, va); A2_VLDB(va, 4); A2_SB(); A2_PVB(3, vb); A2_VLDB(vb, 5); A2_SB(); \
    A2_PVB(4, va); A2_VLDB(va, 6); A2_SB(); A2_PVB(5, vb); A2_VLDB(vb, 7); A2_SB(); A2_PVB(6, va); A2_SB(); A2_PVB(7, vb); A2_SB(); } while (0)
  A2_WAIT_BAR(0);
  qkt(pA, shm3 + LDS_K, qr, krow, hi);
  for (int j = 0; j < NT; j += 2) {
    A2_STEP(pA, pB, KBUF, 0, 0, VBUF, j);
    A2_STEP(pB, pA, 0, KBUF, VBUF, 0, j + 1);
  }
#undef A2_STEP
#undef A2_PACK
#undef A2_E4
#undef A2_MAX3
#undef A2_PVA
#undef A2_PVB
#undef A2_VLDA
#undef A2_VLDB
#undef A2_KLD
#undef A2_PK
#undef A2_SB
  if (hi == 0) { wsf[32 + r32] = m_reg; wsf[64 + r32] = l_reg; }
  A2_WAIT_BAR(0);
  { const float pm = wsp[32 + r32], pl = wsp[64 + r32], M = fmaxf(m_reg, pm);
    const float fs = __builtin_amdgcn_exp2f((m_reg - M) * C), fp = __builtin_amdgcn_exp2f((pm - M) * C);
    const float Ltot = l_reg * fs + pl * fp;
    if (hi == 0) wsf[r32] = fs * __builtin_amdgcn_rcpf(Ltot); }
  asm volatile("s_waitcnt lgkmcnt(0)" ::: "memory");
  float fr_[16];
#pragma unroll
  for (int r = 0; r < 16; ++r) fr_[r] = wsf[crow(r, hi)];
  int lane2 = lane; asm volatile("" : "+v"(lane2));
  const int r32b = lane2 & 31, hib = lane2 >> 5;
  float* xs = (float*)shm + wid * 4096 + lane2; const float* xr = (const float*)shm + (wid ^ 4) * 4096 + lane2;
  bf16* Ow = Ob + (size_t)(rg * 32) * LDO + r32b;
  if (kh == 0) {
#pragma unroll
    for (int d = 0; d < 4; ++d)
#pragma unroll
      for (int r = 0; r < 16; ++r) xs[(d * 16 + r) * 64] = o[4 + d][r] * fr_[r];
    A2_WAIT_BAR(0);
#pragma unroll
    for (int d = 0; d < 4; ++d)
#pragma unroll
      for (int r = 0; r < 16; ++r) { const float v = o[d][r] * fr_[r] + xr[(d * 16 + r) * 64]; Ow[(size_t)crow(r, hib) * LDO + d * 32] = (bf16)(cvtpk(v, 0.f) & 0xffffu); }
  } else {
#pragma unroll
    for (int d = 0; d < 4; ++d)
#pragma unroll
      for (int r = 0; r < 16; ++r) xs[(d * 16 + r) * 64] = o[d][r] * fr_[r];
    A2_WAIT_BAR(0);
#pragma unroll
    for (int d = 0; d < 4; ++d)
#pragma unroll
      for (int r = 0; r < 16; ++r) { const float v = o[4 + d][r] * fr_[r] + xr[(d * 16 + r) * 64]; Ow[(size_t)crow(r, hib) * LDO + 128 + d * 32] = (bf16)(cvtpk(v, 0.f) & 0xffffu); }
  }
  A2_WAIT_BAR(0);
  __builtin_amdgcn_s_setprio(0);
#undef A2_DMA
}

__device__ __forceinline__ void attn_unit256(const bf16* __restrict__ Qb, const bf16* __restrict__ Kc, const bf16* __restrict__ Kl, const bf16* __restrict__ Vc, const bf16* __restrict__ Vl,
                                             bf16* __restrict__ Ob, int seq, char* shm, float* sml) {
  int tid = threadIdx.x; asm volatile("" : "+v"(tid));
  const int lane = tid & 63, r32 = lane & 31, hi = lane >> 5; const int wid = __builtin_amdgcn_readfirstlane(tid >> 6);
  const unsigned lds0 = (unsigned)(uintptr_t)shm; const lds_cptr shm3 = (lds_cptr)shm;
  float* wsf = sml + wid * 128;
  unsigned koff[2], voff[4];
#pragma unroll
  for (int i = 0; i < 2; ++i) { const int q = wid * 2 + i, row = 4 * q + (lane >> 4); koff[i] = (unsigned)(row * 256 + (((lane & 15) << 4) ^ ((row & 7) << 4))); }
#pragma unroll
  for (int i = 0; i < 4; ++i) { const int q = wid * 4 + i, st = 2 * q + (lane >> 5), kk = (st >> 3) * 8 + ((lane & 31) >> 2), k = (kk & ~0xC) | ((kk & 4) << 1) | ((kk & 8) >> 1), c = (st & 7) * 32 + (lane & 3) * 8;
    voff[i] = (unsigned)(k * 512 + c * 2); }
  const unsigned kdst = lds0 + LDS_K + wid * 2048, vdst = lds0 + LDS_V + wid * 4096;
  const int NT = seq / 64;
  bf16x8 qr[8];
  { const bf16* Qw = Qb + (size_t)(wid * 32 + r32) * 128 + hi * 8;
#pragma unroll
    for (int d0 = 0; d0 < 8; ++d0) qr[d0] = *reinterpret_cast<const bf16x8*>(Qw + d0 * 16); }
  { const char* k0p = (const char*)Kc; const char* v0p = (const char*)Vc;
#pragma unroll
    for (int i = 0; i < 2; ++i) glds16(k0p + koff[i], (unsigned)__builtin_amdgcn_readfirstlane(kdst + i * 1024));
#pragma unroll
    for (int i = 0; i < 4; ++i) glds16(v0p + voff[i], (unsigned)__builtin_amdgcn_readfirstlane(vdst + i * 1024)); }
  const int kx = (r32 & 7) << 4;
  const lds_cptr kp0 = shm3 + LDS_K + r32 * 256, vp0 = shm3 + LDS_V + v_rd_base(lane);
  float m_reg = -1e30f, l_reg = 0.f, alpha = 1.f; f32x16 o[8];
#pragma unroll
  for (int d = 0; d < 8; ++d) o[d] = f32x16{};
  f32x16 p; bf16x8 pa0, pa1;
#define A5_SB() __builtin_amdgcn_sched_barrier(0)
#define A5_PK(L, H) (bf16x8){L[0], L[1], L[2], L[3], H[0], H[1], H[2], H[3]}
#define A5_KLD(d0) (*(const __attribute__((address_space(3))) bf16x8*)(kb + ((((d0) * 32 + hi * 16)) ^ kx)))
#define A5_VLDA(S, d0) do { S##0 = vtr(vp + (d0) * 512); S##1 = vtr(vp + (d0) * 512 + 4096); } while (0)
#define A5_VLDB(S, d0) do { S##0 = vtr(vp + (d0) * 512 + 8192); S##1 = vtr(vp + (d0) * 512 + 12288); } while (0)
#define A5_PVA(d0, S) o[d0] = __builtin_amdgcn_mfma_f32_32x32x16_bf16(pa0, A5_PK(S##0, S##1), o[d0], 0, 0, 0)
#define A5_PVB(d0, S) o[d0] = __builtin_amdgcn_mfma_f32_32x32x16_bf16(pa1, A5_PK(S##0, S##1), o[d0], 0, 0, 0)
#define A5_MAX3(a, b, c) fmaxf(fmaxf((a), (b)), (c))
#define A5_NOPIECE(i) do { } while (0)
#define A5_PIECE(i) do { if ((i) == 0) glds16(ktn + koff[0], kdn); else if ((i) == 1) glds16(ktn + koff[1], kdn + 1024); else glds16(vtn + voff[(i) - 2], vdn + ((i) - 2) * 1024); } while (0)
#define A5_HALF(KOFF, VOFF, PIECE) do { \
    const lds_cptr kb = kp0 + (KOFF); const lds_cptr vp = vp0 + (VOFF); \
    bf16x8 ka, kc; s16x4 va0, va1, vb0, vb1; \
    ka = A5_KLD(0); kc = A5_KLD(1); A5_SB(); \
    p = __builtin_amdgcn_mfma_f32_32x32x16_bf16(ka, qr[0], f32x16{}, 0, 0, 0); ka = A5_KLD(2); PIECE(0); A5_SB(); \
    p = __builtin_amdgcn_mfma_f32_32x32x16_bf16(kc, qr[1], p, 0, 0, 0); kc = A5_KLD(3); PIECE(1); A5_SB(); \
    p = __builtin_amdgcn_mfma_f32_32x32x16_bf16(ka, qr[2], p, 0, 0, 0); ka = A5_KLD(4); PIECE(2); A5_SB(); \
    p = __builtin_amdgcn_mfma_f32_32x32x16_bf16(kc, qr[3], p, 0, 0, 0); kc = A5_KLD(5); PIECE(3); A5_SB(); \
    p = __builtin_amdgcn_mfma_f32_32x32x16_bf16(ka, qr[4], p, 0, 0, 0); ka = A5_KLD(6); PIECE(4); A5_SB(); \
    p = __builtin_amdgcn_mfma_f32_32x32x16_bf16(kc, qr[5], p, 0, 0, 0); kc = A5_KLD(7); PIECE(5); A5_SB(); \
    p = __builtin_amdgcn_mfma_f32_32x32x16_bf16(ka, qr[6], p, 0, 0, 0); A5_VLDA(va, 0); A5_SB(); \
    p = __builtin_amdgcn_mfma_f32_32x32x16_bf16(kc, qr[7], p, 0, 0, 0); A5_VLDA(vb, 1); A5_SB(); \
    const float x1_ = A5_MAX3(p[0], p[1], p[2]), x2_ = A5_MAX3(p[3], p[4], p[5]), x3_ = A5_MAX3(p[6], p[7], p[8]), x4_ = A5_MAX3(p[9], p[10], p[11]), x5_ = A5_MAX3(p[12], p[13], p[14]); \
    float pmax = fmaxf(A5_MAX3(x1_, x2_, x3_), A5_MAX3(x4_, x5_, p[15])); \
    { auto rr = __builtin_amdgcn_permlane32_swap(__float_as_uint(pmax), __float_as_uint(pmax), false, false); pmax = fmaxf(__uint_as_float(rr[0]), __uint_as_float(rr[1])); } \
    const float mn = (pmax - m_reg > THR / SCALE) ? fmaxf(m_reg, pmax) : m_reg; \
    alpha = __builtin_amdgcn_exp2f((m_reg - mn) * C); m_reg = mn; const float mnC = -mn * C; \
    _Pragma("unroll") for (int r = 0; r < 16; ++r) p[r] = __builtin_amdgcn_exp2f(fmaf(p[r], C, mnC)); \
    float ps = ((p[0] + p[1]) + (p[2] + p[3])) + ((p[4] + p[5]) + (p[6] + p[7])); ps += ((p[8] + p[9]) + (p[10] + p[11])) + ((p[12] + p[13]) + (p[14] + p[15])); \
    { auto rr = __builtin_amdgcn_permlane32_swap(__float_as_uint(ps), __float_as_uint(ps), false, false); ps = __uint_as_float(rr[0]) + __uint_as_float(rr[1]); } \
    l_reg = l_reg * alpha + ps; \
    { unsigned a0 = cvtpk(p[0], p[1]), a1 = cvtpk(p[2], p[3]), b0 = cvtpk(p[4], p[5]), b1 = cvtpk(p[6], p[7]); \
      auto r0 = __builtin_amdgcn_permlane32_swap(a0, b0, false, false); auto r1 = __builtin_amdgcn_permlane32_swap(a1, b1, false, false); u32x4 w = {r0[0], r1[0], r0[1], r1[1]}; pa0 = __builtin_bit_cast(bf16x8, w); } \
    { unsigned a0 = cvtpk(p[8], p[9]), a1 = cvtpk(p[10], p[11]), b0 = cvtpk(p[12], p[13]), b1 = cvtpk(p[14], p[15]); \
      auto r0 = __builtin_amdgcn_permlane32_swap(a0, b0, false, false); auto r1 = __builtin_amdgcn_permlane32_swap(a1, b1, false, false); u32x4 w = {r0[0], r1[0], r0[1], r1[1]}; pa1 = __builtin_bit_cast(bf16x8, w); } \
    if (__any(alpha < 1.f)) { if (hi == 0) wsf[r32] = alpha; asm volatile("s_waitcnt lgkmcnt(0)" ::: "memory"); \
      _Pragma("unroll") for (int r = 0; r < 16; ++r) { const float a_ = wsf[crow(r, hi)]; \
        _Pragma("unroll") for (int d = 0; d < 8; ++d) o[d][r] *= a_; } } \
    A5_SB(); \
    A5_PVA(0, va); A5_VLDA(va, 2); A5_SB(); A5_PVA(1, vb); A5_VLDA(vb, 3); A5_SB(); A5_PVA(2, va); A5_VLDA(va, 4); A5_SB(); A5_PVA(3, vb); A5_VLDA(vb, 5); A5_SB(); \
    A5_PVA(4, va); A5_VLDA(va, 6); A5_SB(); A5_PVA(5, vb); A5_VLDA(vb, 7); A5_SB(); A5_PVA(6, va); A5_VLDB(va, 0); A5_SB(); A5_PVA(7, vb); A5_VLDB(vb, 1); A5_SB(); \
    A5_PVB(0, va); A5_VLDB(va, 2); A5_SB(); A5_PVB(1, vb); A5_VLDB(vb, 3); A5_SB(); A5_PVB(2, va); A5_VLDB(va, 4); A5_SB(); A5_PVB(3, vb); A5_VLDB(vb, 5); A5_SB(); \
    A5_PVB(4, va); A5_VLDB(va, 6); A5_SB(); A5_PVB(5, vb); A5_VLDB(vb, 7); A5_SB(); A5_PVB(6, va); A5_SB(); A5_PVB(7, vb); A5_SB(); } while (0)
#define A5_TILE(KS, VS, KSN, VSN, j) do { \
    A2_WAIT_BAR(0); \
    const int tn_ = ((j) + 1 < NT) ? (j) + 1 : NT - 1; \
    const char* ktn = (tn_ * 64 < CTXN) ? (const char*)Kc + (size_t)(tn_ * 64) * 256 : (const char*)Kl + (size_t)(tn_ * 64 - CTXN) * 256; \
    const char* vtn = (tn_ * 64 < CTXN) ? (const char*)Vc + (size_t)(tn_ * 64) * 512 : (const char*)Vl + (size_t)(tn_ * 64 - CTXN) * 512; \
    const unsigned kdn = (unsigned)__builtin_amdgcn_readfirstlane(kdst + (KSN)), vdn = (unsigned)__builtin_amdgcn_readfirstlane(vdst + (VSN)); \
    A5_HALF((KS), (VS), A5_PIECE); \
    A5_HALF((KS) + 8192, (VS) + 16384, A5_NOPIECE); } while (0)
  for (int j = 0; j < NT; j += 2) {
    A5_TILE(0, 0, KBUF, VBUF, j);
    A5_TILE(KBUF, VBUF, 0, 0, j + 1);
  }
#undef A5_TILE
#undef A5_HALF
#undef A5_PIECE
#undef A5_NOPIECE
#undef A5_MAX3
#undef A5_PVA
#undef A5_PVB
#undef A5_VLDA
#undef A5_VLDB
#undef A5_KLD
#undef A5_PK
#undef A5_SB
  if (hi == 0) wsf[32 + r32] = l_reg;
  asm volatile("s_waitcnt lgkmcnt(0)" ::: "memory");
  int lane2 = lane; asm volatile("" : "+v"(lane2));
  const int r32b = lane2 & 31, hib = lane2 >> 5;
  float rli[16];
#pragma unroll
  for (int r = 0; r < 16; ++r) rli[r] = __builtin_amdgcn_rcpf(wsf[32 + crow(r, hib)]);
  bf16* Ow = Ob + (size_t)(wid * 32) * LDO + r32b;
#pragma unroll
  for (int r = 0; r < 16; ++r)
#pragma unroll
    for (int d = 0; d < 8; ++d) Ow[(size_t)crow(r, hib) * LDO + d * 32] = (bf16)(cvtpk(o[d][r] * rli[r], 0.f) & 0xffffu);
  A2_WAIT_BAR(0);
}

using i32x4v = __attribute__((ext_vector_type(4))) int;
using i32x16 = __attribute__((ext_vector_type(16))) int;
using f32x4v = __attribute__((ext_vector_type(4))) float;
__device__ __forceinline__ unsigned q8p(float a, float b, float c, float d) {
  const int ia = (int)__builtin_rintf(a), ib = (int)__builtin_rintf(b), ic = (int)__builtin_rintf(c), id = (int)__builtin_rintf(d);
  return (unsigned)(ia & 255) | ((unsigned)(ib & 255) << 8) | ((unsigned)(ic & 255) << 16) | ((unsigned)id << 24); }
__device__ __forceinline__ float blo(unsigned w) { return __uint_as_float(w << 16); }
__device__ __forceinline__ float bhi(unsigned w) { return __uint_as_float(w & 0xffff0000u); }
__device__ __forceinline__ void attn_unit256q(const bf16* __restrict__ Qb, const unsigned char* __restrict__ Kc, const unsigned char* __restrict__ Kl, const float* __restrict__ Sc, const float* __restrict__ Sl,
                                              const bf16* __restrict__ Vc, const bf16* __restrict__ Vl, bf16* __restrict__ Ob, int seq, char* shm, float* sml) {
  int tid = threadIdx.x; asm volatile("" : "+v"(tid));
  const int lane = tid & 63, r32 = lane & 31, hi = lane >> 5; const int wid = __builtin_amdgcn_readfirstlane(tid >> 6);
  const unsigned lds0 = (unsigned)(uintptr_t)shm; const lds_cptr shm3 = (lds_cptr)shm;
  float* wsf = sml + wid * 128;
  unsigned koff, voff[4];
  { const int row = wid * 8 + (lane >> 3); koff = (unsigned)(row * 128 + (((lane & 7) ^ (row & 7)) << 4)); }
#pragma unroll
  for (int i = 0; i < 4; ++i) { const int q = wid * 4 + i, st = 2 * q + (lane >> 5), kk = (st >> 3) * 8 + ((lane & 31) >> 2), k = (kk & ~0xC) | ((kk & 4) << 1) | ((kk & 8) >> 1), c = (st & 7) * 32 + (lane & 3) * 8;
    voff[i] = (unsigned)(k * 512 + c * 2); }
  const unsigned kdst = lds0 + LDS_K + wid * 1024, vdst = lds0 + LDS_V + wid * 4096;
  const int NT = seq / 64;
  i32x4v qr[4]; float Cq, thrq;
  { const u32x4* Qw = (const u32x4*)(Qb + (size_t)(wid * 32 + r32) * 128 + hi * 16);
    u32x4 qa[4], qb[4];
#pragma unroll
    for (int d0 = 0; d0 < 4; ++d0) { qa[d0] = Qw[d0 * 4]; qb[d0] = Qw[d0 * 4 + 1]; }
    float mx = 0.f;
#define Q5_MX(w) mx = fmaxf(mx, fmaxf(__builtin_fabsf(blo(w)), __builtin_fabsf(bhi(w))))
#pragma unroll
    for (int d0 = 0; d0 < 4; ++d0) { Q5_MX(qa[d0].x); Q5_MX(qa[d0].y); Q5_MX(qa[d0].z); Q5_MX(qa[d0].w); Q5_MX(qb[d0].x); Q5_MX(qb[d0].y); Q5_MX(qb[d0].z); Q5_MX(qb[d0].w); }
#undef Q5_MX
    { auto rr = __builtin_amdgcn_permlane32_swap(__float_as_uint(mx), __float_as_uint(mx), false, false); mx = fmaxf(__uint_as_float(rr[0]), __uint_as_float(rr[1])); }
    const float inv = mx > 0.f ? 127.f / mx : 0.f, qs = mx * (1.f / 127.f);
    Cq = C * qs; thrq = mx > 0.f ? THR / (SCALE * qs) : 3.0e38f;
#define Q5_Q2(w0, w1) q8p(blo(w0) * inv, bhi(w0) * inv, blo(w1) * inv, bhi(w1) * inv)
#pragma unroll
    for (int d0 = 0; d0 < 4; ++d0) { qr[d0][0] = (int)Q5_Q2(qa[d0].x, qa[d0].y); qr[d0][1] = (int)Q5_Q2(qa[d0].z, qa[d0].w); qr[d0][2] = (int)Q5_Q2(qb[d0].x, qb[d0].y); qr[d0][3] = (int)Q5_Q2(qb[d0].z, qb[d0].w); }
#undef Q5_Q2
  }
  { glds16((const char*)Kc + koff, (unsigned)__builtin_amdgcn_readfirstlane(kdst));
#pragma unroll
    for (int i = 0; i < 4; ++i) glds16((const char*)Vc + voff[i], (unsigned)__builtin_amdgcn_readfirstlane(vdst + i * 1024)); }
  const int kx = (r32 & 7) << 4;
  const lds_cptr kp0 = shm3 + LDS_K + r32 * 128, vp0 = shm3 + LDS_V + v_rd_base(lane);
  float ksn0 = Sc[0], ksn1 = Sc[1];
  constexpr float BIAS = 12582912.f;
  i32x16 bini;
#pragma unroll
  for (int r = 0; r < 16; ++r) bini[r] = 0x4B400000;
  asm volatile("" : "+v"(bini));
  float m_reg = -1e30f, l_reg = 0.f, alpha = 1.f; f32x16 o[8];
#pragma unroll
  for (int d = 0; d < 8; ++d) o[d] = f32x16{};
  f32x16 p; i32x16 p8; bf16x8 pa0, pa1; float ks0, ks1;
#define A5_SB() __builtin_amdgcn_sched_barrier(0)
#define A5_PK(L, H) (bf16x8){L[0], L[1], L[2], L[3], H[0], H[1], H[2], H[3]}
#define A5_KLD(d0) (*(const __attribute__((address_space(3))) i32x4v*)(kb + ((((d0) * 32 + hi * 16)) ^ kx)))
#define A5_VLDA(S, d0) do { S##0 = vtr(vp + (d0) * 512); S##1 = vtr(vp + (d0) * 512 + 4096); } while (0)
#define A5_VLDB(S, d0) do { S##0 = vtr(vp + (d0) * 512 + 8192); S##1 = vtr(vp + (d0) * 512 + 12288); } while (0)
#define A5_PVA(d0, S) o[d0] = __builtin_amdgcn_mfma_f32_32x32x16_bf16(pa0, A5_PK(S##0, S##1), o[d0], 0, 0, 0)
#define A5_PVB(d0, S) o[d0] = __builtin_amdgcn_mfma_f32_32x32x16_bf16(pa1, A5_PK(S##0, S##1), o[d0], 0, 0, 0)
#define A5_MAX3(a, b, c) fmaxf(fmaxf((a), (b)), (c))
#define A5_NOPIECE(i) do { } while (0)
#define A5_PIECE(i) do { if ((i) == 0) glds16(ktn + koff, kdn); else if ((i) < 5) glds16(vtn + voff[(i) - 1], vdn + ((i) - 1) * 1024); } while (0)
#define A5_HALF(KOFF, KSB, VOFF, PIECE) do { \
    const lds_cptr kb = kp0 + (KOFF); const lds_cptr vp = vp0 + (VOFF); \
    i32x4v ka, kc; s16x4 va0, va1, vb0, vb1; \
    ka = A5_KLD(0); kc = A5_KLD(1); A5_SB(); \
    p8 = __builtin_amdgcn_mfma_i32_32x32x32_i8(ka, qr[0], bini, 0, 0, 0); ka = A5_KLD(2); PIECE(0); PIECE(1); A5_SB(); \
    p8 = __builtin_amdgcn_mfma_i32_32x32x32_i8(kc, qr[1], p8, 0, 0, 0); kc = A5_KLD(3); PIECE(2); PIECE(3); A5_SB(); \
    p8 = __builtin_amdgcn_mfma_i32_32x32x32_i8(ka, qr[2], p8, 0, 0, 0); PIECE(4); A5_VLDA(va, 0); A5_SB(); \
    p8 = __builtin_amdgcn_mfma_i32_32x32x32_i8(kc, qr[3], p8, 0, 0, 0); A5_VLDA(vb, 1); A5_SB(); \
    _Pragma("unroll") for (int r = 0; r < 16; ++r) p[r] = __int_as_float(p8[r]); \
    const float x1_ = A5_MAX3(p[0], p[1], p[2]), x2_ = A5_MAX3(p[3], p[4], p[5]), x3_ = A5_MAX3(p[6], p[7], p[8]), x4_ = A5_MAX3(p[9], p[10], p[11]), x5_ = A5_MAX3(p[12], p[13], p[14]); \
    float pmax = fmaxf(A5_MAX3(x1_, x2_, x3_), A5_MAX3(x4_, x5_, p[15])); \
    { auto rr = __builtin_amdgcn_permlane32_swap(__float_as_uint(pmax), __float_as_uint(pmax), false, false); pmax = fmaxf(__uint_as_float(rr[0]), __uint_as_float(rr[1])); } \
    pmax = (pmax - BIAS) * (KSB); \
    const float mn = (pmax - m_reg > thrq) ? fmaxf(m_reg, pmax) : m_reg; \
    alpha = __builtin_amdgcn_exp2f((m_reg - mn) * Cq); m_reg = mn; const float c1_ = (KSB) * Cq, mnC = -fmaf(BIAS, c1_, mn * Cq); \
    _Pragma("unroll") for (int r = 0; r < 16; ++r) p[r] = __builtin_amdgcn_exp2f(fmaf(p[r], c1_, mnC)); \
    float ps = ((p[0] + p[1]) + (p[2] + p[3])) + ((p[4] + p[5]) + (p[6] + p[7])); ps += ((p[8] + p[9]) + (p[10] + p[11])) + ((p[12] + p[13]) + (p[14] + p[15])); \
    { auto rr = __builtin_amdgcn_permlane32_swap(__float_as_uint(ps), __float_as_uint(ps), false, false); ps = __uint_as_float(rr[0]) + __uint_as_float(rr[1]); } \
    l_reg = l_reg * alpha + ps; \
    { unsigned a0 = cvtpk(p[0], p[1]), a1 = cvtpk(p[2], p[3]), b0 = cvtpk(p[4], p[5]), b1 = cvtpk(p[6], p[7]); \
      auto r0 = __builtin_amdgcn_permlane32_swap(a0, b0, false, false); auto r1 = __builtin_amdgcn_permlane32_swap(a1, b1, false, false); u32x4 w = {r0[0], r1[0], r0[1], r1[1]}; pa0 = __builtin_bit_cast(bf16x8, w); } \
    { unsigned a0 = cvtpk(p[8], p[9]), a1 = cvtpk(p[10], p[11]), b0 = cvtpk(p[12], p[13]), b1 = cvtpk(p[14], p[15]); \
      auto r0 = __builtin_amdgcn_permlane32_swap(a0, b0, false, false); auto r1 = __builtin_amdgcn_permlane32_swap(a1, b1, false, false); u32x4 w = {r0[0], r1[0], r0[1], r1[1]}; pa1 = __builtin_bit_cast(bf16x8, w); } \
    if (__any(alpha < 1.f)) { if (hi == 0) wsf[r32] = alpha; asm volatile("s_waitcnt lgkmcnt(0)" ::: "memory"); \
      _Pragma("unroll") for (int r = 0; r < 16; ++r) { const float a_ = wsf[crow(r, hi)]; \
        _Pragma("unroll") for (int d = 0; d < 8; ++d) o[d][r] *= a_; } } \
    A5_SB(); \
    A5_PVA(0, va); A5_VLDA(va, 2); A5_SB(); A5_PVA(1, vb); A5_VLDA(vb, 3); A5_SB(); A5_PVA(2, va); A5_VLDA(va, 4); A5_SB(); A5_PVA(3, vb); A5_VLDA(vb, 5); A5_SB(); \
    A5_PVA(4, va); A5_VLDA(va, 6); A5_SB(); A5_PVA(5, vb); A5_VLDA(vb, 7); A5_SB(); A5_PVA(6, va); A5_VLDB(va, 0); A5_SB(); A5_PVA(7, vb); A5_VLDB(vb, 1); A5_SB(); \
    A5_PVB(0, va); A5_VLDB(va, 2); A5_SB(); A5_PVB(1, vb); A5_VLDB(vb, 3); A5_SB(); A5_PVB(2, va); A5_VLDB(va, 4); A5_SB(); A5_PVB(3, vb); A5_VLDB(vb, 5); A5_SB(); \
    A5_PVB(4, va); A5_VLDB(va, 6); A5_SB(); A5_PVB(5, vb); A5_VLDB(vb, 7); A5_SB(); A5_PVB(6, va); A5_SB(); A5_PVB(7, vb); A5_SB(); } while (0)
#define A5_TILE(KS, VS, KSN, VSN, j) do { \
    A2_WAIT_BAR(0); \
    asm volatile("" : "+v"(ksn0), "+v"(ksn1)); ks0 = ksn0; ks1 = ksn1;        \
    const int tn_ = ((j) + 1 < NT) ? (j) + 1 : NT - 1; \
    const char* ktn = (tn_ * 64 < CTXN) ? (const char*)Kc + (size_t)(tn_ * 64) * 128 : (const char*)Kl + (size_t)(tn_ * 64 - CTXN) * 128; \
    { const float* stn = (tn_ * 64 < CTXN) ? Sc + tn_ * 2 : Sl + (tn_ * 2 - CTXN / 32); ksn0 = stn[0]; ksn1 = stn[1]; } \
    const char* vtn = (tn_ * 64 < CTXN) ? (const char*)Vc + (size_t)(tn_ * 64) * 512 : (const char*)Vl + (size_t)(tn_ * 64 - CTXN) * 512; \
    const unsigned kdn = (unsigned)__builtin_amdgcn_readfirstlane(kdst + (KSN)), vdn = (unsigned)__builtin_amdgcn_readfirstlane(vdst + (VSN)); \
    A5_HALF((KS), ks0, (VS), A5_PIECE); \
    A5_HALF((KS) + 4096, ks1, (VS) + 16384, A5_NOPIECE); } while (0)
  for (int j = 0; j < NT; j += 2) {
    A5_TILE(0, 0, KBUF, VBUF, j);
    A5_TILE(KBUF, VBUF, 0, 0, j + 1);
  }
#undef A5_TILE
#undef A5_HALF
#undef A5_PIECE
#undef A5_NOPIECE
#undef A5_MAX3
#undef A5_PVA
#undef A5_PVB
#undef A5_VLDA
#undef A5_VLDB
#undef A5_KLD
#undef A5_PK
#undef A5_SB
  if (hi == 0) wsf[32 + r32] = l_reg;
  asm volatile("s_waitcnt lgkmcnt(0)" ::: "memory");
  int lane2 = lane; asm volatile("" : "+v"(lane2));
  const int r32b = lane2 & 31, hib = lane2 >> 5;
  float rli[16];
#pragma unroll
  for (int r = 0; r < 16; ++r) rli[r] = __builtin_amdgcn_rcpf(wsf[32 + crow(r, hib)]);
  bf16* Ow = Ob + (size_t)(wid * 32) * LDO + r32b;
#pragma unroll
  for (int r = 0; r < 16; ++r)
#pragma unroll
    for (int d = 0; d < 8; ++d) Ow[(size_t)crow(r, hib) * LDO + d * 32] = (bf16)(cvtpk(o[d][r] * rli[r], 0.f) & 0xffffu);
  A2_WAIT_BAR(0);
}
}

#ifndef FORCE_LAM_ALL8
#define FORCE_LAM_ALL8 0.45f
#endif
constexpr int NWAVES = 8;
constexpr int G8T = 8;
constexpr int QB8 = 384 + 8 * G8T;
constexpr float LAM_ALL8 = FORCE_LAM_ALL8, LAM_SAFE = 0.55f;
constexpr int DM = 4096, NB = 4, SEQL = 4096, CTXL = 256;
constexpr int MLAT = NB * SEQL, MCTX = NB * CTXL, MTOT = MLAT + MCTX;
constexpr int NIN0 = 16384;
constexpr float EPS = 1e-6f;
constexpr int N_PHASES = 14;

constexpr size_t MiB = 1u << 20;
constexpr size_t WS_CTL = 0, CTL_ZERO_BYTES = 1 * MiB;
constexpr size_t WS_MOD = 1 * MiB;
constexpr size_t WS_ROPE = WS_MOD + 512 * 1024;
constexpr size_t WS_A16 = WS_ROPE + 64 * 1024;
constexpr size_t WS_RS = WS_A16 + 256 * 1024;
constexpr size_t WS_CS = WS_RS + 72 * 1024;
constexpr size_t WS_CS2 = WS_CS + 64 * 1024;
constexpr size_t WS_WIN0 = 2 * MiB;
constexpr size_t WS_WOUT0 = WS_WIN0 + 128 * MiB;
constexpr size_t WS_W5IN = WS_WOUT0 + 32 * MiB;
constexpr size_t WS_WGLU = WS_W5IN + 64 * MiB;
constexpr size_t WS_W5OUT = WS_WGLU + 32 * MiB;
constexpr size_t WS_E = WS_W5OUT + 32 * MiB;
constexpr size_t WS_W2 = WS_E + 32 * MiB;
constexpr size_t WS_H = WS_W2 + 64 * MiB;
constexpr size_t WS_P = WS_H + 136 * MiB;
constexpr size_t WS_OB = WS_P + 544 * MiB;
constexpr size_t WS_PARTM = WS_OB + 272 * MiB;
constexpr size_t WS_END = WS_PARTM + 8 * MiB;
constexpr size_t WS_QH = WS_P, WS_KH = WS_P + 136 * MiB, WS_VH = WS_P + 272 * MiB, WS_GT = WS_P + 408 * MiB;
constexpr size_t WS_AO = WS_H, WS_OUT0 = WS_P, WS_XS = WS_P, WS_SZ = WS_P + 320 * MiB, WS_HLOC = WS_OB, WS_YG = WS_H, WS_Y2 = WS_OB, WS_OUT1 = WS_P;
constexpr size_t CTL_COLMAX2 = 320 * 1024, CTL_TOKMAX = 384 * 1024;
constexpr size_t CTL_COLMAX = 256 * 1024;
constexpr int CW_TMO = 0, CW_BAR = 4096, CW_MODT = 16384;

constexpr int RING_OFF = 0, RING_BYTES = 131072;
constexpr int LDSCTL_OFF = RING_BYTES, MISC_OFF = LDSCTL_OFF + 320;
constexpr int LDS_BYTES = 147456;
constexpr int ATT_SML_OFF = RING_BYTES + 1024;

#define GAS __attribute__((address_space(1)))
#define LAS __attribute__((address_space(3)))
typedef unsigned short bf16;
typedef unsigned v4u __attribute__((ext_vector_type(4)));
typedef unsigned v2u __attribute__((ext_vector_type(2)));
typedef float f32x4 __attribute__((ext_vector_type(4)));
typedef float f32x2 __attribute__((ext_vector_type(2)));
typedef GAS unsigned gu32;
#define RLX_AGENT __ATOMIC_RELAXED, __HIP_MEMORY_SCOPE_AGENT
#define LDS_WAIT() asm volatile("s_waitcnt lgkmcnt(0)" ::: "memory")
__device__ __forceinline__ unsigned pk2(float lo, float hi) { return pg8::cvt_pk_bf16(lo, hi); }
__device__ __forceinline__ float wave_sum(float v) {
#pragma unroll
    for (int o = 1; o < 64; o <<= 1) v += __shfl_xor(v, o);
    return v;
}
__device__ __forceinline__ float half_sum(float v) {
#pragma unroll
    for (int o = 1; o < 32; o <<= 1) v += __shfl_xor(v, o);
    return v;
}

#define XB_TMO      128
#define XB_XCNT(j)  (256  + 64 * (j))
#define XB_XSUB(j)  (1280 + 64 * (j))
#define XB_XGEN(j)  (2304 + 64 * (j))
#define XB_TOP      3328
#define XB_TOPGEN   3392
#define XCD_BAR_WORDS 3456
#define XB_SPIN_CAP (1u << 18)
__device__ __forceinline__ unsigned xb_ld(unsigned* p)              { return __hip_atomic_load(p, __ATOMIC_RELAXED, __HIP_MEMORY_SCOPE_AGENT); }
__device__ __forceinline__ unsigned xb_add(unsigned* p, unsigned v) { return __hip_atomic_fetch_add(p, v, __ATOMIC_RELAXED, __HIP_MEMORY_SCOPE_AGENT); }
__device__ __forceinline__ unsigned xb_xcc_id() { return (unsigned)__builtin_amdgcn_s_getreg((3 << 11) | 20) & 0xFu; }
#define XB_SPIN(cond, bar) do { unsigned _sp = 0; while (cond) { __builtin_amdgcn_s_sleep(1); \
    if ((++_sp & 255u) == 0u) { if (xb_ld(&(bar)[XB_TMO])) break; if (_sp > XB_SPIN_CAP) { atomicAdd(&(bar)[XB_TMO], 1u); break; } } } } while (0)
struct XcdBarrier { unsigned* bar; unsigned x; volatile LAS unsigned* st; };
__device__ __forceinline__ XcdBarrier xcd_barrier_post(unsigned* bar, volatile LAS unsigned* st) {
    XcdBarrier b; b.bar = bar; b.x = xb_xcc_id(); b.st = st;
    if (threadIdx.x == 0) (void)xb_add(&bar[XB_XCNT(b.x)], 1u);
    return b;
}
__device__ __forceinline__ void xcd_barrier_complete(unsigned* bar, unsigned x, unsigned& nloc, unsigned& nx) {
    const unsigned G = gridDim.x * gridDim.y * gridDim.z;
    unsigned sum, cnt, mine, sp = 0u;
    for (;;) {
        sum = 0u; cnt = 0u; mine = 0u;
#pragma unroll
        for (unsigned j = 0; j < 16; ++j) { const unsigned c = xb_ld(&bar[XB_XCNT(j)]); sum += c; cnt += (c > 0u) ? 1u : 0u; mine = (j == x) ? c : mine; }
        if (sum == G) break;
        __builtin_amdgcn_s_sleep(1);
        if ((++sp & 255u) == 0u) { if (xb_ld(&bar[XB_TMO])) break; if (sp > XB_SPIN_CAP) { atomicAdd(&bar[XB_TMO], 1u); break; } }
    }
    nloc = mine > 0u ? mine : 1u; nx = cnt > 0u ? cnt : 1u;
}
__device__ __forceinline__ void xcd_barrier(const XcdBarrier& b) {
    asm volatile("s_waitcnt vmcnt(0)" ::: "memory");
    __syncthreads();
    if (threadIdx.x == 0) {
        unsigned* bar = b.bar;
        __builtin_amdgcn_s_waitcnt(0);
        unsigned nloc = b.st[0], nx = b.st[1];
        if (nloc == 0u) { xcd_barrier_complete(bar, b.x, nloc, nx); b.st[0] = nloc; b.st[1] = nx; }
        const unsigned old = xb_add(&bar[XB_XSUB(b.x)], 1u);
        const unsigned gen = old / nloc;
        if (old + 1u == (gen + 1u) * nloc) {
            __builtin_amdgcn_fence(__ATOMIC_RELEASE, "agent");
            asm volatile("s_waitcnt vmcnt(0)" ::: "memory");
            const unsigned og = xb_add(&bar[XB_TOP], 1u);
            const unsigned tg = og / nx;
            if (og + 1u == (tg + 1u) * nx) xb_add(&bar[XB_TOPGEN], 1u);
            else XB_SPIN(xb_ld(&bar[XB_TOPGEN]) == tg, bar);
            __builtin_amdgcn_fence(__ATOMIC_ACQUIRE, "agent");
            xb_add(&bar[XB_XGEN(b.x)], 1u);
            asm volatile("s_waitcnt vmcnt(0)" ::: "memory");
        } else {
            XB_SPIN(xb_ld(&bar[XB_XGEN(b.x)]) == gen, bar);
            __builtin_amdgcn_fence(__ATOMIC_ACQUIRE, "agent");
            asm volatile("s_waitcnt vmcnt(0)" ::: "memory");
        }
    }
    __syncthreads();
}

__device__ __forceinline__ void sincos_d(double x, double& s, double& c) {
    const double k = __builtin_rint(x * 0.15915494309189535);
    double r = __builtin_fma(-k, 6.283185307179586, x); r = __builtin_fma(-k, 2.4492935982947064e-16, r);
    const double q = r * 0.25, q2 = q * q;
    double sp = -7.647163731819816e-13;
    sp = sp * q2 + 1.6059043836821613e-10;
    sp = sp * q2 - 2.505210838544172e-08;
    sp = sp * q2 + 2.7557319223985893e-06;
    sp = sp * q2 - 1.984126984126984e-04;
    sp = sp * q2 + 8.333333333333333e-03;
    sp = sp * q2 - 1.6666666666666666e-01;
    double s1 = q + q * q2 * sp;
    double cp = 4.779477332387385e-14;
    cp = cp * q2 - 1.1470745597729725e-11;
    cp = cp * q2 + 2.08767569878681e-09;
    cp = cp * q2 - 2.755731922398589e-07;
    cp = cp * q2 + 2.48015873015873e-05;
    cp = cp * q2 - 1.388888888888889e-03;
    cp = cp * q2 + 4.1666666666666664e-02;
    cp = cp * q2 - 0.5;
    double c1 = 1.0 + q2 * cp;
    double s2 = 2.0 * s1 * c1, c2 = 1.0 - 2.0 * s1 * s1;
    s = 2.0 * s2 * c2; c = 1.0 - 2.0 * s2 * s2;
}
__device__ __forceinline__ double exp_d(double x) {
    const double k = __builtin_rint(x * 1.4426950408889634);
    const double r = __builtin_fma(-k, 0.6931471805599453, x) - k * 2.3190468138462996e-17;
    double p = 1.0 / 479001600.0;
    p = p * r + 1.0 / 39916800.0; p = p * r + 1.0 / 3628800.0; p = p * r + 1.0 / 362880.0; p = p * r + 1.0 / 40320.0; p = p * r + 1.0 / 5040.0;
    p = p * r + 1.0 / 720.0; p = p * r + 1.0 / 120.0; p = p * r + 1.0 / 24.0; p = p * r + 1.0 / 6.0; p = p * r + 0.5; p = p * r + 1.0; p = p * r + 1.0;
    const long long ki = (long long)k;
    const double sc = __builtin_bit_cast(double, (unsigned long long)((ki + 1023) << 52));
    return p * sc;
}

struct Args { const float* in[23]; float* out; unsigned char* ws; int ph_lo, ph_hi; };
enum { I_X = 0, I_C, I_CTX, I_CCTX, I_ADAW, I_ADAB, I_NPRE, I_NPOST, I_AWIN, I_AWOUT, I_ALAM, I_ASUB, I_SWIN, I_SARE, I_SAIM, I_SLDT, I_SBRE, I_SBIM, I_SCRE, I_SCIM, I_SD, I_SWGLU, I_SWOUT };

template <bool QKPERM>
__device__ __forceinline__ void transpose_item(const float* W, int K, int N, bf16* WT, LAS float* scr, int item, int lane, int row_sub = 0) {
    const int nblk = N / 32, kb = item / nblk, nb = item % nblk, k0 = 64 * kb, n0 = 32 * nb;
#pragma unroll 8
    for (int i = 0; i < 32; ++i) { const int kk = 2 * i + (lane >> 5); scr[kk * 33 + (lane & 31)] = __builtin_nontemporal_load(W + (size_t)(k0 + kk) * N + n0 + (lane & 31)); }
    LDS_WAIT(); asm volatile("" ::: "memory");
    const int c = lane & 7;
#pragma unroll
    for (int j = 0; j < 4; ++j) { const int n = (lane >> 3) + 8 * j; const LAS float* s = scr + (8 * c) * 33 + n;
        v4u o; o.x = pk2(s[0 * 33], s[1 * 33]); o.y = pk2(s[2 * 33], s[3 * 33]); o.z = pk2(s[4 * 33], s[5 * 33]); o.w = pk2(s[6 * 33], s[7 * 33]);
        int nn = n0 + n;
        if (QKPERM && nn < 8192) { const int d = nn & 127, a = d >> 6, jj = (d >> 5) & 1, f = d & 31; nn = (nn & ~127) + 2 * (a * 32 + f) + jj; }
        *(GAS v4u*)(WT + pg8::blk_off(nn - row_sub, k0 + 8 * c)) = o; }
    LDS_WAIT(); asm volatile("" ::: "memory");
}

#define GEMV_ITEM(item) do { \
                const int layer = item / 384, rem = item % 384, ks = rem / 24, cs = rem % 24, k0 = ks * 256, n0 = cs * 512; \
                for (int e = tid; e < 1280; e += NWAVES * 64) { const int r = e >> 8, kk = e & 255; const float v = (r < 4) ? cvec[r * 4096 + k0 + kk] : cctx[k0 + kk]; sv[e] = v * pg8::sigmoidf_fast(v); } \
                __syncthreads(); \
                const int cg = tid & 127, sub = tid >> 7; \
                const float* wp = args.in[I_ADAW] + ((size_t)layer * 4096 + k0 + sub * 64) * 12288 + n0 + cg * 4; \
                f32x4 acc[5]; \
_Pragma("unroll") \
                for (int r = 0; r < 5; ++r) acc[r] = (f32x4){0.f, 0.f, 0.f, 0.f}; \
                for (int i = 0; i < 64; i += 8) { \
                    f32x4 w[8]; \
_Pragma("unroll") \
                    for (int q = 0; q < 8; ++q) w[q] = __builtin_nontemporal_load((const GAS f32x4*)(wp + (size_t)(i + q) * 12288)); \
_Pragma("unroll") \
                    for (int q = 0; q < 8; ++q) \
_Pragma("unroll") \
                        for (int r = 0; r < 5; ++r) acc[r] += w[q] * sv[r * 256 + sub * 64 + i + q]; \
                } \
_Pragma("unroll") \
                for (int r = 0; r < 5; ++r) red[(sub * 128 + cg) * 5 + r] = acc[r]; \
                __syncthreads(); \
                float* part = PARTM + ((size_t)((layer * 24 + cs) * 16 + ks)) * 2560; \
                for (int e = tid; e < 640; e += NWAVES * 64) { const int cg2 = e / 5, r = e % 5; \
                    const f32x4 sm = red[(0 * 128 + cg2) * 5 + r] + red[(1 * 128 + cg2) * 5 + r] + red[(2 * 128 + cg2) * 5 + r] + red[(3 * 128 + cg2) * 5 + r]; \
                    float* pp = part + r * 512 + cg2 * 4; \
                    __hip_atomic_store(pp + 0, sm.x, __ATOMIC_RELAXED, __HIP_MEMORY_SCOPE_AGENT); __hip_atomic_store(pp + 1, sm.y, __ATOMIC_RELAXED, __HIP_MEMORY_SCOPE_AGENT); \
                    __hip_atomic_store(pp + 2, sm.z, __ATOMIC_RELAXED, __HIP_MEMORY_SCOPE_AGENT); __hip_atomic_store(pp + 3, sm.w, __ATOMIC_RELAXED, __HIP_MEMORY_SCOPE_AGENT); } \
                asm volatile("s_waitcnt vmcnt(0)" ::: "memory"); \
                __syncthreads(); \
                if (tid == 0) MISC[16] = __hip_atomic_fetch_add((unsigned*)(ctl + CW_MODT + 64 * (layer * 24 + cs)), 1u, __ATOMIC_RELAXED, __HIP_MEMORY_SCOPE_AGENT); \
                __syncthreads(); \
                if (MISC[16] == 15u) { \
                    __builtin_amdgcn_fence(__ATOMIC_ACQUIRE, "agent"); \
                    const float* pb = PARTM + ((size_t)((layer * 24 + cs) * 16)) * 2560; \
                    for (int e = tid; e < 2560; e += NWAVES * 64) { const int r = e >> 9, cn = e & 511; float sm = args.in[I_ADAB][layer * 12288 + n0 + cn]; \
_Pragma("unroll") \
                        for (int k = 0; k < 16; ++k) sm += __hip_atomic_load(pb + (size_t)k * 2560 + e, __ATOMIC_RELAXED, __HIP_MEMORY_SCOPE_AGENT); \
                        MOD[((size_t)layer * 5 + r) * 12288 + n0 + cn] = sm; } \
                } \
                __syncthreads(); \
            } while (0)

__device__ __forceinline__ float wave_max(float v) {
#pragma unroll
    for (int o = 1; o < 64; o <<= 1) v = fmaxf(v, __shfl_xor(v, o));
    return v;
}
__device__ __forceinline__ int qkperm_col(int nn) { if (nn < 8192) { const int d = nn & 127, a = d >> 6, jj = (d >> 5) & 1, f = d & 31; nn = (nn & ~127) + 2 * (a * 32 + f) + jj; } return nn; }
template <bool PERM>
__device__ __forceinline__ void colmax_item(const float* W, int N, unsigned* colmax, int item, int lane) {
    const int nblk = N / 32, kb = item / nblk, nb = item % nblk, k0 = 64 * kb, n0 = 32 * nb; float m = 0.f;
#pragma unroll 8
    for (int i = 0; i < 32; ++i) m = fmaxf(m, __builtin_fabsf(__builtin_nontemporal_load(W + (size_t)(k0 + 2 * i + (lane >> 5)) * N + n0 + (lane & 31))));
    m = fmaxf(m, __shfl_xor(m, 32));
    if (lane < 32) (void)__hip_atomic_fetch_max(colmax + (PERM ? qkperm_col(n0 + lane) : n0 + lane), __float_as_uint(m), __ATOMIC_RELAXED, __HIP_MEMORY_SCOPE_AGENT);
}
__device__ __forceinline__ unsigned q8pack(float a, float b, float c, float d) {
    const int ia = (int)__builtin_rintf(a), ib = (int)__builtin_rintf(b), ic = (int)__builtin_rintf(c), id = (int)__builtin_rintf(d);
    return (unsigned)(ia & 255) | ((unsigned)(ib & 255) << 8) | ((unsigned)(ic & 255) << 16) | ((unsigned)id << 24);
}
template <bool PERM>
__device__ __forceinline__ void quant_item(const float* W, int N, const unsigned* colmax, unsigned char* WQ, float* CS, LAS float* scr, int item, int lane) {
    const int nblk = N / 32, kb = item / nblk, nb = item % nblk, k0 = 64 * kb, n0 = 32 * nb;
#pragma unroll 8
    for (int i = 0; i < 32; ++i) { const int kk = 2 * i + (lane >> 5); scr[kk * 33 + (lane & 31)] = __builtin_nontemporal_load(W + (size_t)(k0 + kk) * N + n0 + (lane & 31)); }
    LDS_WAIT(); asm volatile("" ::: "memory");
    const int c = lane & 7;
#pragma unroll
    for (int j = 0; j < 4; ++j) { const int n = (lane >> 3) + 8 * j, nn = PERM ? qkperm_col(n0 + n) : n0 + n; const LAS float* sp = scr + (8 * c) * 33 + n;
        const float cm = __uint_as_float(colmax[nn]), inv = cm > 0.f ? 127.f / cm : 0.f;
        v2u o; o.x = q8pack(sp[0 * 33] * inv, sp[1 * 33] * inv, sp[2 * 33] * inv, sp[3 * 33] * inv); o.y = q8pack(sp[4 * 33] * inv, sp[5 * 33] * inv, sp[6 * 33] * inv, sp[7 * 33] * inv);
        *(GAS v2u*)(WQ + pg8::blk8_off(nn, k0 + 8 * c)) = o;
        if (kb == 0 && c == 0) CS[nn] = cm * (1.f / 127.f); }
    LDS_WAIT(); asm volatile("" ::: "memory");
}

__global__ void __launch_bounds__(NWAVES * 64, 2) fwd_kernel(Args args) {
    extern __shared__ __attribute__((aligned(16))) unsigned char lds[];
    LAS unsigned char* L = (LAS unsigned char*)lds;
    volatile LAS unsigned* MISC = (volatile LAS unsigned*)(L + MISC_OFF);
    const int tid = threadIdx.x, lane = tid & 63, wave = __builtin_amdgcn_readfirstlane(tid >> 6);
    const int G = gridDim.x; const int bx = blockIdx.x; const int vcu = (G % 8 == 0) ? (bx % 8) * (G / 8) + bx / 8 : bx;
    const int gw = vcu * NWAVES + wave, NGW = G * NWAVES;
    unsigned char* ws = args.ws;
    gu32* ctl = (gu32*)(ws + WS_CTL);
    for (int u = tid; u < (LDS_BYTES - LDSCTL_OFF) / 4; u += NWAVES * 64) ((LAS unsigned*)(L + LDSCTL_OFF))[u] = 0u;
    __syncthreads();
    XcdBarrier bar; bar.bar = (unsigned*)(ctl + CW_BAR); bar.x = 0; bar.st = nullptr;
    if (!MK_PER_PHASE) bar = xcd_barrier_post((unsigned*)(ctl + CW_BAR), MISC + 8);
    const int lo = args.ph_lo, hi = args.ph_hi;
#define IN(k) (lo <= (k) && (k) < hi)
#define SEAM(k) do { if (IN(k) && IN((k) + 1)) xcd_barrier(bar); } while (0)

    int n8;
    { const float* lv_ = args.in[I_ALAM];
      const float d01_ = wave_sum(lv_[lane] * lv_[128 + lane] + lv_[64 + lane] * lv_[192 + lane]), d23_ = wave_sum(lv_[256 + lane] * lv_[384 + lane] + lv_[320 + lane] * lv_[448 + lane]);
      const float lam_ = __expf(d01_) - __expf(d23_) + 0.2f; n8 = __builtin_amdgcn_readfirstlane((lam_ <= LAM_ALL8) ? 64 : (lam_ <= LAM_SAFE) ? 48 + G8T : 32); }
    const int qb8 = n8 * 8;
    const float* x = args.in[I_X]; const float* cvec = args.in[I_C]; const float* ctx = args.in[I_CTX]; const float* cctx = args.in[I_CCTX];
    float* RS = (float*)(ws + WS_RS); float* CS = (float*)(ws + WS_CS); unsigned* COLMAX = (unsigned*)(ws + WS_CTL + CTL_COLMAX);
    unsigned char* HQ = ws + WS_OB; unsigned char* WQ8 = ws + WS_WIN0; bf16* WG0 = (bf16*)(ws + WS_WIN0 + 64 * MiB);
    float* CS2 = (float*)(ws + WS_CS2); unsigned* COLMAX2 = (unsigned*)(ws + WS_CTL + CTL_COLMAX2); unsigned* TOKMAX = (unsigned*)(ws + WS_CTL + CTL_TOKMAX);
    unsigned char* WGLU8 = ws + WS_WGLU; unsigned char* A8 = ws + WS_P;
    unsigned char* K8 = ws + WS_H; float* KSC = (float*)(ws + WS_H + 72 * MiB);
    bf16* X1B = (bf16*)(ws + WS_WIN0);
    float* MOD = (float*)(ws + WS_MOD); float* PARTM = (float*)(ws + WS_PARTM); float* ROPE = (float*)(ws + WS_ROPE); float* A16 = (float*)(ws + WS_A16);
    bf16* Win0 = (bf16*)(ws + WS_WIN0); bf16* Wout0 = (bf16*)(ws + WS_WOUT0); bf16* W5in = (bf16*)(ws + WS_W5IN); bf16* Wglu = (bf16*)(ws + WS_WGLU); bf16* W5out = (bf16*)(ws + WS_W5OUT);
    bf16* Etab = (bf16*)(ws + WS_E); bf16* W2tab = (bf16*)(ws + WS_W2);
    bf16* Hb = (bf16*)(ws + WS_H); bf16* OB = (bf16*)(ws + WS_OB); bf16* QH = (bf16*)(ws + WS_QH); bf16* KH = (bf16*)(ws + WS_KH); bf16* VH = (bf16*)(ws + WS_VH); bf16* GT = (bf16*)(ws + WS_GT);
    bf16* AO = (bf16*)(ws + WS_AO); bf16* OUT0 = (bf16*)(ws + WS_OUT0); bf16* XS = (bf16*)(ws + WS_XS); bf16* SZ = (bf16*)(ws + WS_SZ);
    bf16* HLOC = (bf16*)(ws + WS_HLOC); bf16* YG = (bf16*)(ws + WS_YG); bf16* Y2 = (bf16*)(ws + WS_Y2); bf16* OUT1 = (bf16*)(ws + WS_OUT1);

    if (IN(0)) {
        {
            LAS float* sv = (LAS float*)L;
            LAS f32x4* red = (LAS f32x4*)(L + 8192);
            for (int item = vcu; item < 384; item += G) GEMV_ITEM(item);
        }
        __syncthreads();
        if (vcu == 0) for (int e = tid; e < 2048; e += 512) { const int pos = e >> 5, f = e & 31; const double invf = exp_d(-(double)f * (9.210340371976184 / 32.0)); double sn, cs; sincos_d((double)pos * invf, sn, cs);
            *(GAS f32x2*)(ROPE + e * 2) = (f32x2){(float)cs, (float)sn}; }
        __syncthreads();
        {
            LAS float* scr = (LAS float*)(L + RING_OFF + wave * 16384);
            constexpr int I_0 = 64 * 512, I_1 = 0, I_2 = 0, I_3 = 0, I_4 = 0;
            constexpr int NITEMS = I_0 + I_1 + I_2 + I_3 + I_4;
            for (int it = gw; it < NITEMS; it += NGW) {
                int r = it;
                if (r < I_0) { if ((r % 512) < qb8) colmax_item<true>(args.in[I_AWIN], 16384, COLMAX, r, lane);
                               else transpose_item<false>(args.in[I_AWIN], 4096, 16384, WG0, scr, r, lane, 8192);
                               continue; } r -= I_0;
                if (r < I_1) { transpose_item<false>(args.in[I_AWOUT], 4096, 4096, Wout0, scr, r, lane); continue; } r -= I_1;
                if (r < I_2) { transpose_item<false>(args.in[I_SWIN], 4096, 8192, W5in, scr, r, lane); continue; } r -= I_2;
                if (r < I_3) { colmax_item<false>(args.in[I_SWGLU], 4096, COLMAX2, r, lane); continue; } r -= I_3;
                (void)r;
            }
        }
        __syncthreads();
        __syncthreads();
    }
    SEAM(0);

    if (IN(1)) {
        const float* npre = args.in[I_NPRE];
        const int wgb = G >> 2, bq = (wgb > 0) ? vcu / wgb : 4, wl = (wgb > 0) ? vcu % wgb : 0;
        LAS f32x4* Va = (LAS f32x4*)L; LAS f32x4* Vs = Va + 1024;
#define P1_LOADVEC(mb) do { const float* shift_ = MOD + (size_t)(mb) * 12288; const float* scale_ = shift_ + 4096; \
            for (int q = tid; q < 1024; q += NWAVES * 64) { Va[q] = ((const GAS f32x4*)npre)[q] * (((const GAS f32x4*)scale_)[q] + 1.f); Vs[q] = ((const GAS f32x4*)shift_)[q]; } } while (0)
#define P1_ROW(row, xr) do { \
            unsigned vbase = (unsigned)lane * 16u; asm volatile("" : "+v"(vbase)); \
            const LAS f32x4* Va_ = (const LAS f32x4*)(L + vbase); const LAS f32x4* Vs_ = Va_ + 1024; \
            f32x4 v[16]; float ss = 0.f; \
            _Pragma("unroll") for (int j = 0; j < 16; ++j) { v[j] = __builtin_nontemporal_load((const GAS f32x4*)(xr) + lane + 64 * j); ss += (v[j].x * v[j].x + v[j].y * v[j].y) + (v[j].z * v[j].z + v[j].w * v[j].w); } \
            const float rstd = __builtin_amdgcn_rsqf(wave_sum(ss) * (1.f / DM) + EPS); float mx = 0.f; \
            _Pragma("unroll") for (int j = 0; j < 16; ++j) { v[j] = v[j] * rstd * Va_[64 * j] + Vs_[64 * j]; \
                mx = fmaxf(fmaxf(mx, fmaxf(__builtin_fabsf(v[j].x), __builtin_fabsf(v[j].y))), fmaxf(__builtin_fabsf(v[j].z), __builtin_fabsf(v[j].w))); if ((j & 3) == 3) __builtin_amdgcn_sched_barrier(0); } \
            mx = wave_max(mx); const float inv = mx > 0.f ? 127.f / mx : 0.f; if (lane == 0) RS[(row)] = mx * (1.f / 127.f); \
            _Pragma("unroll") for (int j = 0; j < 16; ++j) { *(GAS v2u*)(Hb + pg8::blk_off((row), 4 * (lane + 64 * j))) = (v2u){pk2(v[j].x, v[j].y), pk2(v[j].z, v[j].w)}; \
                *(GAS unsigned*)(HQ + pg8::blk8_off((row), 4 * (lane + 64 * j))) = q8pack(v[j].x * inv, v[j].y * inv, v[j].z * inv, v[j].w * inv); } } while (0)
        if (bq < 4) P1_LOADVEC(bq);
        __syncthreads();
        if (bq < 4) for (int r = wl * NWAVES + wave; r < SEQL; r += wgb * NWAVES) { const int row = bq * SEQL + r; P1_ROW(row, x + (size_t)row * DM); }
        __syncthreads();
        P1_LOADVEC(4);
        __syncthreads();
        for (int row = MLAT + gw; row < MTOT; row += NGW) P1_ROW(row, ctx + (size_t)(row - MLAT) * DM);
        __syncthreads();
        { LAS float* scr = (LAS float*)(L + RING_OFF + wave * 16384);
          for (int it = gw; it < 64 * 512; it += NGW) if ((it % 512) < qb8) quant_item<true>(args.in[I_AWIN], 16384, COLMAX, WQ8, CS, scr, it, lane);
        }
        __syncthreads();
#undef P1_ROW
#undef P1_LOADVEC
    }
    SEAM(1);

    if (IN(2)) {
        { pg8::Gemm g{(const pg8::bf16_t*)HQ, (const pg8::bf16_t*)WQ8, 2048, 128u, 32u, 32768u, 1048576u, 128u, 32768u, 1048576u}; pg8::StaticOrder S; S.init(68, n8, G, bx);
          pg8::EpiRope8 E{QH, KH, VH, GT, ROPE, RS, CS};
          pg8::gemm_phase<pg8::EpiRope8, pg8::StaticOrder, PG8_ALIGN, PG8_SP2, true>(L + RING_OFF, g, S, E); }
        { pg8::Gemm g{Hb, WG0 + (size_t)(n8 - 32) * 1048576, 4096, 128u, 32u, 32768u, 2097152u, 128u, 32768u, 2097152u}; pg8::StaticOrder S; S.init(68, 64 - n8, G, G - 1 - bx);
          pg8::EpiRope E{QH, KH, VH, GT, ROPE, n8};
          pg8::gemm_phase<pg8::EpiRope, pg8::StaticOrder, PG8_ALIGN, PG8_SP2>(L + RING_OFF, g, S, E); }
        { const bool reg = (G == 256); const int ntw = reg ? 64 : G, ncw0 = reg ? 64 : 0, ncw = reg ? 160 : G;
          if (bx < ntw) {
        for (int g = 192 + bx; g < 256; g += ntw) {
            LAS f32x2* pw = (LAS f32x2*)L;
            LAS f32x2* Bb = (LAS f32x2*)(L + 17408);
            LAS f32x2* Cc = (LAS f32x2*)(L + 17408 + 16384);
            LAS float* Kt = (LAS float*)(L + 17408 + 32768);
            LAS f32x2* fz = (LAS f32x2*)(L + 17408 + 65536);
            if (tid < 128) {
                const int d = tid >> 6, p = tid & 63; const int gi = (d * 256 + g) * 64 + p;
                const double dt = exp_d((double)args.in[I_SLDT][d * 256 + g]);
                const double Ar = (double)args.in[I_SARE][gi], Ai = (double)args.in[I_SAIM][gi];
                const double mag = exp_d(Ar * dt); double sn, cs; sincos_d(Ai * dt, sn, cs);
                const double ar = mag * cs, ai = mag * sn;
                const double den = Ar * Ar + Ai * Ai;
                const double fr_ = ((ar - 1.0) * Ar + ai * Ai) / den, fi_ = (ai * Ar - (ar - 1.0) * Ai) / den;
                fz[d * 64 + p] = (f32x2){(float)fr_, (float)fi_};
                double pr = 1.0, pi = 0.0;
                for (int n = 0; n <= 16; ++n) { pw[(d * 17 + n) * 64 + p] = (f32x2){(float)pr, (float)pi}; const double t = pr * ar - pi * ai; pi = pr * ai + pi * ar; pr = t; }
                *(GAS f32x2*)(A16 + (size_t)gi * 2) = pw[(d * 17 + 16) * 64 + p];
            }
            __syncthreads();
            for (int e = tid; e < 2048; e += 512) {
                { const int d = e >> 10, p = (e >> 4) & 63, c = e & 15; const size_t gi = ((size_t)(d * 256 + g) * 64 + p) * 16 + c;
                  const float br = args.in[I_SBRE][gi], bi = args.in[I_SBIM][gi]; const f32x2 f = fz[d * 64 + p];
                  Bb[e] = (f32x2){f.x * br - f.y * bi, f.x * bi + f.y * br}; }
                { const int d = e >> 10, c = (e >> 6) & 15, p = e & 63; const size_t gi = ((size_t)(d * 256 + g) * 16 + c) * 64 + p;
                  Cc[e] = (f32x2){args.in[I_SCRE][gi], args.in[I_SCIM][gi]}; }
            }
            __syncthreads();
            {
                const int cp = tid & 15, c = (tid >> 4) & 15, d = tid >> 8; float kacc[16];
#pragma unroll
                for (int t = 0; t < 16; ++t) kacc[t] = 0.f;
                for (int p = 0; p < 64; ++p) { const f32x2 cc = Cc[(d * 16 + c) * 64 + p], bb = Bb[(d * 64 + p) * 16 + cp];
                    const float tr = cc.x * bb.x - cc.y * bb.y, ti = cc.x * bb.y + cc.y * bb.x;
#pragma unroll
                    for (int t = 0; t < 16; ++t) { const f32x2 aa = pw[(d * 17 + t) * 64 + p]; kacc[t] += tr * aa.x - ti * aa.y; } }
#pragma unroll
                for (int t = 0; t < 16; ++t) Kt[((d * 16 + t) * 16 + c) * 16 + cp] = kacc[t];
            }
            __syncthreads();
            const float* Dk = args.in[I_SD] + g * 16;
            for (int e = tid; e < 16384; e += 512) {
                const int ch = e & 63, n = e >> 6, t = n >> 4, c = n & 15; float v[8];
                if (ch < 32) { const int sI = ch >> 1, c0 = (ch & 1) * 8;
#pragma unroll
                    for (int i = 0; i < 8; ++i) v[i] = 0.f;
                    if (sI <= t) { const LAS f32x4* kp = (const LAS f32x4*)(Kt + ((0 * 16 + (t - sI)) * 16 + c) * 16 + c0); const f32x4 a0 = kp[0], a1 = kp[1];
                        v[0] += a0.x; v[1] += a0.y; v[2] += a0.z; v[3] += a0.w; v[4] += a1.x; v[5] += a1.y; v[6] += a1.z; v[7] += a1.w; }
                    if (sI >= t) { const LAS f32x4* kp = (const LAS f32x4*)(Kt + ((1 * 16 + (sI - t)) * 16 + c) * 16 + c0); const f32x4 a0 = kp[0], a1 = kp[1];
                        v[0] += a0.x; v[1] += a0.y; v[2] += a0.z; v[3] += a0.w; v[4] += a1.x; v[5] += a1.y; v[6] += a1.z; v[7] += a1.w; }
                    if (sI == t && (c >> 3) == (ch & 1)) { const float dk = Dk[c];
#pragma unroll
                        for (int i = 0; i < 8; ++i) v[i] += ((c & 7) == i) ? dk : 0.f; }
                } else { const int kk = (ch - 32) * 8, d = kk >> 7, p0 = (kk & 127) >> 1, pwn = d == 0 ? t + 1 : 16 - t;
#pragma unroll
                    for (int i = 0; i < 4; ++i) { const f32x2 cc = Cc[(d * 16 + c) * 64 + p0 + i], aa = pw[(d * 17 + pwn) * 64 + p0 + i]; v[2 * i] = cc.x * aa.x - cc.y * aa.y; v[2 * i + 1] = -(cc.x * aa.y + cc.y * aa.x); } }
                *(GAS v4u*)(W2tab + ((size_t)g * 256 + n) * 512 + 8 * ch) = (v4u){pk2(v[0], v[1]), pk2(v[2], v[3]), pk2(v[4], v[5]), pk2(v[6], v[7])};
            }
            for (int e = tid; e < 8192; e += 512) {
                const int ch = e & 31, n = e >> 5, d = n >> 7, p = (n & 127) >> 1, ri = n & 1, sI = ch >> 1, c0 = (ch & 1) * 8, pwn = d == 0 ? 15 - sI : sI;
                const f32x2 aa = pw[(d * 17 + pwn) * 64 + p]; float v[8];
#pragma unroll
                for (int i = 0; i < 8; ++i) { const f32x2 b = Bb[(d * 64 + p) * 16 + c0 + i]; v[i] = ri ? (aa.x * b.y + aa.y * b.x) : (aa.x * b.x - aa.y * b.y); }
                *(GAS v4u*)(Etab + ((size_t)g * 256 + n) * 256 + 8 * ch) = (v4u){pk2(v[0], v[1]), pk2(v[2], v[3]), pk2(v[4], v[5]), pk2(v[6], v[7])};
            }
            __syncthreads();
        }
          }
          if (bx >= ncw0 && bx < ncw0 + ncw) { LAS float* scr = (LAS float*)(L + RING_OFF + wave * 16384);
              for (int it = (bx - ncw0) * NWAVES + wave; it < 2 * 64 * 128; it += ncw * NWAVES) {
                  if (it < 64 * 128) transpose_item<false>(args.in[I_AWOUT], 4096, 4096, Wout0, scr, it, lane);
                  else colmax_item<false>(args.in[I_SWGLU], 4096, COLMAX2, it - 64 * 128, lane); } } }
    }
    SEAM(2);

    if (IN(3)) {
        { constexpr int NBLK = 32 * 17408 / 32; const int nsw = G * NWAVES;
          for (int blk = bx * NWAVES + wave; blk < NBLK; blk += nsw) {
              v4u kv[8]; const size_t r0 = (size_t)blk * 32 + (lane >> 4);
#pragma unroll
              for (int u = 0; u < 8; ++u) kv[u] = __builtin_nontemporal_load((const v4u*)(KH + (r0 + 4 * u) * 128 + (lane & 15) * 8));
              float m = 0.f;
#pragma unroll
              for (int u = 0; u < 8; ++u) { m = fmaxf(m, fmaxf(fmaxf(__builtin_fabsf(pg8::bflo(kv[u].x)), __builtin_fabsf(pg8::bfhi(kv[u].x))), fmaxf(__builtin_fabsf(pg8::bflo(kv[u].y)), __builtin_fabsf(pg8::bfhi(kv[u].y)))));
                                            m = fmaxf(m, fmaxf(fmaxf(__builtin_fabsf(pg8::bflo(kv[u].z)), __builtin_fabsf(pg8::bfhi(kv[u].z))), fmaxf(__builtin_fabsf(pg8::bflo(kv[u].w)), __builtin_fabsf(pg8::bfhi(kv[u].w))))); }
              m = fmaxf(m, __shfl_xor(m, 1)); m = fmaxf(m, __shfl_xor(m, 2)); m = fmaxf(m, __shfl_xor(m, 4)); m = fmaxf(m, __shfl_xor(m, 8)); m = fmaxf(m, __shfl_xor(m, 16)); m = fmaxf(m, __shfl_xor(m, 32));
              const float inv = m > 0.f ? 127.f / m : 0.f;
#pragma unroll
              for (int u = 0; u < 8; ++u) { v2u o; o.x = q8pack(pg8::bflo(kv[u].x) * inv, pg8::bfhi(kv[u].x) * inv, pg8::bflo(kv[u].y) * inv, pg8::bfhi(kv[u].y) * inv); o.y = q8pack(pg8::bflo(kv[u].z) * inv, pg8::bfhi(kv[u].z) * inv, pg8::bflo(kv[u].w) * inv, pg8::bfhi(kv[u].w) * inv);
                  *(GAS v2u*)(K8 + (r0 + 4 * u) * 128 + (lane & 15) * 8) = o; }
              if (lane == 0) KSC[blk] = m * (1.f / 127.f); } }
        xcd_barrier(bar);
        float* sml = (float*)((char*)lds + ATT_SML_OFF);
        for (int i = 0;; ++i) {
            const long Lu = (long)i * G + bx; if (Lu >= 2176) break;
            int b, h, n, qrow0, seq;
            if (Lu < 2048) { const int xcd = (int)(Lu & 7), k = (int)(Lu >> 3), bh = xcd * 8 + (k >> 5), r = k & 31; b = bh >> 4; h = bh & 15; n = r >> 4; qrow0 = b * 4096 + (r & 15) * 256; seq = 4352; }
            else { const int e = (int)Lu - 2048; b = e >> 5; h = (e >> 1) & 15; n = e & 1; qrow0 = MLAT + b * 256; seq = 256; }
            const size_t hm = (size_t)(h * 2 + n) * 17408, qk0 = hm * 128, v0 = (size_t)h * 17408 * 256; const size_t crow = MLAT + b * 256, lrow = b * 4096;
            att2::attn_unit256q(QH + qk0 + (size_t)qrow0 * 128, K8 + (hm + crow) * 128, K8 + (hm + lrow) * 128, KSC + (hm + crow) / 32, KSC + (hm + lrow) / 32, VH + v0 + crow * 256, VH + v0 + lrow * 256,
                                OB + (size_t)qrow0 * 8192 + n * 4096 + h * 256, seq, (char*)lds + RING_OFF, sml);
        }
        __syncthreads();
    }
    SEAM(3);

    if (IN(4)) {
        const float* lv = args.in[I_ALAM]; const float* sub = args.in[I_ASUB];
        const float d01 = wave_sum(lv[lane] * lv[128 + lane] + lv[64 + lane] * lv[192 + lane]);
        const float d23 = wave_sum(lv[256 + lane] * lv[384 + lane] + lv[320 + lane] * lv[448 + lane]);
        const float lam = __expf(d01) - __expf(d23) + 0.2f;
        const int hl = lane >> 5, cl = (lane & 31) * 8;
        f32x4 sg0 = *(const GAS f32x4*)(sub + cl), sg1 = *(const GAS f32x4*)(sub + cl + 4);
        sg0 = sg0 * 0.8f; sg1 = sg1 * 0.8f;
        for (int row = gw; row < MTOT; row += NGW) {
            const bf16* o0p = OB + (size_t)row * 8192; const bf16* gp = GT + (size_t)row * DM;
            v4u av[8], bv[8], gv[8];
#pragma unroll
            for (int j = 0; j < 8; ++j) { const int col = (2 * j + hl) * 256 + cl;
                av[j] = __builtin_nontemporal_load((const GAS v4u*)(o0p + col)); bv[j] = __builtin_nontemporal_load((const GAS v4u*)(o0p + 4096 + col)); gv[j] = __builtin_nontemporal_load((const GAS v4u*)(gp + col)); }
#pragma unroll
            for (int j = 0; j < 8; ++j) { const int col = (2 * j + hl) * 256 + cl; const v4u a = av[j], b = bv[j], gt = gv[j];
                float o[8];
                o[0] = pg8::bflo(a.x) - lam * pg8::bflo(b.x); o[1] = pg8::bfhi(a.x) - lam * pg8::bfhi(b.x); o[2] = pg8::bflo(a.y) - lam * pg8::bflo(b.y); o[3] = pg8::bfhi(a.y) - lam * pg8::bfhi(b.y);
                o[4] = pg8::bflo(a.z) - lam * pg8::bflo(b.z); o[5] = pg8::bfhi(a.z) - lam * pg8::bfhi(b.z); o[6] = pg8::bflo(a.w) - lam * pg8::bflo(b.w); o[7] = pg8::bfhi(a.w) - lam * pg8::bfhi(b.w);
                float ss = 0.f;
#pragma unroll
                for (int e = 0; e < 8; ++e) ss += o[e] * o[e];
                const float rstd = __builtin_amdgcn_rsqf(half_sum(ss) * (1.f / 256.f) + EPS);
                float gg[8] = {pg8::bflo(gt.x), pg8::bfhi(gt.x), pg8::bflo(gt.y), pg8::bfhi(gt.y), pg8::bflo(gt.z), pg8::bfhi(gt.z), pg8::bflo(gt.w), pg8::bfhi(gt.w)};
#pragma unroll
                for (int e = 0; e < 8; ++e) o[e] = o[e] * rstd * (e < 4 ? sg0[e] : sg1[e - 4]) * (gg[e] * pg8::sigmoidf_fast(gg[e]));
                *(GAS v4u*)(AO + pg8::blk_off(row, col)) = (v4u){pk2(o[0], o[1]), pk2(o[2], o[3]), pk2(o[4], o[5]), pk2(o[6], o[7])}; }
        }
    }
    SEAM(4);

    if (IN(5)) {
        pg8::Gemm g{AO, Wout0, 4096, 128u, 32u, 32768u, 2097152u, 128u, 32768u, 2097152u}; pg8::StaticOrder S; S.init(68, 16, G, bx);
        pg8::EpiStore E{OUT0, 4096, 1};
        pg8::gemm_phase<pg8::EpiStore, pg8::StaticOrder, PG8_ALIGN, PG8_SP2>(L + RING_OFF, g, S, E);
        const int first_free = (G > 64) ? 64 : 0, nfree = G - first_free;
        if (bx >= first_free) {
            LAS float* sv = (LAS float*)L; LAS f32x4* red = (LAS f32x4*)(L + 8192);
            for (int item = 384 + (bx - first_free); item < 768; item += nfree) GEMV_ITEM(item);
            __syncthreads();
            { LAS float* scr = (LAS float*)(L + RING_OFF + wave * 16384); const int nfw = nfree * NWAVES;
              for (int it = (bx - first_free) * NWAVES + wave; it < 64 * 256; it += nfw) transpose_item<false>(args.in[I_SWIN], 4096, 8192, W5in, scr, it, lane); }
        }
    }
    SEAM(5);

    if (IN(6)) {
        const float* npost = args.in[I_NPOST]; const float* npre1 = args.in[I_NPRE] + 4096;
        const int wgb = G >> 2, bq = (wgb > 0) ? vcu / wgb : 4, wl = (wgb > 0) ? vcu % wgb : 0;
        LAS f32x4* Vg = (LAS f32x4*)L; LAS f32x4* Va = Vg + 1024; LAS f32x4* Vs = Va + 1024;
#define P6_LOADVEC(mb) do { const float* gate0_ = MOD + (size_t)(mb) * 12288 + 8192; const float* shift1_ = MOD + (size_t)(5 + (mb)) * 12288; const float* scale1_ = shift1_ + 4096; \
            for (int q = tid; q < 1024; q += NWAVES * 64) { Vg[q] = ((const GAS f32x4*)gate0_)[q] * ((const GAS f32x4*)npost)[q]; Va[q] = ((const GAS f32x4*)npre1)[q] * (((const GAS f32x4*)scale1_)[q] + 1.f); Vs[q] = ((const GAS f32x4*)shift1_)[q]; } } while (0)
#define P6_ROW(row, xr, LAT) do { const bf16* op = OUT0 + (size_t)(row) * DM; \
            unsigned vbase = (unsigned)lane * 16u; asm volatile("" : "+v"(vbase)); \
            const LAS f32x4* Vg_ = (const LAS f32x4*)(L + vbase); const LAS f32x4* Va_ = Vg_ + 1024; const LAS f32x4* Vs_ = Va_ + 1024; \
            v2u ov[16]; float ss = 0.f; \
            _Pragma("unroll") for (int j = 0; j < 16; ++j) { ov[j] = ((const GAS v2u*)op)[lane + 64 * j]; const float a = pg8::bflo(ov[j].x), b = pg8::bfhi(ov[j].x), c = pg8::bflo(ov[j].y), d = pg8::bfhi(ov[j].y); ss += (a * a + b * b) + (c * c + d * d); } \
            f32x4 v[16]; \
            _Pragma("unroll") for (int j = 0; j < 16; ++j) v[j] = ((const GAS f32x4*)(xr))[lane + 64 * j]; \
            const float rstd0 = __builtin_amdgcn_rsqf(wave_sum(ss) * (1.f / DM) + EPS); float ss1 = 0.f; \
            _Pragma("unroll") for (int j = 0; j < 16; ++j) { const f32x4 o4 = {pg8::bflo(ov[j].x), pg8::bfhi(ov[j].x), pg8::bflo(ov[j].y), pg8::bfhi(ov[j].y)}; \
                v[j] = v[j] + Vg_[64 * j] * (o4 * rstd0); ss1 += (v[j].x * v[j].x + v[j].y * v[j].y) + (v[j].z * v[j].z + v[j].w * v[j].w); \
                if (LAT) ((GAS v2u*)(X1B + (size_t)(row) * DM))[lane + 64 * j] = (v2u){pk2(v[j].x, v[j].y), pk2(v[j].z, v[j].w)}; if ((j & 3) == 3) __builtin_amdgcn_sched_barrier(0); } \
            const float rstd1 = __builtin_amdgcn_rsqf(wave_sum(ss1) * (1.f / DM) + EPS); \
            _Pragma("unroll") for (int j = 0; j < 16; ++j) { const f32x4 h = v[j] * rstd1 * Va_[64 * j] + Vs_[64 * j]; *(GAS v2u*)(Hb + pg8::blk_off((row), 4 * (lane + 64 * j))) = (v2u){pk2(h.x, h.y), pk2(h.z, h.w)}; \
                if ((j & 3) == 3) __builtin_amdgcn_sched_barrier(0); } } while (0)
        if (bq < 4) P6_LOADVEC(bq);
        __syncthreads();
        if (bq < 4) for (int r = wl * NWAVES + wave; r < SEQL; r += wgb * NWAVES) { const int row = bq * SEQL + r; P6_ROW(row, x + (size_t)row * DM, true); }
        __syncthreads();
        P6_LOADVEC(4);
        __syncthreads();
        for (int row = MLAT + gw; row < MTOT; row += NGW) P6_ROW(row, ctx + (size_t)(row - MLAT) * DM, false);
        __syncthreads();
#undef P6_ROW
#undef P6_LOADVEC
    }
    SEAM(6);

    if (IN(7)) {
        pg8::Gemm g{Hb, W5in, 4096, 128u, 32u, 32768u, 2097152u, 128u, 32768u, 2097152u}; pg8::OrderP7 S{G, bx};
        pg8::EpiS5In E{XS, SZ};
        pg8::gemm_phase<pg8::EpiS5In, pg8::OrderP7, PG8_ALIGN, PG8_SP2>(L + RING_OFF, g, S, E);
        { const int first_free = (G > 64) ? 64 : 0, nfw = (G - first_free) * NWAVES;
          if (bx >= first_free) {
        for (int g = bx - first_free; g < ((G >= 128) ? 192 : 256); g += G - first_free) {
            LAS f32x2* pw = (LAS f32x2*)L;
            LAS f32x2* Bb = (LAS f32x2*)(L + 17408);
            LAS f32x2* Cc = (LAS f32x2*)(L + 17408 + 16384);
            LAS float* Kt = (LAS float*)(L + 17408 + 32768);
            LAS f32x2* fz = (LAS f32x2*)(L + 17408 + 65536);
            if (tid < 128) {
                const int d = tid >> 6, p = tid & 63; const int gi = (d * 256 + g) * 64 + p;
                const double dt = exp_d((double)args.in[I_SLDT][d * 256 + g]);
                const double Ar = (double)args.in[I_SARE][gi], Ai = (double)args.in[I_SAIM][gi];
                const double mag = exp_d(Ar * dt); double sn, cs; sincos_d(Ai * dt, sn, cs);
                const double ar = mag * cs, ai = mag * sn;
                const double den = Ar * Ar + Ai * Ai;
                const double fr_ = ((ar - 1.0) * Ar + ai * Ai) / den, fi_ = (ai * Ar - (ar - 1.0) * Ai) / den;
                fz[d * 64 + p] = (f32x2){(float)fr_, (float)fi_};
                double pr = 1.0, pi = 0.0;
                for (int n = 0; n <= 16; ++n) { pw[(d * 17 + n) * 64 + p] = (f32x2){(float)pr, (float)pi}; const double t = pr * ar - pi * ai; pi = pr * ai + pi * ar; pr = t; }
                *(GAS f32x2*)(A16 + (size_t)gi * 2) = pw[(d * 17 + 16) * 64 + p];
            }
            __syncthreads();
            for (int e = tid; e < 2048; e += 512) {
                { const int d = e >> 10, p = (e >> 4) & 63, c = e & 15; const size_t gi = ((size_t)(d * 256 + g) * 64 + p) * 16 + c;
                  const float br = args.in[I_SBRE][gi], bi = args.in[I_SBIM][gi]; const f32x2 f = fz[d * 64 + p];
                  Bb[e] = (f32x2){f.x * br - f.y * bi, f.x * bi + f.y * br}; }
                { const int d = e >> 10, c = (e >> 6) & 15, p = e & 63; const size_t gi = ((size_t)(d * 256 + g) * 16 + c) * 64 + p;
                  Cc[e] = (f32x2){args.in[I_SCRE][gi], args.in[I_SCIM][gi]}; }
            }
            __syncthreads();
            {
                const int cp = tid & 15, c = (tid >> 4) & 15, d = tid >> 8; float kacc[16];
#pragma unroll
                for (int t = 0; t < 16; ++t) kacc[t] = 0.f;
                for (int p = 0; p < 64; ++p) { const f32x2 cc = Cc[(d * 16 + c) * 64 + p], bb = Bb[(d * 64 + p) * 16 + cp];
                    const float tr = cc.x * bb.x - cc.y * bb.y, ti = cc.x * bb.y + cc.y * bb.x;
#pragma unroll
                    for (int t = 0; t < 16; ++t) { const f32x2 aa = pw[(d * 17 + t) * 64 + p]; kacc[t] += tr * aa.x - ti * aa.y; } }
#pragma unroll
                for (int t = 0; t < 16; ++t) Kt[((d * 16 + t) * 16 + c) * 16 + cp] = kacc[t];
            }
            __syncthreads();
            const float* Dk = args.in[I_SD] + g * 16;
            for (int e = tid; e < 16384; e += 512) {
                const int ch = e & 63, n = e >> 6, t = n >> 4, c = n & 15; float v[8];
                if (ch < 32) { const int sI = ch >> 1, c0 = (ch & 1) * 8;
#pragma unroll
                    for (int i = 0; i < 8; ++i) v[i] = 0.f;
                    if (sI <= t) { const LAS f32x4* kp = (const LAS f32x4*)(Kt + ((0 * 16 + (t - sI)) * 16 + c) * 16 + c0); const f32x4 a0 = kp[0], a1 = kp[1];
                        v[0] += a0.x; v[1] += a0.y; v[2] += a0.z; v[3] += a0.w; v[4] += a1.x; v[5] += a1.y; v[6] += a1.z; v[7] += a1.w; }
                    if (sI >= t) { const LAS f32x4* kp = (const LAS f32x4*)(Kt + ((1 * 16 + (sI - t)) * 16 + c) * 16 + c0); const f32x4 a0 = kp[0], a1 = kp[1];
                        v[0] += a0.x; v[1] += a0.y; v[2] += a0.z; v[3] += a0.w; v[4] += a1.x; v[5] += a1.y; v[6] += a1.z; v[7] += a1.w; }
                    if (sI == t && (c >> 3) == (ch & 1)) { const float dk = Dk[c];
#pragma unroll
                        for (int i = 0; i < 8; ++i) v[i] += ((c & 7) == i) ? dk : 0.f; }
                } else { const int kk = (ch - 32) * 8, d = kk >> 7, p0 = (kk & 127) >> 1, pwn = d == 0 ? t + 1 : 16 - t;
#pragma unroll
                    for (int i = 0; i < 4; ++i) { const f32x2 cc = Cc[(d * 16 + c) * 64 + p0 + i], aa = pw[(d * 17 + pwn) * 64 + p0 + i]; v[2 * i] = cc.x * aa.x - cc.y * aa.y; v[2 * i + 1] = -(cc.x * aa.y + cc.y * aa.x); } }
                *(GAS v4u*)(W2tab + ((size_t)g * 256 + n) * 512 + 8 * ch) = (v4u){pk2(v[0], v[1]), pk2(v[2], v[3]), pk2(v[4], v[5]), pk2(v[6], v[7])};
            }
            for (int e = tid; e < 8192; e += 512) {
                const int ch = e & 31, n = e >> 5, d = n >> 7, p = (n & 127) >> 1, ri = n & 1, sI = ch >> 1, c0 = (ch & 1) * 8, pwn = d == 0 ? 15 - sI : sI;
                const f32x2 aa = pw[(d * 17 + pwn) * 64 + p]; float v[8];
#pragma unroll
                for (int i = 0; i < 8; ++i) { const f32x2 b = Bb[(d * 64 + p) * 16 + c0 + i]; v[i] = ri ? (aa.x * b.y + aa.y * b.x) : (aa.x * b.x - aa.y * b.y); }
                *(GAS v4u*)(Etab + ((size_t)g * 256 + n) * 256 + 8 * ch) = (v4u){pk2(v[0], v[1]), pk2(v[2], v[3]), pk2(v[4], v[5]), pk2(v[6], v[7])};
            }
            __syncthreads();
        }
              LAS float* scr = (LAS float*)(L + RING_OFF + wave * 16384);
              for (int it = (bx - first_free) * NWAVES + wave; it < 2 * 64 * 128; it += nfw) {
                  if (it < 64 * 128) quant_item<false>(args.in[I_SWGLU], 4096, COLMAX2, WGLU8, CS2, scr, it, lane);
                  else transpose_item<false>(args.in[I_SWOUT], 4096, 4096, W5out, scr, it - 64 * 128, lane); } } }
    }
    SEAM(7);

    if (IN(8)) {
        { pg8::Gemm g{XS, Etab, 256, 1024u, 32u, 128u, 262144u, 512u, 128u, 131072u}; pg8::OrderGrp<5> S{G, vcu};
          pg8::EpiStore E{HLOC, 256, 0};
          pg8::gemm_phase<pg8::EpiStore, pg8::OrderGrp<5>, PG8_ALIGN, PG8_SP2>(L + RING_OFF, g, S, E); }
        asm volatile("s_waitcnt vmcnt(0)" ::: "memory"); __syncthreads();
        for (int g = vcu; g < 256; g += G) {
            const int d = wave & 1, b = wave >> 1, p = lane;
            const f32x2 a = *(const GAS f32x2*)(A16 + ((size_t)(d * 256 + g) * 64 + p) * 2);
            const bf16* hl = HLOC + (size_t)g * 1280 * 256 + d * 128 + 2 * p; bf16* xo = XS + (size_t)g * 1280 * 512 + 256 + d * 128 + 2 * p;
            float hr = 0.f, hi_ = 0.f;
            {   unsigned v[16];
#pragma unroll
                for (int j = 0; j < 16; ++j) { const int cj = d ? 15 - j : j; v[j] = *(const GAS unsigned*)(hl + (size_t)(1024 + b * 16 + cj) * 256); }
#pragma unroll
                for (int j = 0; j < 16; ++j) { const float tr = a.x * hr - a.y * hi_ + pg8::bflo(v[j]), ti = a.x * hi_ + a.y * hr + pg8::bfhi(v[j]); hr = tr; hi_ = ti; } }
            for (int j0 = 0; j0 < 256; j0 += 32) {
                unsigned v[32];
#pragma unroll
                for (int j = 0; j < 32; ++j) { const int cj = d ? 255 - (j0 + j) : (j0 + j); v[j] = *(const GAS unsigned*)(hl + (size_t)(b * 256 + cj) * 256); }
#pragma unroll
                for (int j = 0; j < 32; ++j) { const int cj = d ? 255 - (j0 + j) : (j0 + j);
                    *(GAS unsigned*)(xo + (size_t)(b * 256 + cj) * 512) = pk2(hr, hi_);
                    const float tr = a.x * hr - a.y * hi_ + pg8::bflo(v[j]), ti = a.x * hi_ + a.y * hr + pg8::bfhi(v[j]); hr = tr; hi_ = ti; }
            }
        }
        asm volatile("s_waitcnt vmcnt(0)" ::: "memory"); __syncthreads();
        { pg8::Gemm g{XS, W2tab, 512, 1024u, 32u, 128u, 262144u, 1024u, 128u, 262144u}; pg8::OrderGrp<4> S{G, vcu};
          pg8::EpiS5Out E{YG, TOKMAX};
          pg8::gemm_phase<pg8::EpiS5Out, pg8::OrderGrp<4>, PG8_ALIGN, PG8_SP2>(L + RING_OFF, g, S, E); }
    }
    if (IN(8) && IN(11)) xcd_barrier(bar);


    if (IN(11)) {
        for (int it = bx; it < 1024; it += G) { const int tb = it >> 5, gb = it & 31, g = gb * 8 + wave;
            v4u y0[8], y1[8]; float tm[8];
#pragma unroll
            for (int u = 0; u < 8; ++u) { const int token = tb * 512 + u * 64 + lane; const v4u* yp = (const v4u*)(YG + ((size_t)g * 16384 + token) * 16);
                y0[u] = __builtin_nontemporal_load(yp); y1[u] = __builtin_nontemporal_load(yp + 1); tm[u] = __uint_as_float(TOKMAX[token]); }
#pragma unroll
            for (int u = 0; u < 8; ++u) { const float inv = tm[u] > 0.f ? 127.f / tm[u] : 0.f;
                v4u o; o.x = q8pack(pg8::bflo(y0[u].x) * inv, pg8::bfhi(y0[u].x) * inv, pg8::bflo(y0[u].y) * inv, pg8::bfhi(y0[u].y) * inv); o.y = q8pack(pg8::bflo(y0[u].z) * inv, pg8::bfhi(y0[u].z) * inv, pg8::bflo(y0[u].w) * inv, pg8::bfhi(y0[u].w) * inv);
                o.z = q8pack(pg8::bflo(y1[u].x) * inv, pg8::bfhi(y1[u].x) * inv, pg8::bflo(y1[u].y) * inv, pg8::bfhi(y1[u].y) * inv); o.w = q8pack(pg8::bflo(y1[u].z) * inv, pg8::bfhi(y1[u].z) * inv, pg8::bflo(y1[u].w) * inv, pg8::bfhi(y1[u].w) * inv);
                *(LAS v4u*)(L + RING_OFF + (u * 64 + lane) * 128 + ((wave ^ (lane & 7)) << 4)) = o;
                if (gb == 0 && wave == 0) RS[tb * 512 + u * 64 + lane] = tm[u] * (1.f / 127.f); }
            __syncthreads();
#pragma unroll
            for (int i = 0; i < 8; ++i) { const int row = wave * 64 + i * 8 + (lane >> 3), piece = lane & 7;
                const v4u o = *(const LAS v4u*)(L + RING_OFF + row * 128 + ((piece ^ (row & 7)) << 4));
                *(GAS v4u*)(A8 + pg8::blk8_off(tb * 512 + row, gb * 128) + piece * 16) = o; }
            __syncthreads(); }
        xcd_barrier(bar);
        pg8::Gemm g{(const pg8::bf16_t*)A8, (const pg8::bf16_t*)WGLU8, 2048, 128u, 32u, 32768u, 1048576u, 128u, 32768u, 1048576u}; pg8::StaticOrder S; S.init(64, 16, G, bx);
        pg8::EpiGlu8 E{YG, SZ, Y2, RS, CS2};
        pg8::gemm_phase<pg8::EpiGlu8, pg8::StaticOrder, PG8_ALIGN, PG8_SP2, true>(L + RING_OFF, g, S, E);
    }
    SEAM(11);

    if (IN(12)) {
        pg8::Gemm g{Y2, W5out, 4096, 128u, 32u, 32768u, 2097152u, 128u, 32768u, 2097152u}; pg8::StaticOrder S; S.init(64, 16, G, bx);
        pg8::EpiStore E{OUT1, 4096, 1};
        pg8::gemm_phase<pg8::EpiStore, pg8::StaticOrder, PG8_ALIGN, PG8_SP2>(L + RING_OFF, g, S, E);
    }
    SEAM(12);

    if (IN(13)) {
        const float* npost1 = args.in[I_NPOST] + 4096;
        const int wgb = G >> 2, bq = (wgb > 0) ? vcu / wgb : 4, wl = (wgb > 0) ? vcu % wgb : 0;
        LAS f32x4* Vg = (LAS f32x4*)L;
        if (bq < 4) { const float* gate1 = MOD + (size_t)(5 + bq) * 12288 + 8192;
            for (int q = tid; q < 1024; q += NWAVES * 64) Vg[q] = ((const GAS f32x4*)gate1)[q] * ((const GAS f32x4*)npost1)[q]; }
        __syncthreads();
        if (bq < 4) for (int r = wl * NWAVES + wave; r < SEQL; r += wgb * NWAVES) {
            const int row = bq * SEQL + r; const bf16* op = OUT1 + (size_t)row * DM; float* xo = args.out + (size_t)row * DM;
            unsigned vbase = (unsigned)lane * 16u; asm volatile("" : "+v"(vbase));
            const LAS f32x4* Vg_ = (const LAS f32x4*)(L + vbase);
            v2u ov[16]; float ss = 0.f;
#pragma unroll
            for (int j = 0; j < 16; ++j) { ov[j] = ((const GAS v2u*)op)[lane + 64 * j]; const float a = pg8::bflo(ov[j].x), b = pg8::bfhi(ov[j].x), c = pg8::bflo(ov[j].y), d = pg8::bfhi(ov[j].y); ss += (a * a + b * b) + (c * c + d * d); }
            v2u xv[16]; const bf16* x1p = X1B + (size_t)row * DM;
#pragma unroll
            for (int j = 0; j < 16; ++j) xv[j] = ((const GAS v2u*)x1p)[lane + 64 * j];
            const float rstd = __builtin_amdgcn_rsqf(wave_sum(ss) * (1.f / DM) + EPS);
#pragma unroll
            for (int j = 0; j < 16; ++j) { const f32x4 o4 = {pg8::bflo(ov[j].x), pg8::bfhi(ov[j].x), pg8::bflo(ov[j].y), pg8::bfhi(ov[j].y)};
                const f32x4 x4 = {pg8::bflo(xv[j].x), pg8::bfhi(xv[j].x), pg8::bflo(xv[j].y), pg8::bfhi(xv[j].y)};
                ((GAS f32x4*)xo)[lane + 64 * j] = x4 + Vg_[64 * j] * (o4 * rstd); if ((j & 3) == 3) __builtin_amdgcn_sched_barrier(0); }
        }
    }
#undef IN
#undef SEAM
}

extern "C" void kernel_launch(void* const* d_in, const int* in_sizes, int n_in, void* d_out, int out_size, void* d_ws, size_t ws_size, hipStream_t stream) {
    static int grid = 0;
    if (grid == 0) {
        if (n_in != 23 || out_size != MLAT * DM || ws_size < WS_END) { fprintf(stderr, "kernel_launch: unexpected shapes: n_in %d out %d ws %zu (need %zu)\n", n_in, out_size, ws_size, (size_t)WS_END); grid = -1; return; }
        int dev = 0, cus = 0, per_cu = 0;
        if (hipGetDevice(&dev) != hipSuccess || hipDeviceGetAttribute(&cus, hipDeviceAttributeMultiprocessorCount, dev) != hipSuccess) { grid = -1; return; }
        if (hipFuncSetAttribute((const void*)fwd_kernel, hipFuncAttributeMaxDynamicSharedMemorySize, LDS_BYTES) != hipSuccess) { fprintf(stderr, "kernel_launch: hipFuncSetAttribute failed\n"); grid = -1; return; }
        if (hipOccupancyMaxActiveBlocksPerMultiprocessor(&per_cu, (const void*)fwd_kernel, NWAVES * 64, LDS_BYTES) != hipSuccess || per_cu < 1) { fprintf(stderr, "kernel_launch: occupancy query says %d\n", per_cu); }
        (void)hipGetLastError();
        grid = cus;
    }
    if (grid < 0) return;
    if (hipMemsetAsync((char*)d_ws + WS_CTL, 0, CTL_ZERO_BYTES, stream) != hipSuccess) return;
    Args a{};
    for (int i = 0; i < 23; ++i) a.in[i] = (const float*)d_in[i];
    a.out = (float*)d_out; a.ws = (unsigned char*)d_ws;
#if MK_PER_PHASE
    for (int p = 0; p < MK_LAST_PHASE; ++p) { a.ph_lo = p; a.ph_hi = p + 1; hipLaunchKernelGGL(fwd_kernel, dim3(grid), dim3(NWAVES * 64), LDS_BYTES, stream, a); }
#else
    a.ph_lo = 0; a.ph_hi = MK_LAST_PHASE;
    hipLaunchKernelGGL(fwd_kernel, dim3(grid), dim3(NWAVES * 64), LDS_BYTES, stream, a);
#endif
    const hipError_t le = hipPeekAtLastError();
    if (le != hipSuccess) fprintf(stderr, "kernel_launch: launch failed: %s\n", hipGetErrorName(le));
}
```

```cpp
#include <hip/hip_runtime.h>
#include <cstdio>
#include <cstdint>
#include <type_traits>

#ifndef MK_PER_PHASE
#define MK_PER_PHASE 0
#endif
#ifndef MK_LAST_PHASE
#define MK_LAST_PHASE 14
#endif

namespace pg8 {
#define PG8_LAS __attribute__((address_space(3)))
typedef unsigned short bf16_t;
typedef short bf16x8 __attribute__((ext_vector_type(8)));
typedef float f32x4 __attribute__((ext_vector_type(4)));
typedef unsigned u32x4 __attribute__((ext_vector_type(4)));
typedef int i32x4 __attribute__((ext_vector_type(4)));
constexpr int BM = 256, BK = 64, HALF = 128, HTB = HALF * BK * 2, STAGE_BYTES = 8 * HTB, NXCD = 8, WGM = 8;

__host__ __device__ __forceinline__ int lds_byte(int r, int c) { const int st = (r >> 4) * 2 + (c >> 5), rr = r & 15, cc = c & 31, ob = rr * 64 + cc * 2; return st * 1024 + (ob ^ (((ob >> 9) & 1) << 5)); }
__host__ __device__ __forceinline__ void stage_rc(int b, int& R, int& C) { const int st = b / 1024, sb = b % 1024, swz = sb ^ (((sb >> 9) & 1) << 5); R = (st >> 1) * 16 + swz / 64; C = (st & 1) * 32 + (swz % 64) / 2; }
__host__ __device__ __forceinline__ int perm32(int rho) { const int n = rho >> 4, i = rho & 15; return 8 * (i >> 2) + 4 * n + (i & 3); }

struct Unit { int pm, pn; };
struct Gemm { const bf16_t* A; const bf16_t* Bt; int K; unsigned a_row, a_cg, a_kt, a_tile, b_row, b_kt, b_tile; };
__host__ __device__ __forceinline__ size_t blk8_off(int r, int c) { return ((size_t)((r >> 8) * 32 + (c >> 7)) << 15) + (size_t)(((r & 255) << 7) + (c & 127)); }
__host__ __device__ __forceinline__ size_t blk_off(int r, int c) { return ((size_t)((r >> 8) * 64 + (c >> 6)) << 14) + (size_t)(((r & 255) << 6) + (c & 63)); }

__host__ __device__ __forceinline__ void static_map(int L, int nM, int nN, int& pm, int& pn) {
    const int nwg = nM * nN; int wgid = L;
    { const int q = nwg / NXCD, r = nwg % NXCD, xcd = wgid % NXCD, off = wgid / NXCD; wgid = (xcd < r ? xcd * (q + 1) : r * (q + 1) + (xcd - r) * q) + off; }
    const int nig = WGM * nN, gid = wgid / nig, fm = gid * WGM, gsz = (nM - fm) < WGM ? (nM - fm) : WGM;
    pm = fm + ((wgid % nig) % gsz); pn = (wgid % nig) / gsz;
}
struct StaticOrder {
    int nM, nN, nwg, G, c;
    __host__ __device__ void init(int nM_, int nN_, int G_, int c_) { nM = nM_; nN = nN_; nwg = nM * nN; G = G_; c = c_; }
    __host__ __device__ bool next(int i, Unit& u) const { const long L = (long)i * G + c; if (L >= nwg) return false; static_map((int)L, nM, nN, u.pm, u.pn); return true; }
    __device__ __forceinline__ void a_ready(const Unit&) const {}
    __device__ __forceinline__ void done(const Unit&) const {}
};
struct OrderP7 {
    int G, c;
    __host__ __device__ bool next(int i, Unit& u) const { const long L = (long)i * G + c; if (L >= 2112) return false;
        if (L < 2048) static_map((int)L, 64, 32, u.pm, u.pn); else { const int e = (int)L - 2048; u.pm = 64 + (e & 3); u.pn = e >> 2; } return true; }
    __device__ __forceinline__ void a_ready(const Unit&) const {}
    __device__ __forceinline__ void done(const Unit&) const {}
};
template <int RT> struct OrderGrp {
    int G, c;
    __host__ __device__ bool next(int i, Unit& u) const { const int g = c + (i / RT) * G, rt = i % RT; if (g >= 256) return false; u.pm = g * 5 + rt; u.pn = g; return true; }
    __device__ __forceinline__ void a_ready(const Unit&) const {}
    __device__ __forceinline__ void done(const Unit&) const {}
};
template <int RT> struct OrderS5 {
    int G, c;
    __host__ __device__ bool next(int i, Unit& u) const { const long L = (long)i * G + c; if (L >= 256 * RT) return false; const int g = (int)L / RT, rt = (int)L % RT; u.pm = g * 5 + rt; u.pn = g; return true; }
    __device__ __forceinline__ void a_ready(const Unit&) const {}
    __device__ __forceinline__ void done(const Unit&) const {}
};

__device__ __forceinline__ unsigned cvt_pk_bf16(float lo, float hi) { unsigned r; asm("v_cvt_pk_bf16_f32 %0, %1, %2" : "=v"(r) : "v"(lo), "v"(hi)); return r; }
__device__ __forceinline__ float bflo(unsigned w) { return __uint_as_float(w << 16); }
__device__ __forceinline__ float bfhi(unsigned w) { return __uint_as_float(w & 0xffff0000u); }
__device__ __forceinline__ u32x4 pack8(const f32x4& v0, const f32x4& v1) { u32x4 w; w.x = cvt_pk_bf16(v0[0], v0[1]); w.y = cvt_pk_bf16(v0[2], v0[3]); w.z = cvt_pk_bf16(v1[0], v1[1]); w.w = cvt_pk_bf16(v1[2], v1[3]); return w; }
__device__ __forceinline__ float sigmoidf_fast(float v) { return __builtin_amdgcn_rcpf(1.f + __builtin_amdgcn_exp2f(-1.4426950408889634f * v)); }

struct EpiStore {
    static constexpr bool PERM = true, AFTER_DRAIN = false;
    bf16_t* O; int ldc; int use_pn;
    __device__ __forceinline__ void operator()(const f32x4 (&acc)[2][2][4][2], const Unit& u, int wr, int wc, int fr, int fq) const {
        const int row0 = u.pm * BM + wr * 64 + fr, col0 = (use_pn ? u.pn * BM : 0) + wc * 32 + 8 * fq;
#pragma unroll
        for (int ai = 0; ai < 2; ++ai)
#pragma unroll
            for (int m = 0; m < 4; ++m) { bf16_t* rowp = O + (size_t)(row0 + ai * HALF + m * 16) * ldc + col0;
#pragma unroll
                for (int bj = 0; bj < 2; ++bj) *(u32x4*)(rowp + bj * HALF) = pack8(acc[ai][bj][m][0], acc[ai][bj][m][1]); }
    }
};
struct EpiRope {
    static constexpr bool PERM = true, AFTER_DRAIN = false;
    bf16_t* QH; bf16_t* KH; bf16_t* VH; bf16_t* GT; const float* rope; int pn_off;
    __device__ __forceinline__ void operator()(const f32x4 (&acc)[2][2][4][2], const Unit& u, int wr, int wc, int fr, int fq) const {
        const int row0 = u.pm * BM + wr * 64 + fr, sec = (u.pn + pn_off) >> 4, h = (u.pn + pn_off) & 15, cw = wc * 32 + 8 * fq;
        const bool do_rope = (u.pm < 64) && (sec < 2);
        const int axis = wc >> 1, f0 = (wc & 1) * 16 + 4 * fq;
        bf16_t* base; size_t rstride, bjstride;
        if (sec < 2) { base = (sec == 0 ? QH : KH) + (size_t)(h * 2) * 17408 * 128; rstride = 128; bjstride = (size_t)17408 * 128; }
        else if (sec == 2) { base = VH + (size_t)h * 17408 * 256; rstride = 256; bjstride = 128; }
        else { base = GT + h * 256; rstride = 4096; bjstride = 128; }
#pragma unroll
        for (int ai = 0; ai < 2; ++ai)
#pragma unroll
            for (int m = 0; m < 4; ++m) { const int row = row0 + ai * HALF + m * 16; bf16_t* rowp = base + (size_t)row * rstride + cw;
                f32x4 c0 = {1.f, 0.f, 1.f, 0.f}, c1 = {1.f, 0.f, 1.f, 0.f};
                if (do_rope) { const int t = row & 4095, pos = axis ? (t & 63) : (t >> 6); const f32x4* tp = (const f32x4*)(rope + (pos * 32 + f0) * 2); c0 = tp[0]; c1 = tp[1]; }
#pragma unroll
                for (int bj = 0; bj < 2; ++bj) { const f32x4 a = acc[ai][bj][m][0], b = acc[ai][bj][m][1]; f32x4 v0, v1;
                    v0[0] = a[0] * c0[0] - a[1] * c0[1]; v0[1] = a[1] * c0[0] + a[0] * c0[1]; v0[2] = a[2] * c0[2] - a[3] * c0[3]; v0[3] = a[3] * c0[2] + a[2] * c0[3];
                    v1[0] = b[0] * c1[0] - b[1] * c1[1]; v1[1] = b[1] * c1[0] + b[0] * c1[1]; v1[2] = b[2] * c1[2] - b[3] * c1[3]; v1[3] = b[3] * c1[2] + b[2] * c1[3];
                    *(u32x4*)(rowp + bj * bjstride) = pack8(v0, v1); } }
    }
};
struct EpiRope8 {
    static constexpr bool PERM = true, AFTER_DRAIN = false;
    bf16_t* QH; bf16_t* KH; bf16_t* VH; bf16_t* GT; const float* rope; const float* RS; const float* CS;
    __device__ __forceinline__ void operator()(const i32x4 (&acc)[2][2][4][2], const Unit& u, int wr, int wc, int fr, int fq) const {
        const int row0 = u.pm * BM + wr * 64 + fr, sec = u.pn >> 4, h = u.pn & 15, cw = wc * 32 + 8 * fq;
        const bool do_rope = (u.pm < 64) && (sec < 2);
        const int axis = wc >> 1, f0 = (wc & 1) * 16 + 4 * fq;
        f32x4 csv[2][2];
#pragma unroll
        for (int bj = 0; bj < 2; ++bj)
#pragma unroll
            for (int n = 0; n < 2; ++n) csv[bj][n] = *(const f32x4*)(CS + u.pn * BM + bj * HALF + cw + 4 * n);
        bf16_t* base; size_t rstride, bjstride;
        if (sec < 2) { base = (sec == 0 ? QH : KH) + (size_t)(h * 2) * 17408 * 128; rstride = 128; bjstride = (size_t)17408 * 128; }
        else if (sec == 2) { base = VH + (size_t)h * 17408 * 256; rstride = 256; bjstride = 128; }
        else { base = GT + h * 256; rstride = 4096; bjstride = 128; }
        if (!do_rope) {
#pragma unroll
            for (int ai = 0; ai < 2; ++ai)
#pragma unroll
                for (int m = 0; m < 4; ++m) { const int row = row0 + ai * HALF + m * 16; bf16_t* rowp = base + (size_t)row * rstride + cw; const float rsv = RS[row];
#pragma unroll
                    for (int bj = 0; bj < 2; ++bj) *(u32x4*)(rowp + bj * bjstride) = pack8(__builtin_convertvector(acc[ai][bj][m][0], f32x4) * (csv[bj][0] * rsv), __builtin_convertvector(acc[ai][bj][m][1], f32x4) * (csv[bj][1] * rsv)); }
            return;
        }
#pragma unroll
        for (int ai = 0; ai < 2; ++ai)
#pragma unroll
            for (int m = 0; m < 4; ++m) { const int row = row0 + ai * HALF + m * 16; bf16_t* rowp = base + (size_t)row * rstride + cw; const float rsv = RS[row];
                f32x4 c0 = {1.f, 0.f, 1.f, 0.f}, c1 = {1.f, 0.f, 1.f, 0.f};
                if (do_rope) { const int t = row & 4095, pos = axis ? (t & 63) : (t >> 6); const f32x4* tp = (const f32x4*)(rope + (pos * 32 + f0) * 2); c0 = tp[0]; c1 = tp[1]; }
#pragma unroll
                for (int bj = 0; bj < 2; ++bj) { const f32x4 a = __builtin_convertvector(acc[ai][bj][m][0], f32x4) * (csv[bj][0] * rsv), b = __builtin_convertvector(acc[ai][bj][m][1], f32x4) * (csv[bj][1] * rsv); f32x4 v0, v1;
                    v0[0] = a[0] * c0[0] - a[1] * c0[1]; v0[1] = a[1] * c0[0] + a[0] * c0[1]; v0[2] = a[2] * c0[2] - a[3] * c0[3]; v0[3] = a[3] * c0[2] + a[2] * c0[3];
                    v1[0] = b[0] * c1[0] - b[1] * c1[1]; v1[1] = b[1] * c1[0] + b[0] * c1[1]; v1[2] = b[2] * c1[2] - b[3] * c1[3]; v1[3] = b[3] * c1[2] + b[2] * c1[3];
                    *(u32x4*)(rowp + bj * bjstride) = pack8(v0, v1); } }
    }
};
struct EpiS5In {
    static constexpr bool PERM = true, AFTER_DRAIN = false;
    bf16_t* XS; bf16_t* SZ;
    __device__ __forceinline__ void operator()(const f32x4 (&acc)[2][2][4][2], const Unit& u, int wr, int wc, int fr, int fq) const {
        const int row0 = u.pm * BM + wr * 64 + fr, col0 = u.pn * BM + wc * 32 + 8 * fq;
        if (u.pn < 16) {
#pragma unroll
            for (int ai = 0; ai < 2; ++ai)
#pragma unroll
                for (int m = 0; m < 4; ++m) { const int row = row0 + ai * HALF + m * 16; const int xsrow = (row < 16384) ? (row >> 4) : (1024 + ((row - 16384) >> 4)), tt = row & 15;
#pragma unroll
                    for (int bj = 0; bj < 2; ++bj) { const int col = col0 + bj * HALF, g = col >> 4, half = col & 15;
                        *(u32x4*)((char*)XS + (size_t)g * (1280u * 1024u) + (size_t)xsrow * 1024 + tt * 32 + half * 2) = pack8(acc[ai][bj][m][0], acc[ai][bj][m][1]); } }
        } else {
#pragma unroll
            for (int ai = 0; ai < 2; ++ai)
#pragma unroll
                for (int m = 0; m < 4; ++m) { bf16_t* rowp = SZ + (size_t)(row0 + ai * HALF + m * 16) * 4096 + (col0 - 4096);
#pragma unroll
                    for (int bj = 0; bj < 2; ++bj) { f32x4 a = acc[ai][bj][m][0], b = acc[ai][bj][m][1];
#pragma unroll
                        for (int e = 0; e < 4; ++e) { a[e] = a[e] * sigmoidf_fast(a[e]); b[e] = b[e] * sigmoidf_fast(b[e]); }
                        *(u32x4*)(rowp + bj * HALF) = pack8(a, b); } }
        }
    }
};
struct EpiS5Out {
    static constexpr bool PERM = true, AFTER_DRAIN = false;
    bf16_t* YG; unsigned* tokmax;
    __device__ __forceinline__ void operator()(const f32x4 (&acc)[2][2][4][2], const Unit& u, int wr, int wc, int fr, int fq) const {
        const int g = u.pn, rt = u.pm - 5 * g; const int row0 = (g * 4 + rt) * BM + wr * 64 + fr, col0 = wc * 32 + 8 * fq;
#pragma unroll
        for (int ai = 0; ai < 2; ++ai)
#pragma unroll
            for (int m = 0; m < 4; ++m) { bf16_t* rowp = YG + (size_t)(row0 + ai * HALF + m * 16) * 256 + col0;
#pragma unroll
                for (int bj = 0; bj < 2; ++bj) { f32x4 a = acc[ai][bj][m][0], b = acc[ai][bj][m][1];
#pragma unroll
                    for (int e = 0; e < 4; ++e) { const float za = 1.5957691216057308f * (a[e] + 0.044715f * a[e] * a[e] * a[e]); a[e] = a[e] * sigmoidf_fast(za);
                                                  const float zb = 1.5957691216057308f * (b[e] + 0.044715f * b[e] * b[e] * b[e]); b[e] = b[e] * sigmoidf_fast(zb); }
                    *(u32x4*)(rowp + bj * HALF) = pack8(a, b);
                    float mx = fmaxf(fmaxf(fmaxf(__builtin_fabsf(a[0]), __builtin_fabsf(a[1])), fmaxf(__builtin_fabsf(a[2]), __builtin_fabsf(a[3]))), fmaxf(fmaxf(__builtin_fabsf(b[0]), __builtin_fabsf(b[1])), fmaxf(__builtin_fabsf(b[2]), __builtin_fabsf(b[3]))));
                    mx = fmaxf(mx, __shfl_xor(mx, 16));
                    if ((fq & 1) == 0) (void)__hip_atomic_fetch_max(tokmax + ((rt * BM + wr * 64 + fr + ai * HALF + m * 16) * 16 + wc * 2 + (fq >> 1) + bj * 8), __float_as_uint(mx), __ATOMIC_RELAXED, __HIP_MEMORY_SCOPE_AGENT); } }
    }
};
struct EpiGlu {
    static constexpr bool PERM = true, AFTER_DRAIN = false;
    const bf16_t* YG; const bf16_t* SZ; bf16_t* Y2;
    __device__ __forceinline__ void operator()(const f32x4 (&acc)[2][2][4][2], const Unit& u, int wr, int wc, int fr, int fq) const {
        const int row0 = u.pm * BM + wr * 64 + fr, col0 = u.pn * BM + wc * 32 + 8 * fq;
#pragma unroll
        for (int ai = 0; ai < 2; ++ai)
#pragma unroll
            for (int m = 0; m < 4; ++m) { const int row = row0 + ai * HALF + m * 16;
#pragma unroll
                for (int bj = 0; bj < 2; ++bj) { const int col = col0 + bj * HALF;
                    const u32x4 yv = *(const u32x4*)((const char*)YG + (size_t)(col >> 4) * (16384u * 32u) + (size_t)row * 32 + (col & 15) * 2);
                    const u32x4 sv = *(const u32x4*)(SZ + (size_t)row * 4096 + col);
                    const f32x4 a = acc[ai][bj][m][0], b = acc[ai][bj][m][1]; f32x4 v0, v1;
                    v0[0] = bflo(yv.x) * bflo(sv.x) * sigmoidf_fast(a[0]); v0[1] = bfhi(yv.x) * bfhi(sv.x) * sigmoidf_fast(a[1]);
                    v0[2] = bflo(yv.y) * bflo(sv.y) * sigmoidf_fast(a[2]); v0[3] = bfhi(yv.y) * bfhi(sv.y) * sigmoidf_fast(a[3]);
                    v1[0] = bflo(yv.z) * bflo(sv.z) * sigmoidf_fast(b[0]); v1[1] = bfhi(yv.z) * bfhi(sv.z) * sigmoidf_fast(b[1]);
                    v1[2] = bflo(yv.w) * bflo(sv.w) * sigmoidf_fast(b[2]); v1[3] = bfhi(yv.w) * bfhi(sv.w) * sigmoidf_fast(b[3]);
                    *(u32x4*)(Y2 + blk_off(row, col)) = pack8(v0, v1); } }
    }
};
struct EpiGlu8 {
    static constexpr bool PERM = true, AFTER_DRAIN = false;
    const bf16_t* YG; const bf16_t* SZ; bf16_t* Y2; const float* RS; const float* CS;
    __device__ __forceinline__ void operator()(const i32x4 (&acc)[2][2][4][2], const Unit& u, int wr, int wc, int fr, int fq) const {
        const int row0 = u.pm * BM + wr * 64 + fr, col0 = u.pn * BM + wc * 32 + 8 * fq;
        f32x4 csv[2][2];
#pragma unroll
        for (int bj = 0; bj < 2; ++bj)
#pragma unroll
            for (int n = 0; n < 2; ++n) csv[bj][n] = *(const f32x4*)(CS + col0 + bj * HALF + 4 * n);
#pragma unroll
        for (int am = 0; am < 4; ++am) { const int ai = am >> 1, mb = (am & 1) * 2;
            u32x4 yv[2][2], sv[2][2]; float rsv[2];
#pragma unroll
            for (int m = 0; m < 2; ++m) { const int row = row0 + ai * HALF + (mb + m) * 16; rsv[m] = RS[row];
#pragma unroll
                for (int bj = 0; bj < 2; ++bj) { const int col = col0 + bj * HALF;
                    yv[m][bj] = *(const u32x4*)((const char*)YG + (size_t)(col >> 4) * (16384u * 32u) + (size_t)row * 32 + (col & 15) * 2);
                    sv[m][bj] = *(const u32x4*)(SZ + (size_t)row * 4096 + col); } }
#pragma unroll
            for (int m = 0; m < 2; ++m) { const int row = row0 + ai * HALF + (mb + m) * 16;
#pragma unroll
                for (int bj = 0; bj < 2; ++bj) { const int col = col0 + bj * HALF; const u32x4 y = yv[m][bj], z = sv[m][bj];
                    const f32x4 a = __builtin_convertvector(acc[ai][bj][mb + m][0], f32x4) * (csv[bj][0] * rsv[m]), b = __builtin_convertvector(acc[ai][bj][mb + m][1], f32x4) * (csv[bj][1] * rsv[m]); f32x4 v0, v1;
                    v0[0] = bflo(y.x) * bflo(z.x) * sigmoidf_fast(a[0]); v0[1] = bfhi(y.x) * bfhi(z.x) * sigmoidf_fast(a[1]);
                    v0[2] = bflo(y.y) * bflo(z.y) * sigmoidf_fast(a[2]); v0[3] = bfhi(y.y) * bfhi(z.y) * sigmoidf_fast(a[3]);
                    v1[0] = bflo(y.z) * bflo(z.z) * sigmoidf_fast(b[0]); v1[1] = bfhi(y.z) * bfhi(z.z) * sigmoidf_fast(b[1]);
                    v1[2] = bflo(y.w) * bflo(z.w) * sigmoidf_fast(b[2]); v1[3] = bfhi(y.w) * bfhi(z.w) * sigmoidf_fast(b[3]);
                    *(u32x4*)(Y2 + blk_off(row, col)) = pack8(v0, v1); } }
        }
    }
};

template <class Epi, class Sched, bool ALIGN_EPI = false, bool SP2 = false, bool I8 = false>
__device__ __forceinline__ void gemm_phase(PG8_LAS unsigned char* lds, const Gemm g, const Sched& S, const Epi& E) {
    const int tid = threadIdx.x, wid = __builtin_amdgcn_readfirstlane(tid >> 6), lane = tid & 63, wr = wid >> 2, wc = wid & 3, fr = lane & 15, fq = lane >> 4;
    const int K = g.K, nt = K / BK;
    unsigned voffA[2], voffB[2];
#pragma unroll
    for (int i = 0; i < 2; ++i) { int R, C; stage_rc(tid * 16 + i * 8192, R, C); const int Rb = Epi::PERM ? ((R & ~31) + perm32(R & 31)) : R;
        voffA[i] = (unsigned)R * g.a_row + (unsigned)(C >> 4) * g.a_cg + (unsigned)(C & 15) * 2u; voffB[i] = (unsigned)Rb * g.b_row + (unsigned)C * 2u; }
    const size_t kstepA = (size_t)g.a_kt, kstepB = (size_t)g.b_kt;
    const size_t hstepA = (size_t)HALF * g.a_row, hstepB = (size_t)HALF * g.b_row;
    const size_t tstepA = (size_t)g.a_tile, tstepB = (size_t)g.b_tile;
    const unsigned ldsw = (unsigned)wid * 1024u;
    const int aoff = lds_byte(wr * 64 + fr, fq * 8), boff = lds_byte(wc * 32 + fr, fq * 8);
#define PG8_SA(b, h) (((b) * 2 + (h)) * HTB)
#define PG8_SB(b, h) ((4 + (b) * 2 + (h)) * HTB)
#define PG8_STAGE(bufoff, gbase, voff) do { _Pragma("unroll") for (int _i = 0; _i < 2; ++_i) \
        __builtin_amdgcn_global_load_lds((const unsigned*)((const char*)(gbase) + (voff)[_i]), (PG8_LAS unsigned*)(lds + (bufoff) + ldsw + _i * 8192), 16, 0, 0); } while (0)
#define PG8_LDA(dst, b, h) do { _Pragma("unroll") for (int m = 0; m < 4; ++m) _Pragma("unroll") for (int k = 0; k < 2; ++k) dst[m][k] = *(const PG8_LAS bf16x8*)(lds + PG8_SA(b, h) + aoff + m * 2048 + k * 1024); } while (0)
#define PG8_LDB(dst, b, h) do { _Pragma("unroll") for (int n = 0; n < 2; ++n) _Pragma("unroll") for (int k = 0; k < 2; ++k) dst[n][k] = *(const PG8_LAS bf16x8*)(lds + PG8_SB(b, h) + boff + n * 2048 + k * 1024); } while (0)
#define PG8_MMA(ai, bj, At, Bt) do { __builtin_amdgcn_s_setprio(1); _Pragma("unroll") for (int m = 0; m < 4; ++m) _Pragma("unroll") for (int n = 0; n < 2; ++n) _Pragma("unroll") for (int k = 0; k < 2; ++k) \
        { if constexpr (I8) acc[ai][bj][m][n] = __builtin_amdgcn_mfma_i32_16x16x64_i8(__builtin_bit_cast(i32x4, Bt[n][k]), __builtin_bit_cast(i32x4, At[m][k]), acc[ai][bj][m][n], 0, 0, 0); \
          else acc[ai][bj][m][n] = __builtin_amdgcn_mfma_f32_16x16x32_bf16(Bt[n][k], At[m][k], acc[ai][bj][m][n], 0, 0, 0); } __builtin_amdgcn_s_setprio(0); } while (0)
#define PG8_WAIT_V(n) asm volatile("s_waitcnt vmcnt(" #n ")" ::: "memory")
#define PG8_WAIT_L(n) asm volatile("s_waitcnt lgkmcnt(" #n ")" ::: "memory")
#define PG8_BAR __builtin_amdgcn_s_barrier()
#define PG8_SCHED __builtin_amdgcn_sched_barrier(0)
    Unit cur, nxt; int ui = 0;
    if (!S.next(0, cur)) return;
    typedef typename std::conditional<I8, i32x4, f32x4>::type acc_t;
    acc_t acc[2][2][4][2];
#pragma unroll
    for (int a = 0; a < 2; ++a)
#pragma unroll
        for (int b = 0; b < 2; ++b)
#pragma unroll
            for (int m = 0; m < 4; ++m)
#pragma unroll
                for (int n = 0; n < 2; ++n) acc[a][b][m][n] = acc_t{};
    bf16x8 At[4][2], B0[2][2], B1[2][2];
    const char* cA = (const char*)g.A + (size_t)cur.pm * tstepA; const char* cB = (const char*)g.Bt + (size_t)cur.pn * tstepB;
    S.a_ready(cur);
    if constexpr (SP2) {
        PG8_STAGE(PG8_SB(0, 0), cB, voffB); PG8_STAGE(PG8_SB(0, 1), cB + hstepB, voffB); PG8_STAGE(PG8_SA(0, 0), cA, voffA); PG8_STAGE(PG8_SA(0, 1), cA + hstepA, voffA);
        if (wr == 1) PG8_BAR;
        PG8_WAIT_V(2); PG8_BAR;
        PG8_STAGE(PG8_SB(1, 0), cB + kstepB, voffB); PG8_STAGE(PG8_SA(1, 0), cA + kstepA, voffA); PG8_STAGE(PG8_SB(1, 1), cB + hstepB + kstepB, voffB);
        PG8_WAIT_V(6); PG8_BAR;
    } else {
        PG8_STAGE(PG8_SB(0, 0), cB, voffB); PG8_STAGE(PG8_SA(0, 0), cA, voffA); PG8_STAGE(PG8_SB(0, 1), cB + hstepB, voffB); PG8_STAGE(PG8_SA(0, 1), cA + hstepA, voffA);
        if (wr == 1) PG8_BAR;
        PG8_WAIT_V(4); PG8_BAR;
        PG8_STAGE(PG8_SB(1, 0), cB + kstepB, voffB); PG8_STAGE(PG8_SA(1, 0), cA + kstepA, voffA); PG8_STAGE(PG8_SB(1, 1), cB + hstepB + kstepB, voffB);
        PG8_WAIT_V(6); PG8_BAR;
    }
    for (;;) {
        const bool has_next = S.next(ui + 1, nxt);
        const char* nA = has_next ? (const char*)g.A + (size_t)nxt.pm * tstepA : cA; const char* nB = has_next ? (const char*)g.Bt + (size_t)nxt.pn * tstepB : cB;
#pragma unroll 1
        for (int t = 0; t < nt; t += 2) {
            const bool last = (t == nt - 2);
            const char* a1 = cA + (size_t)(t + 1) * kstepA;
            const char* a2 = last ? nA : cA + (size_t)(t + 2) * kstepA; const char* b2 = last ? nB : cB + (size_t)(t + 2) * kstepB;
            const char* a3 = a2 + kstepA; const char* b3 = b2 + kstepB;
            if (last && has_next) S.a_ready(nxt);
            if constexpr (SP2) {
            PG8_LDB(B0, 0, 0); PG8_LDB(B1, 0, 1); PG8_SCHED; PG8_LDA(At, 0, 0); PG8_STAGE(PG8_SA(1, 1), a1 + hstepA, voffA);
            PG8_WAIT_V(8); PG8_WAIT_L(0); PG8_BAR; PG8_MMA(0, 0, At, B0); PG8_MMA(0, 1, At, B1); PG8_BAR; PG8_SCHED;
            PG8_LDA(At, 0, 1); PG8_STAGE(PG8_SB(0, 0), b2, voffB); PG8_STAGE(PG8_SB(0, 1), b2 + hstepB, voffB); PG8_STAGE(PG8_SA(0, 0), a2, voffA);
            PG8_WAIT_V(8); PG8_WAIT_L(0); PG8_BAR; PG8_MMA(1, 0, At, B0); PG8_MMA(1, 1, At, B1); PG8_BAR; PG8_SCHED;
            PG8_LDB(B0, 1, 0); PG8_LDB(B1, 1, 1); PG8_SCHED; PG8_LDA(At, 1, 0); PG8_STAGE(PG8_SA(0, 1), a2 + hstepA, voffA);
            PG8_WAIT_V(8); PG8_WAIT_L(0); PG8_BAR; PG8_MMA(0, 0, At, B0); PG8_MMA(0, 1, At, B1); PG8_BAR; PG8_SCHED;
            PG8_LDA(At, 1, 1); PG8_STAGE(PG8_SB(1, 0), b3, voffB); PG8_STAGE(PG8_SB(1, 1), b3 + hstepB, voffB); PG8_STAGE(PG8_SA(1, 0), a3, voffA);
            PG8_WAIT_V(8); PG8_WAIT_L(0); PG8_BAR; PG8_MMA(1, 0, At, B0); PG8_MMA(1, 1, At, B1); PG8_BAR; PG8_SCHED;
            } else {
            PG8_LDB(B0, 0, 0); PG8_SCHED; PG8_LDA(At, 0, 0); PG8_STAGE(PG8_SA(1, 1), a1 + hstepA, voffA);
            PG8_WAIT_L(8); PG8_BAR; PG8_WAIT_L(0); PG8_MMA(0, 0, At, B0); PG8_BAR; PG8_SCHED;
            PG8_LDB(B1, 0, 1); PG8_STAGE(PG8_SB(0, 0), b2, voffB);
            PG8_BAR; PG8_WAIT_L(0); PG8_MMA(0, 1, At, B1); PG8_BAR;
            PG8_LDA(At, 0, 1); PG8_STAGE(PG8_SA(0, 0), a2, voffA);
            PG8_BAR; PG8_WAIT_L(0); PG8_MMA(1, 0, At, B0); PG8_BAR; PG8_SCHED;
            PG8_STAGE(PG8_SB(0, 1), b2 + hstepB, voffB);
            PG8_WAIT_V(6); PG8_BAR; PG8_MMA(1, 1, At, B1); PG8_BAR;
            PG8_LDB(B0, 1, 0); PG8_SCHED; PG8_LDA(At, 1, 0); PG8_STAGE(PG8_SA(0, 1), a2 + hstepA, voffA);
            PG8_WAIT_L(8); PG8_BAR; PG8_WAIT_L(0); PG8_MMA(0, 0, At, B0); PG8_BAR; PG8_SCHED;
            PG8_LDB(B1, 1, 1); PG8_STAGE(PG8_SB(1, 0), b3, voffB);
            PG8_BAR; PG8_WAIT_L(0); PG8_MMA(0, 1, At, B1); PG8_BAR;
            PG8_LDA(At, 1, 1); PG8_STAGE(PG8_SA(1, 0), a3, voffA);
            PG8_BAR; PG8_WAIT_L(0); PG8_MMA(1, 0, At, B0); PG8_BAR; PG8_SCHED;
            PG8_STAGE(PG8_SB(1, 1), b3 + hstepB, voffB);
            PG8_WAIT_V(6); PG8_BAR; PG8_MMA(1, 1, At, B1); PG8_BAR;
            }
        }
        if constexpr (ALIGN_EPI) { if (wr == 0) PG8_BAR; }
        asm volatile("s_nop 15\n\ts_nop 7" ::: "memory");
        if constexpr (!Epi::AFTER_DRAIN) { E(acc, cur, wr, wc, fr, fq); S.done(cur); }
        if (!has_next) break;
#pragma unroll
        for (int a = 0; a < 2; ++a)
#pragma unroll
            for (int b = 0; b < 2; ++b)
#pragma unroll
                for (int m = 0; m < 4; ++m)
#pragma unroll
                    for (int n = 0; n < 2; ++n) acc[a][b][m][n] = acc_t{};
        cur = nxt; cA = nA; cB = nB; ++ui;
        if constexpr (ALIGN_EPI) { if (wr == 1) PG8_BAR; }
    }
    PG8_WAIT_V(0);
    if constexpr (!ALIGN_EPI) { if (wr == 0) PG8_BAR; }
    PG8_BAR;
#undef PG8_SA
#undef PG8_SB
#undef PG8_STAGE
#undef PG8_LDA
#undef PG8_LDB
#undef PG8_MMA
#undef PG8_WAIT_V
#undef PG8_WAIT_L
#undef PG8_BAR
#undef PG8_SCHED
}
}
#define PG8_SP2 true
#define PG8_ALIGN true

namespace att {
typedef unsigned short bf16;
constexpr int D = 128, NW = 8, QBLK = 32, KVBLK = 64, CTXN = 256;
constexpr float SCALE = 0.088388347648318440f;
constexpr float THR = 8.f;
constexpr int SDEPTH = 2;
constexpr long LDQ = 128, LDK = 128, LDV = 256, LDO = 8192;
constexpr size_t SHM_V = KVBLK * D * 2, SHM_K = KVBLK * D * 2, SHM_ATTN = 2 * SHM_V + 2 * SHM_K + NW * 64 * 4;
using bf16x8 = __attribute__((ext_vector_type(8))) short;
using s16x4  = __attribute__((ext_vector_type(4))) short;
using f32x16 = __attribute__((ext_vector_type(16))) float;
using u32x4  = __attribute__((ext_vector_type(4))) unsigned;
#define KSWZ(row, colB) ((row) * 256 + ((colB) ^ (((row) & 7) << 4)))
#define SBAR() __builtin_amdgcn_sched_barrier(0)
__device__ __forceinline__ int crow(int r, int hi) { return (r & 3) + 8 * (r >> 2) + 4 * hi; }
__device__ __forceinline__ unsigned cvtpk(float lo, float hi) { unsigned r; asm volatile("v_cvt_pk_bf16_f32 %0, %1, %2" : "=v"(r) : "v"(lo), "v"(hi)); return r; }

__device__ __forceinline__ void partialSM(f32x16& p0, f32x16& p1, float& m_reg, float& mn, float& alpha) {
  constexpr float C = SCALE * 1.4426950408889634f;
  float pmax = p0[0]; for (int r = 1; r < 16; ++r) pmax = fmaxf(pmax, p0[r]); for (int r = 0; r < 16; ++r) pmax = fmaxf(pmax, p1[r]);
  { auto rr = __builtin_amdgcn_permlane32_swap(__float_as_uint(pmax), __float_as_uint(pmax), false, false);
    pmax = fmaxf(__uint_as_float(rr[0]), __uint_as_float(rr[1])); }
  if (__builtin_expect(__all(pmax - m_reg <= THR / SCALE), 1)) { mn = m_reg; alpha = 1.f; }
  else { mn = fmaxf(m_reg, pmax); alpha = __builtin_amdgcn_exp2f((m_reg - mn) * C); m_reg = mn; }
  float mnC = -mn * C;
  for (int r = 0; r < 16; ++r) p0[r] = fmaf(p0[r], C, mnC); for (int r = 0; r < 16; ++r) p1[r] = fmaf(p1[r], C, mnC);
  for (int r = 0; r < 16; ++r) p0[r] = __builtin_amdgcn_exp2f(p0[r]);
}
__device__ __forceinline__ void finishSM(f32x16& p0, f32x16& p1, float alpha, float& l_reg, bf16x8& pa0, bf16x8& pa1, bf16x8& pa2, bf16x8& pa3) {
  for (int r = 0; r < 16; ++r) p1[r] = __builtin_amdgcn_exp2f(p1[r]);
  float ps = 0; for (int r = 0; r < 16; ++r) ps += p0[r]; for (int r = 0; r < 16; ++r) ps += p1[r];
  { auto rr = __builtin_amdgcn_permlane32_swap(__float_as_uint(ps), __float_as_uint(ps), false, false);
    ps = __uint_as_float(rr[0]) + __uint_as_float(rr[1]); }
  l_reg = l_reg * alpha + ps;
#define PK4(P, BASE, OUT) do { unsigned a0 = cvtpk(P[BASE + 0], P[BASE + 1]), a1 = cvtpk(P[BASE + 2], P[BASE + 3]);   \
    unsigned b0 = cvtpk(P[BASE + 4], P[BASE + 5]), b1 = cvtpk(P[BASE + 6], P[BASE + 7]);                              \
    auto r0 = __builtin_amdgcn_permlane32_swap(a0, b0, false, false); auto r1 = __builtin_amdgcn_permlane32_swap(a1, b1, false, false); \
    u32x4 w = {r0[0], r1[0], r0[1], r1[1]}; OUT = *reinterpret_cast<bf16x8*>(&w); } while (0)
  PK4(p0, 0, pa0); PK4(p0, 8, pa1); PK4(p1, 0, pa2); PK4(p1, 8, pa3);
#undef PK4
}
__device__ __forceinline__ void qkt(f32x16& p0, f32x16& p1, const bf16* Ks, const bf16x8* qr, int r32, int hi) {
  p0 = f32x16{}; p1 = f32x16{};
  for (int d0 = 0; d0 < 8; ++d0) { int cb = (d0 * 16 + hi * 8) * 2;
    bf16x8 b0 = *reinterpret_cast<const bf16x8*>((const char*)Ks + KSWZ(r32, cb));
    bf16x8 b1 = *reinterpret_cast<const bf16x8*>((const char*)Ks + KSWZ(32 + r32, cb));
    p0 = __builtin_amdgcn_mfma_f32_32x32x16_bf16(b0, qr[d0], p0, 0, 0, 0);
    p1 = __builtin_amdgcn_mfma_f32_32x32x16_bf16(b1, qr[d0], p1, 0, 0, 0); }
}
__device__ __forceinline__ int v_st(int k, int c) { const int kk = (k & ~0xC) | ((k & 4) << 1) | ((k & 8) >> 1); return ((kk >> 3) * 4 + (c >> 5)) * 512 + ((kk & 7) * 32 + (c & 31)) * 2; }
__device__ __forceinline__ int v_rd_base(int lane) { return ((lane & 3) << 3) | (((lane >> 2) & 3) << 6) | (((lane >> 4) & 1) << 5) | (((lane >> 5) & 1) << 8); }
constexpr int v_rd_off(int d0, int ks, int half) { return d0 * 512 + ks * 4096 + half * 2048; }
template <int OFF> __device__ __forceinline__ s16x4 tr_read(int vb) {
  s16x4 r; asm volatile("ds_read_b64_tr_b16 %0, %1 offset:%2" : "=&v"(r) : "v"(vb), "i"(OFF) : "memory"); return r;
}
template <int D0> __device__ __forceinline__ void pv_one(f32x16& od, int vb, bf16x8 pa0, bf16x8 pa1, bf16x8 pa2, bf16x8 pa3) {
  const s16x4 l0 = tr_read<v_rd_off(D0, 0, 0)>(vb), h0 = tr_read<v_rd_off(D0, 0, 1)>(vb), l1 = tr_read<v_rd_off(D0, 1, 0)>(vb), h1 = tr_read<v_rd_off(D0, 1, 1)>(vb);
  const s16x4 l2 = tr_read<v_rd_off(D0, 2, 0)>(vb), h2 = tr_read<v_rd_off(D0, 2, 1)>(vb), l3 = tr_read<v_rd_off(D0, 3, 0)>(vb), h3 = tr_read<v_rd_off(D0, 3, 1)>(vb);
  asm volatile("s_waitcnt lgkmcnt(0)" ::: "memory"); SBAR();
#define PK(L, H) (bf16x8){L[0], L[1], L[2], L[3], H[0], H[1], H[2], H[3]}
  od = __builtin_amdgcn_mfma_f32_32x32x16_bf16(pa0, PK(l0, h0), od, 0, 0, 0);
  od = __builtin_amdgcn_mfma_f32_32x32x16_bf16(pa1, PK(l1, h1), od, 0, 0, 0);
  od = __builtin_amdgcn_mfma_f32_32x32x16_bf16(pa2, PK(l2, h2), od, 0, 0, 0);
  od = __builtin_amdgcn_mfma_f32_32x32x16_bf16(pa3, PK(l3, h3), od, 0, 0, 0);
#undef PK
}
__device__ __forceinline__ void pv_d0(f32x16* o, int vb, bf16x8 pa0, bf16x8 pa1, bf16x8 pa2, bf16x8 pa3) {
  pv_one<0>(o[0], vb, pa0, pa1, pa2, pa3); pv_one<1>(o[1], vb, pa0, pa1, pa2, pa3); pv_one<2>(o[2], vb, pa0, pa1, pa2, pa3); pv_one<3>(o[3], vb, pa0, pa1, pa2, pa3);
}
__device__ __forceinline__ void attn_dense_body(const bf16* __restrict__ Qb, const bf16* __restrict__ Kc, const bf16* __restrict__ Kl, const bf16* __restrict__ Vc, const bf16* __restrict__ Vl,
                                                bf16* __restrict__ Ob, int seq, char* lds) {
  const int tid = threadIdx.x, wid = tid >> 6, lane = tid & 63, r32 = lane & 31, hi = lane >> 5;
  bf16* V_lds = (bf16*)lds; bf16* K_lds = (bf16*)(lds + 2 * SHM_V);
  float* ws = (float*)(lds + 2 * SHM_V + 2 * SHM_K) + wid * 64; float* li_l = ws; float* al_l = ws + 32;
  float m_reg = -1e30f, l_reg = 0; f32x16 o[4] = {}; bf16x8 qr[8];
  const bf16* Qw = Qb + (long)(wid * QBLK + r32) * LDQ + hi * 8;
#pragma unroll
  for (int d0 = 0; d0 < 8; ++d0) qr[d0] = *reinterpret_cast<const bf16x8*>(Qw + d0 * 16);
  const int sr = tid >> 4, sc = (tid & 15) * 8, vst0 = v_st(sr, sc), vst1 = v_st(32 + sr, sc);
  const int vb0 = (int)(uintptr_t)V_lds + v_rd_base(lane);
  struct { bf16x8 vs0, vs1, ks0, ks1; } sr_[SDEPTH];
#define SLOAD(i, k0) do { const bf16* kb_ = ((k0) < CTXN) ? Kc + (long)(k0) * LDK : Kl + (long)((k0) - CTXN) * LDK; const bf16* vb_ = ((k0) < CTXN) ? Vc + (long)(k0) * LDV : Vl + (long)((k0) - CTXN) * LDV; \
    sr_[i].vs0 = *reinterpret_cast<const bf16x8*>(&vb_[(long)sr * LDV + sc]); sr_[i].vs1 = *reinterpret_cast<const bf16x8*>(&vb_[(long)(32 + sr) * LDV + sc]); \
    sr_[i].ks0 = *reinterpret_cast<const bf16x8*>(&kb_[(long)sr * LDK + sc]); sr_[i].ks1 = *reinterpret_cast<const bf16x8*>(&kb_[(long)(32 + sr) * LDK + sc]); } while (0)
#define SWRITE(b, i) do { *(bf16x8*)((char*)V_lds + (b) * SHM_V + vst0) = sr_[i].vs0;          \
    *(bf16x8*)((char*)V_lds + (b) * SHM_V + vst1) = sr_[i].vs1; int kc = sc * 2;               \
    *(bf16x8*)((char*)K_lds + (b) * SHM_K + KSWZ(sr, kc)) = sr_[i].ks0;                       \
    *(bf16x8*)((char*)K_lds + (b) * SHM_K + KSWZ(32 + sr, kc)) = sr_[i].ks1; } while (0)
#define SWAIT() do { if constexpr (SDEPTH == 2) asm volatile("s_waitcnt vmcnt(4)" ::: "memory"); else asm volatile("s_waitcnt vmcnt(0)" ::: "memory"); } while (0)
#define RESC(a) do { if (__any((a) < 1.f)) { if (hi == 0) al_l[r32] = (a); asm volatile("s_waitcnt lgkmcnt(0)" ::: "memory"); \
    for (int d = 0; d < 4; ++d) for (int r = 0; r < 16; ++r) o[d][r] *= al_l[crow(r, hi)]; } } while (0)
  f32x16 pA0, pA1, pB0, pB1; float mnA, mnB, alA, alB; bf16x8 pa0, pa1, pa2, pa3; const int NT = seq / KVBLK;
  constexpr int SE = 0, SO = SDEPTH - 1;
  SLOAD(SE, 0); asm volatile("s_waitcnt vmcnt(0)" ::: "memory"); SWRITE(0, SE); __syncthreads();
  qkt(pA0, pA1, K_lds, qr, r32, hi); partialSM(pA0, pA1, m_reg, mnA, alA);
  SLOAD(SO, KVBLK); if constexpr (SDEPTH == 2) { if (2 < NT) SLOAD(SE, 2 * KVBLK); }
  SWAIT(); SWRITE(1, SO); __syncthreads();
  for (int j = 1; j + 1 < NT; j += 2) {
    SBAR(); qkt(pB0, pB1, (bf16*)((char*)K_lds + SHM_K), qr, r32, hi);
    finishSM(pA0, pA1, alA, l_reg, pa0, pa1, pa2, pa3); SBAR();
    SLOAD(SO, (j + SDEPTH) * KVBLK); SBAR();
    pv_d0(o, vb0, pa0, pa1, pa2, pa3); partialSM(pB0, pB1, m_reg, mnB, alB);
    __syncthreads(); SWAIT(); SWRITE(0, SE);
    RESC(alB); __syncthreads();
    SBAR(); qkt(pA0, pA1, K_lds, qr, r32, hi);
    finishSM(pB0, pB1, alB, l_reg, pa0, pa1, pa2, pa3); SBAR();
    if (SDEPTH == 1 || j + 3 < NT) SLOAD(SE, (j + 1 + SDEPTH) * KVBLK); SBAR();
    pv_d0(o, vb0 + (int)SHM_V, pa0, pa1, pa2, pa3); partialSM(pA0, pA1, m_reg, mnA, alA);
    __syncthreads(); SWAIT(); SWRITE(1, SO);
    RESC(alA); __syncthreads();
  }
  SBAR(); qkt(pB0, pB1, (bf16*)((char*)K_lds + SHM_K), qr, r32, hi);
  finishSM(pA0, pA1, alA, l_reg, pa0, pa1, pa2, pa3); SBAR();
  pv_d0(o, vb0, pa0, pa1, pa2, pa3); partialSM(pB0, pB1, m_reg, mnB, alB);
  __syncthreads(); RESC(alB);
  finishSM(pB0, pB1, alB, l_reg, pa0, pa1, pa2, pa3); SBAR();
  pv_d0(o, vb0 + (int)SHM_V, pa0, pa1, pa2, pa3);
  if (hi == 0) li_l[r32] = l_reg; asm volatile("s_waitcnt lgkmcnt(0)" ::: "memory");
  float rli[16];
#pragma unroll
  for (int r = 0; r < 16; ++r) rli[r] = __builtin_amdgcn_rcpf(li_l[crow(r, hi)]);
  bf16* Ow = Ob + (long)(wid * QBLK) * LDO;
#pragma unroll
  for (int r = 0; r < 16; ++r) { int orow = crow(r, hi);
    for (int d0 = 0; d0 < 4; ++d0) { const unsigned w = cvtpk(o[d0][r] * rli[r], 0.f); Ow[(long)orow * LDO + d0 * 32 + r32] = (bf16)(w & 0xffffu); } }
#undef SLOAD
#undef SWRITE
#undef SWAIT
#undef RESC
}
}


namespace att2 {
typedef unsigned short bf16;
using bf16x8 = __attribute__((ext_vector_type(8))) short;
using s16x4  = __attribute__((ext_vector_type(4))) short;
using f32x16 = __attribute__((ext_vector_type(16))) float;
using u32x4  = __attribute__((ext_vector_type(4))) unsigned;
typedef short v4i16_t __attribute__((ext_vector_type(4)));
typedef __attribute__((address_space(3))) const char* lds_cptr;
constexpr int KBUF = 16384, VBUF = 32768, LDS_K = 0, LDS_V = 2 * KBUF, RING = LDS_V + 3 * VBUF;
constexpr int CTXN = 256, LDO = 8192;
constexpr float SCALE = 0.088388347648318440f, THR = 8.f, C = SCALE * 1.4426950408889634f;
#define A2_WAIT_BAR(N) asm volatile("s_waitcnt vmcnt(" #N ") lgkmcnt(0)\n\ts_barrier" ::: "memory")
__device__ __forceinline__ void glds16(const void* gsrc, unsigned lds_dst) { unsigned keep;
  asm volatile("s_mov_b32 %0, m0\n\ts_mov_b32 m0, %2\n\ts_nop 0\n\tglobal_load_lds_dwordx4 %1, off\n\ts_mov_b32 m0, %0" : "=&s"(keep) : "v"(gsrc), "s"(lds_dst) : "memory"); }
__device__ __forceinline__ int crow(int r, int hi) { return (r & 3) + 8 * (r >> 2) + 4 * hi; }
__device__ __forceinline__ unsigned cvtpk(float lo, float hi) { unsigned r; asm volatile("v_cvt_pk_bf16_f32 %0, %1, %2" : "=v"(r) : "v"(lo), "v"(hi)); return r; }
__device__ __forceinline__ s16x4 vtr(lds_cptr p) { return __builtin_bit_cast(s16x4, __builtin_amdgcn_ds_read_tr16_b64_v4i16((__attribute__((address_space(3))) v4i16_t*)p)); }
__device__ __forceinline__ int v_rd_base(int lane) { return ((lane & 3) << 3) | (((lane >> 2) & 3) << 6) | (((lane >> 4) & 1) << 5) | (((lane >> 5) & 1) << 8); }

__device__ __forceinline__ void qkt(f32x16& p, lds_cptr kb, const bf16x8* qr, int krow, int hi) {
  p = f32x16{};
#pragma unroll
  for (int d0 = 0; d0 < 8; ++d0) { const int cb = d0 * 32 + hi * 16;
    const bf16x8 kf = *(const __attribute__((address_space(3))) bf16x8*)(kb + krow * 256 + (cb ^ ((krow & 7) << 4)));
    p = __builtin_amdgcn_mfma_f32_32x32x16_bf16(kf, qr[d0], p, 0, 0, 0); }
}
__device__ __forceinline__ void pv(f32x16* o, lds_cptr vp, bf16x8 pa0, bf16x8 pa1) {
#define A2_PK(L, H) (bf16x8){L[0], L[1], L[2], L[3], H[0], H[1], H[2], H[3]}
#pragma unroll
  for (int d0 = 0; d0 < 8; ++d0) {
    const s16x4 l0 = vtr(vp + d0 * 512), h0 = vtr(vp + d0 * 512 + 4096), l1 = vtr(vp + d0 * 512 + 8192), h1 = vtr(vp + d0 * 512 + 8192 + 4096);
    o[d0] = __builtin_amdgcn_mfma_f32_32x32x16_bf16(pa0, A2_PK(l0, h0), o[d0], 0, 0, 0);
    o[d0] = __builtin_amdgcn_mfma_f32_32x32x16_bf16(pa1, A2_PK(l1, h1), o[d0], 0, 0, 0); }
#undef A2_PK
}
__device__ __forceinline__ void softmax_step(f32x16& p, float& m_reg, float& l_reg, float& alpha, bf16x8& pa0, bf16x8& pa1) {
  float pmax = p[0];
#pragma unroll
  for (int r = 1; r < 16; ++r) pmax = fmaxf(pmax, p[r]);
  { auto rr = __builtin_amdgcn_permlane32_swap(__float_as_uint(pmax), __float_as_uint(pmax), false, false); pmax = fmaxf(__uint_as_float(rr[0]), __uint_as_float(rr[1])); }
  const bool keep = __all(pmax - m_reg <= THR / SCALE);
  const float mn = keep ? m_reg : fmaxf(m_reg, pmax);
  alpha = keep ? 1.f : __builtin_amdgcn_exp2f((m_reg - mn) * C);
  m_reg = mn;
  const float mnC = -mn * C;
#pragma unroll
  for (int r = 0; r < 16; ++r) p[r] = __builtin_amdgcn_exp2f(fmaf(p[r], C, mnC));
  float ps = 0.f;
#pragma unroll
  for (int r = 0; r < 16; ++r) ps += p[r];
  { auto rr = __builtin_amdgcn_permlane32_swap(__float_as_uint(ps), __float_as_uint(ps), false, false); ps = __uint_as_float(rr[0]) + __uint_as_float(rr[1]); }
  l_reg = l_reg * alpha + ps;
#define A2_PK4(P, BASE, OUT) do { unsigned a0 = cvtpk(P[BASE + 0], P[BASE + 1]), a1 = cvtpk(P[BASE + 2], P[BASE + 3]);   \
    unsigned b0 = cvtpk(P[BASE + 4], P[BASE + 5]), b1 = cvtpk(P[BASE + 6], P[BASE + 7]);                              \
    auto r0 = __builtin_amdgcn_permlane32_swap(a0, b0, false, false); auto r1 = __builtin_amdgcn_permlane32_swap(a1, b1, false, false); \
    u32x4 w = {r0[0], r1[0], r0[1], r1[1]}; OUT = __builtin_bit_cast(bf16x8, w); } while (0)
  A2_PK4(p, 0, pa0); A2_PK4(p, 8, pa1);
#undef A2_PK4
}

__device__ __forceinline__ void attn_unit(const bf16* __restrict__ Qb, const bf16* __restrict__ Kc, const bf16* __restrict__ Kl, const bf16* __restrict__ Vc, const bf16* __restrict__ Vl,
                                          bf16* __restrict__ Ob, int seq, char* shm, float* sml) {
  int tid = threadIdx.x; asm volatile("" : "+v"(tid));
  const int lane = tid & 63, r32 = lane & 31, hi = lane >> 5; const int wid = __builtin_amdgcn_readfirstlane(tid >> 6), rg = wid & 3, kh = wid >> 2;
  const unsigned lds0 = (unsigned)(uintptr_t)shm; const lds_cptr shm3 = (lds_cptr)shm;
  float* wsf = sml + wid * 128; float* wsp = sml + (wid ^ 4) * 128;
  unsigned koff[2], voff[4];
#pragma unroll
  for (int i = 0; i < 2; ++i) { const int q = wid * 2 + i, row = 4 * q + (lane >> 4); koff[i] = (unsigned)(row * 256 + (((lane & 15) << 4) ^ ((row & 7) << 4))); }
#pragma unroll
  for (int i = 0; i < 4; ++i) { const int q = wid * 4 + i, st = 2 * q + (lane >> 5), kk = (st >> 3) * 8 + ((lane & 31) >> 2), k = (kk & ~0xC) | ((kk & 4) << 1) | ((kk & 8) >> 1), c = (st & 7) * 32 + (lane & 3) * 8;
    voff[i] = (unsigned)(k * 512 + c * 2); }
  const unsigned kdst = lds0 + LDS_K + wid * 2048, vdst = lds0 + LDS_V + wid * 4096;
#define A2_DMA(t, kslot, vslot) do { const int k0_ = (t) * 64; \
    const char* kt_ = (k0_ < CTXN) ? (const char*)Kc + (size_t)k0_ * 256 : (const char*)Kl + (size_t)(k0_ - CTXN) * 256; \
    const char* vt_ = (k0_ < CTXN) ? (const char*)Vc + (size_t)k0_ * 512 : (const char*)Vl + (size_t)(k0_ - CTXN) * 512; \
    _Pragma("unroll") for (int i_ = 0; i_ < 2; ++i_) glds16(kt_ + koff[i_], (unsigned)__builtin_amdgcn_readfirstlane(kdst + i_ * 1024 + (kslot))); \
    _Pragma("unroll") for (int i_ = 0; i_ < 4; ++i_) glds16(vt_ + voff[i_], (unsigned)__builtin_amdgcn_readfirstlane(vdst + i_ * 1024 + (vslot))); } while (0)
  const int NT = seq / 64;
  bf16x8 qr[8];
  { const bf16* Qw = Qb + (size_t)(rg * 32 + r32) * 128 + hi * 8;
#pragma unroll
    for (int d0 = 0; d0 < 8; ++d0) qr[d0] = *reinterpret_cast<const bf16x8*>(Qw + d0 * 16); }
  if (kh) __builtin_amdgcn_s_setprio(1);
  { const char* k0p = (const char*)Kc; const char* v0p = (const char*)Vc;
#pragma unroll
    for (int i = 0; i < 2; ++i) glds16(k0p + koff[i], (unsigned)__builtin_amdgcn_readfirstlane(kdst + i * 1024));
#pragma unroll
    for (int i = 0; i < 2; ++i) glds16(k0p + 64 * 256 + koff[i], (unsigned)__builtin_amdgcn_readfirstlane(kdst + KBUF + i * 1024));
#pragma unroll
    for (int i = 0; i < 4; ++i) glds16(v0p + voff[i], (unsigned)__builtin_amdgcn_readfirstlane(vdst + i * 1024)); }
  const int krow = kh * 32 + r32, kx = (krow & 7) << 4;
  const lds_cptr kp0 = shm3 + LDS_K + krow * 256, vp0 = shm3 + LDS_V + v_rd_base(lane) + kh * 16384;
  float m_reg = -1e30f, l_reg = 0.f, alpha = 1.f; f32x16 o[8];
#pragma unroll
  for (int d = 0; d < 8; ++d) o[d] = f32x16{};
  f32x16 pA, pB; bf16x8 pa0, pa1;
#define A2_SB() __builtin_amdgcn_sched_barrier(0)
#define A2_PK(L, H) (bf16x8){L[0], L[1], L[2], L[3], H[0], H[1], H[2], H[3]}
#define A2_KLD(d0) (*(const __attribute__((address_space(3))) bf16x8*)(kb + ((((d0) * 32 + hi * 16)) ^ kx)))
#define A2_VLDA(S, d0) do { S##0 = vtr(vp + (d0) * 512); S##1 = vtr(vp + (d0) * 512 + 4096); } while (0)
#define A2_VLDB(S, d0) do { S##0 = vtr(vp + (d0) * 512 + 8192); S##1 = vtr(vp + (d0) * 512 + 12288); } while (0)
#define A2_PVA(d0, S) o[d0] = __builtin_amdgcn_mfma_f32_32x32x16_bf16(pa0, A2_PK(S##0, S##1), o[d0], 0, 0, 0)
#define A2_PVB(d0, S) o[d0] = __builtin_amdgcn_mfma_f32_32x32x16_bf16(pa1, A2_PK(S##0, S##1), o[d0], 0, 0, 0)
#define A2_MAX3(a, b, c) fmaxf(fmaxf((a), (b)), (c))
#define A2_E4(P, i) do { P[i] = __builtin_amdgcn_exp2f(fmaf(P[i], C, mnC)); P[(i) + 1] = __builtin_amdgcn_exp2f(fmaf(P[(i) + 1], C, mnC)); \
    P[(i) + 2] = __builtin_amdgcn_exp2f(fmaf(P[(i) + 2], C, mnC)); P[(i) + 3] = __builtin_amdgcn_exp2f(fmaf(P[(i) + 3], C, mnC)); } while (0)
#define A2_PACK(P, BASE, OUT) do { unsigned a0 = cvtpk(P[BASE + 0], P[BASE + 1]), a1 = cvtpk(P[BASE + 2], P[BASE + 3]);   \
    unsigned b0 = cvtpk(P[BASE + 4], P[BASE + 5]), b1 = cvtpk(P[BASE + 6], P[BASE + 7]);                              \
    auto r0 = __builtin_amdgcn_permlane32_swap(a0, b0, false, false); auto r1 = __builtin_amdgcn_permlane32_swap(a1, b1, false, false); \
    u32x4 w = {r0[0], r1[0], r0[1], r1[1]}; OUT = __builtin_bit_cast(bf16x8, w); } while (0)
#define A2_STEP(PC, PN, KRD, KST, VRD, VST, j) do { \
    A2_WAIT_BAR(0); \
    const int tk_ = ((j) + 2 < NT) ? (j) + 2 : NT - 1, tv_ = ((j) + 1 < NT) ? (j) + 1 : NT - 1; \
    const char* ktn = (tk_ * 64 < CTXN) ? (const char*)Kc + (size_t)(tk_ * 64) * 256 : (const char*)Kl + (size_t)(tk_ * 64 - CTXN) * 256; \
    const char* vtn = (tv_ * 64 < CTXN) ? (const char*)Vc + (size_t)(tv_ * 64) * 512 : (const char*)Vl + (size_t)(tv_ * 64 - CTXN) * 512; \
    const unsigned kdn = (unsigned)__builtin_amdgcn_readfirstlane(kdst + (KST)), vdn = (unsigned)__builtin_amdgcn_readfirstlane(vdst + (VST)); \
    const lds_cptr kb = kp0 + (KRD); const lds_cptr vp = vp0 + (VRD); \
    bf16x8 ka, kc; s16x4 va0, va1, vb0, vb1; \
    ka = A2_KLD(0); kc = A2_KLD(1); A2_SB(); \
    PN = __builtin_amdgcn_mfma_f32_32x32x16_bf16(ka, qr[0], f32x16{}, 0, 0, 0); ka = A2_KLD(2); glds16(ktn + koff[0], kdn); \
    const float x1_ = A2_MAX3(PC[0], PC[1], PC[2]), x2_ = A2_MAX3(PC[3], PC[4], PC[5]), x3_ = A2_MAX3(PC[6], PC[7], PC[8]), x4_ = A2_MAX3(PC[9], PC[10], PC[11]), x5_ = A2_MAX3(PC[12], PC[13], PC[14]); A2_SB(); \
    PN = __builtin_amdgcn_mfma_f32_32x32x16_bf16(kc, qr[1], PN, 0, 0, 0); kc = A2_KLD(3); glds16(ktn + koff[1], kdn + 1024); \
    float pmax = fmaxf(A2_MAX3(x1_, x2_, x3_), A2_MAX3(x4_, x5_, PC[15])); \
    { auto rr = __builtin_amdgcn_permlane32_swap(__float_as_uint(pmax), __float_as_uint(pmax), false, false); pmax = fmaxf(__uint_as_float(rr[0]), __uint_as_float(rr[1])); } A2_SB(); \
    PN = __builtin_amdgcn_mfma_f32_32x32x16_bf16(ka, qr[2], PN, 0, 0, 0); ka = A2_KLD(4); glds16(vtn + voff[0], vdn); \
    const float mn = (pmax - m_reg > THR / SCALE) ? fmaxf(m_reg, pmax) : m_reg; \
    alpha = __builtin_amdgcn_exp2f((m_reg - mn) * C); m_reg = mn; const float mnC = -mn * C; A2_SB(); \
    PN = __builtin_amdgcn_mfma_f32_32x32x16_bf16(kc, qr[3], PN, 0, 0, 0); kc = A2_KLD(5); glds16(vtn + voff[1], vdn + 1024); A2_E4(PC, 0); A2_SB(); \
    PN = __builtin_amdgcn_mfma_f32_32x32x16_bf16(ka, qr[4], PN, 0, 0, 0); ka = A2_KLD(6); glds16(vtn + voff[2], vdn + 2048); A2_E4(PC, 4); float sa = PC[0] + PC[1], sb = PC[2] + PC[3]; A2_SB(); \
    PN = __builtin_amdgcn_mfma_f32_32x32x16_bf16(kc, qr[5], PN, 0, 0, 0); kc = A2_KLD(7); glds16(vtn + voff[3], vdn + 3072); A2_E4(PC, 8); sa += PC[4]; sb += PC[5]; sa += PC[6]; sb += PC[7]; A2_SB(); \
    PN = __builtin_amdgcn_mfma_f32_32x32x16_bf16(ka, qr[6], PN, 0, 0, 0); A2_VLDA(va, 0); A2_E4(PC, 12); sa += PC[8]; sb += PC[9]; sa += PC[10]; sb += PC[11]; A2_SB(); \
    PN = __builtin_amdgcn_mfma_f32_32x32x16_bf16(kc, qr[7], PN, 0, 0, 0); A2_VLDA(vb, 1); sa += PC[12]; sb += PC[13]; sa += PC[14]; sb += PC[15]; float ps = sa + sb; \
    { auto rr = __builtin_amdgcn_permlane32_swap(__float_as_uint(ps), __float_as_uint(ps), false, false); ps = __uint_as_float(rr[0]) + __uint_as_float(rr[1]); } \
    l_reg = l_reg * alpha + ps; A2_PACK(PC, 0, pa0); A2_SB(); \
    if (__any(alpha < 1.f)) { if (hi == 0) wsf[r32] = alpha; asm volatile("s_waitcnt lgkmcnt(0)" ::: "memory"); \
      _Pragma("unroll") for (int r = 0; r < 16; ++r) { const float a_ = wsf[crow(r, hi)]; \
        _Pragma("unroll") for (int d = 0; d < 8; ++d) o[d][r] *= a_; } } \
    A2_PVA(0, va); A2_VLDA(va, 2); { unsigned a0 = cvtpk(PC[8], PC[9]), a1 = cvtpk(PC[10], PC[11]), b0 = cvtpk(PC[12], PC[13]), b1 = cvtpk(PC[14], PC[15]); \
      auto r0 = __builtin_amdgcn_permlane32_swap(a0, b0, false, false); auto r1 = __builtin_amdgcn_permlane32_swap(a1, b1, false, false); u32x4 w = {r0[0], r1[0], r0[1], r1[1]}; pa1 = __builtin_bit_cast(bf16x8, w); } A2_SB(); \
    A2_PVA(1, vb); A2_VLDA(vb, 3); A2_SB(); A2_PVA(2, va); A2_VLDA(va, 4); A2_SB(); A2_PVA(3, vb); A2_VLDA(vb, 5); A2_SB(); \
    A2_PVA(4, va); A2_VLDA(va, 6); A2_SB(); A2_PVA(5, vb); A2_VLDA(vb, 7); A2_SB(); A2_PVA(6, va); A2_VLDB(va, 0); A2_SB(); A2_PVA(7, vb); A2_VLDB(vb, 1); A2_SB(); \
    A2_PVB(0, va); A2_VLDB(va, 2); A2_SB(); A2_PVB(1, vb); A2_VLDB(vb, 3); A2_SB(); A2_PVB(2, va); A2_VLDB(va, 4); A2_SB(); A2_PVB(3, vb); A2_VLDB(vb, 5); A2_SB(); \
    A2_PVB(4, va); A2_VLDB(va, 6); A2_SB(); A2_PVB(5, vb); A2_VLDB(vb, 7); A2_SB(); A2_PVB(6, va); A2_SB(); A2_PVB(7, vb); A2_SB(); } while (0)
  A2_WAIT_BAR(0);
  qkt(pA, shm3 + LDS_K, qr, krow, hi);
  for (int j = 0; j < NT; j += 2) {
    A2_STEP(pA, pB, KBUF, 0, 0, VBUF, j);
    A2_STEP(pB, pA, 0, KBUF, VBUF, 0, j + 1);
  }
#undef A2_STEP
#undef A2_PACK
#undef A2_E4
#undef A2_MAX3
#undef A2_PVA
#undef A2_PVB
#undef A2_VLDA
#undef A2_VLDB
#undef A2_KLD
#undef A2_PK
#undef A2_SB
  if (hi == 0) { wsf[32 + r32] = m_reg; wsf[64 + r32] = l_reg; }
  A2_WAIT_BAR(0);
  { const float pm = wsp[32 + r32], pl = wsp[64 + r32], M = fmaxf(m_reg, pm);
    const float fs = __builtin_amdgcn_exp2f((m_reg - M) * C), fp = __builtin_amdgcn_exp2f((pm - M) * C);
    const float Ltot = l_reg * fs + pl * fp;
    if (hi == 0) wsf[r32] = fs * __builtin_amdgcn_rcpf(Ltot); }
  asm volatile("s_waitcnt lgkmcnt(0)" ::: "memory");
  float fr_[16];
#pragma unroll
  for (int r = 0; r < 16; ++r) fr_[r] = wsf[crow(r, hi)];
  int lane2 = lane; asm volatile("" : "+v"(lane2));
  const int r32b = lane2 & 31, hib = lane2 >> 5;
  float* xs = (float*)shm + wid * 4096 + lane2; const float* xr = (const float*)shm + (wid ^ 4) * 4096 + lane2;
  bf16* Ow = Ob + (size_t)(rg * 32) * LDO + r32b;
  if (kh == 0) {
#pragma unroll
    for (int d = 0; d < 4; ++d)
#pragma unroll
      for (int r = 0; r < 16; ++r) xs[(d * 16 + r) * 64] = o[4 + d][r] * fr_[r];
    A2_WAIT_BAR(0);
#pragma unroll
    for (int d = 0; d < 4; ++d)
#pragma unroll
      for (int r = 0; r < 16; ++r) { const float v = o[d][r] * fr_[r] + xr[(d * 16 + r) * 64]; Ow[(size_t)crow(r, hib) * LDO + d * 32] = (bf16)(cvtpk(v, 0.f) & 0xffffu); }
  } else {
#pragma unroll
    for (int d = 0; d < 4; ++d)
#pragma unroll
      for (int r = 0; r < 16; ++r) xs[(d * 16 + r) * 64] = o[d][r] * fr_[r];
    A2_WAIT_BAR(0);
#pragma unroll
    for (int d = 0; d < 4; ++d)
#pragma unroll
      for (int r = 0; r < 16; ++r) { const float v = o[4 + d][r] * fr_[r] + xr[(d * 16 + r) * 64]; Ow[(size_t)crow(r, hib) * LDO + 128 + d * 32] = (bf16)(cvtpk(v, 0.f) & 0xffffu); }
  }
  A2_WAIT_BAR(0);
  __builtin_amdgcn_s_setprio(0);
#undef A2_DMA
}

__device__ __forceinline__ void attn_unit256(const bf16* __restrict__ Qb, const bf16* __restrict__ Kc, const bf16* __restrict__ Kl, const bf16* __restrict__ Vc, const bf16* __restrict__ Vl,
                                             bf16* __restrict__ Ob, int seq, char* shm, float* sml) {
  int tid = threadIdx.x; asm volatile("" : "+v"(tid));
  const int lane = tid & 63, r32 = lane & 31, hi = lane >> 5; const int wid = __builtin_amdgcn_readfirstlane(tid >> 6);
  const unsigned lds0 = (unsigned)(uintptr_t)shm; const lds_cptr shm3 = (lds_cptr)shm;
  float* wsf = sml + wid * 128;
  unsigned koff[2], voff[4];
#pragma unroll
  for (int i = 0; i < 2; ++i) { const int q = wid * 2 + i, row = 4 * q + (lane >> 4); koff[i] = (unsigned)(row * 256 + (((lane & 15) << 4) ^ ((row & 7) << 4))); }
#pragma unroll
  for (int i = 0; i < 4; ++i) { const int q = wid * 4 + i, st = 2 * q + (lane >> 5), kk = (st >> 3) * 8 + ((lane & 31) >> 2), k = (kk & ~0xC) | ((kk & 4) << 1) | ((kk & 8) >> 1), c = (st & 7) * 32 + (lane & 3) * 8;
    voff[i] = (unsigned)(k * 512 + c * 2); }
  const unsigned kdst = lds0 + LDS_K + wid * 2048, vdst = lds0 + LDS_V + wid * 4096;
  const int NT = seq / 64;
  bf16x8 qr[8];
  { const bf16* Qw = Qb + (size_t)(wid * 32 + r32) * 128 + hi * 8;
#pragma unroll
    for (int d0 = 0; d0 < 8; ++d0) qr[d0] = *reinterpret_cast<const bf16x8*>(Qw + d0 * 16); }
  { const char* k0p = (const char*)Kc; const char* v0p = (const char*)Vc;
#pragma unroll
    for (int i = 0; i < 2; ++i) glds16(k0p + koff[i], (unsigned)__builtin_amdgcn_readfirstlane(kdst + i * 1024));
#pragma unroll
    for (int i = 0; i < 4; ++i) glds16(v0p + voff[i], (unsigned)__builtin_amdgcn_readfirstlane(vdst + i * 1024)); }
  const int kx = (r32 & 7) << 4;
  const lds_cptr kp0 = shm3 + LDS_K + r32 * 256, vp0 = shm3 + LDS_V + v_rd_base(lane);
  float m_reg = -1e30f, l_reg = 0.f, alpha = 1.f; f32x16 o[8];
#pragma unroll
  for (int d = 0; d < 8; ++d) o[d] = f32x16{};
  f32x16 p; bf16x8 pa0, pa1;
#define A5_SB() __builtin_amdgcn_sched_barrier(0)
#define A5_PK(L, H) (bf16x8){L[0], L[1], L[2], L[3], H[0], H[1], H[2], H[3]}
#define A5_KLD(d0) (*(const __attribute__((address_space(3))) bf16x8*)(kb + ((((d0) * 32 + hi * 16)) ^ kx)))
#define A5_VLDA(S, d0) do { S##0 = vtr(vp + (d0) * 512); S##1 = vtr(vp + (d0) * 512 + 4096); } while (0)
#define A5_VLDB(S, d0) do { S##0 = vtr(vp + (d0) * 512 + 8192); S##1 = vtr(vp + (d0) * 512 + 12288); } while (0)
#define A5_PVA(d0, S) o[d0] = __builtin_amdgcn_mfma_f32_32x32x16_bf16(pa0, A5_PK(S##0, S##1), o[d0], 0, 0, 0)
#define A5_PVB(d0, S) o[d0] = __builtin_amdgcn_mfma_f32_32x32x16_bf16(pa1, A5_PK(S##0, S##1), o[d0], 0, 0, 0)
#define A5_MAX3(a, b, c) fmaxf(fmaxf((a), (b)), (c))
#define A5_NOPIECE(i) do { } while (0)
#define A5_PIECE(i) do { if ((i) == 0) glds16(ktn + koff[0], kdn); else if ((i) == 1) glds16(ktn + koff[1], kdn + 1024); else glds16(vtn + voff[(i) - 2], vdn + ((i) - 2) * 1024); } while (0)
#define A5_HALF(KOFF, VOFF, PIECE) do { \
    const lds_cptr kb = kp0 + (KOFF); const lds_cptr vp = vp0 + (VOFF); \
    bf16x8 ka, kc; s16x4 va0, va1, vb0, vb1; \
    ka = A5_KLD(0); kc = A5_KLD(1); A5_SB(); \
    p = __builtin_amdgcn_mfma_f32_32x32x16_bf16(ka, qr[0], f32x16{}, 0, 0, 0); ka = A5_KLD(2); PIECE(0); A5_SB(); \
    p = __builtin_amdgcn_mfma_f32_32x32x16_bf16(kc, qr[1], p, 0, 0, 0); kc = A5_KLD(3); PIECE(1); A5_SB(); \
    p = __builtin_amdgcn_mfma_f32_32x32x16_bf16(ka, qr[2], p, 0, 0, 0); ka = A5_KLD(4); PIECE(2); A5_SB(); \
    p = __builtin_amdgcn_mfma_f32_32x32x16_bf16(kc, qr[3], p, 0, 0, 0); kc = A5_KLD(5); PIECE(3); A5_SB(); \
    p = __builtin_amdgcn_mfma_f32_32x32x16_bf16(ka, qr[4], p, 0, 0, 0); ka = A5_KLD(6); PIECE(4); A5_SB(); \
    p = __builtin_amdgcn_mfma_f32_32x32x16_bf16(kc, qr[5], p, 0, 0, 0); kc = A5_KLD(7); PIECE(5); A5_SB(); \
    p = __builtin_amdgcn_mfma_f32_32x32x16_bf16(ka, qr[6], p, 0, 0, 0); A5_VLDA(va, 0); A5_SB(); \
    p = __builtin_amdgcn_mfma_f32_32x32x16_bf16(kc, qr[7], p, 0, 0, 0); A5_VLDA(vb, 1); A5_SB(); \
    const float x1_ = A5_MAX3(p[0], p[1], p[2]), x2_ = A5_MAX3(p[3], p[4], p[5]), x3_ = A5_MAX3(p[6], p[7], p[8]), x4_ = A5_MAX3(p[9], p[10], p[11]), x5_ = A5_MAX3(p[12], p[13], p[14]); \
    float pmax = fmaxf(A5_MAX3(x1_, x2_, x3_), A5_MAX3(x4_, x5_, p[15])); \
    { auto rr = __builtin_amdgcn_permlane32_swap(__float_as_uint(pmax), __float_as_uint(pmax), false, false); pmax = fmaxf(__uint_as_float(rr[0]), __uint_as_float(rr[1])); } \
    const float mn = (pmax - m_reg > THR / SCALE) ? fmaxf(m_reg, pmax) : m_reg; \
    alpha = __builtin_amdgcn_exp2f((m_reg - mn) * C); m_reg = mn; const float mnC = -mn * C; \
    _Pragma("unroll") for (int r = 0; r < 16; ++r) p[r] = __builtin_amdgcn_exp2f(fmaf(p[r], C, mnC)); \
    float ps = ((p[0] + p[1]) + (p[2] + p[3])) + ((p[4] + p[5]) + (p[6] + p[7])); ps += ((p[8] + p[9]) + (p[10] + p[11])) + ((p[12] + p[13]) + (p[14] + p[15])); \
    { auto rr = __builtin_amdgcn_permlane32_swap(__float_as_uint(ps), __float_as_uint(ps), false, false); ps = __uint_as_float(rr[0]) + __uint_as_float(rr[1]); } \
    l_reg = l_reg * alpha + ps; \
    { unsigned a0 = cvtpk(p[0], p[1]), a1 = cvtpk(p[2], p[3]), b0 = cvtpk(p[4], p[5]), b1 = cvtpk(p[6], p[7]); \
      auto r0 = __builtin_amdgcn_permlane32_swap(a0, b0, false, false); auto r1 = __builtin_amdgcn_permlane32_swap(a1, b1, false, false); u32x4 w = {r0[0], r1[0], r0[1], r1[1]}; pa0 = __builtin_bit_cast(bf16x8, w); } \
    { unsigned a0 = cvtpk(p[8], p[9]), a1 = cvtpk(p[10], p[11]), b0 = cvtpk(p[12], p[13]), b1 = cvtpk(p[14], p[15]); \
      auto r0 = __builtin_amdgcn_permlane32_swap(a0, b0, false, false); auto r1 = __builtin_amdgcn_permlane32_swap(a1, b1, false, false); u32x4 w = {r0[0], r1[0], r0[1], r1[1]}; pa1 = __builtin_bit_cast(bf16x8, w); } \
    if (__any(alpha < 1.f)) { if (hi == 0) wsf[r32] = alpha; asm volatile("s_waitcnt lgkmcnt(0)" ::: "memory"); \
      _Pragma("unroll") for (int r = 0; r < 16; ++r) { const float a_ = wsf[crow(r, hi)]; \
        _Pragma("unroll") for (int d = 0; d < 8; ++d) o[d][r] *= a_; } } \
    A5_SB(); \
    A5_PVA(0, va); A5_VLDA(va, 2); A5_SB(); A5_PVA(1, vb); A5_VLDA(vb, 3); A5_SB(); A5_PVA(2, va); A5_VLDA(va, 4); A5_SB(); A5_PVA(3, vb); A5_VLDA(vb, 5); A5_SB(); \
    A5_PVA(4, va); A5_VLDA(va, 6); A5_SB(); A5_PVA(5, vb); A5_VLDA(vb, 7); A5_SB(); A5_PVA(6, va); A5_VLDB(va, 0); A5_SB(); A5_PVA(7, vb); A5_VLDB(vb, 1); A5_SB(); \
    A5_PVB(0, va); A5_VLDB(va, 2); A5_SB(); A5_PVB(1, vb); A5_VLDB(vb, 3); A5_SB(); A5_PVB(2, va); A5_VLDB(va, 4); A5_SB(); A5_PVB(3, vb); A5_VLDB(vb, 5); A5_SB(); \
    A5_PVB(4, va); A5_VLDB(va, 6); A5_SB(); A5_PVB(5, vb); A5_VLDB(vb, 7); A5_SB(); A5_PVB(6, va); A5_SB(); A5_PVB(7, vb); A5_SB(); } while (0)
#define A5_TILE(KS, VS, KSN, VSN, j) do { \
    A2_WAIT_BAR(0); \
    const int tn_ = ((j) + 1 < NT) ? (j) + 1 : NT - 1; \
    const char* ktn = (tn_ * 64 < CTXN) ? (const char*)Kc + (size_t)(tn_ * 64) * 256 : (const char*)Kl + (size_t)(tn_ * 64 - CTXN) * 256; \
    const char* vtn = (tn_ * 64 < CTXN) ? (const char*)Vc + (size_t)(tn_ * 64) * 512 : (const char*)Vl + (size_t)(tn_ * 64 - CTXN) * 512; \
    const unsigned kdn = (unsigned)__builtin_amdgcn_readfirstlane(kdst + (KSN)), vdn = (unsigned)__builtin_amdgcn_readfirstlane(vdst + (VSN)); \
    A5_HALF((KS), (VS), A5_PIECE); \
    A5_HALF((KS) + 8192, (VS) + 16384, A5_NOPIECE); } while (0)
  for (int j = 0; j < NT; j += 2) {
    A5_TILE(0, 0, KBUF, VBUF, j);
    A5_TILE(KBUF, VBUF, 0, 0, j + 1);
  }
#undef A5_TILE
#undef A5_HALF
#undef A5_PIECE
#undef A5_NOPIECE
#undef A5_MAX3
#undef A5_PVA
#undef A5_PVB
#undef A5_VLDA
#undef A5_VLDB
#undef A5_KLD
#undef A5_PK
#undef A5_SB
  if (hi == 0) wsf[32 + r32] = l_reg;
  asm volatile("s_waitcnt lgkmcnt(0)" ::: "memory");
  int lane2 = lane; asm volatile("" : "+v"(lane2));
  const int r32b = lane2 & 31, hib = lane2 >> 5;
  float rli[16];
#pragma unroll
  for (int r = 0; r < 16; ++r) rli[r] = __builtin_amdgcn_rcpf(wsf[32 + crow(r, hib)]);
  bf16* Ow = Ob + (size_t)(wid * 32) * LDO + r32b;
#pragma unroll
  for (int r = 0; r < 16; ++r)
#pragma unroll
    for (int d = 0; d < 8; ++d) Ow[(size_t)crow(r, hib) * LDO + d * 32] = (bf16)(cvtpk(o[d][r] * rli[r], 0.f) & 0xffffu);
  A2_WAIT_BAR(0);
}

using i32x4v = __attribute__((ext_vector_type(4))) int;
using i32x16 = __attribute__((ext_vector_type(16))) int;
using f32x4v = __attribute__((ext_vector_type(4))) float;
__device__ __forceinline__ unsigned q8p(float a, float b, float c, float d) {
  const int ia = (int)__builtin_rintf(a), ib = (int)__builtin_rintf(b), ic = (int)__builtin_rintf(c), id = (int)__builtin_rintf(d);
  return (unsigned)(ia & 255) | ((unsigned)(ib & 255) << 8) | ((unsigned)(ic & 255) << 16) | ((unsigned)id << 24); }
__device__ __forceinline__ float blo(unsigned w) { return __uint_as_float(w << 16); }
__device__ __forceinline__ float bhi(unsigned w) { return __uint_as_float(w & 0xffff0000u); }
__device__ __forceinline__ void attn_unit256q(const bf16* __restrict__ Qb, const unsigned char* __restrict__ Kc, const unsigned char* __restrict__ Kl, const float* __restrict__ Sc, const float* __restrict__ Sl,
                                              const bf16* __restrict__ Vc, const bf16* __restrict__ Vl, bf16* __restrict__ Ob, int seq, char* shm, float* sml) {
  int tid = threadIdx.x; asm volatile("" : "+v"(tid));
  const int lane = tid & 63, r32 = lane & 31, hi = lane >> 5; const int wid = __builtin_amdgcn_readfirstlane(tid >> 6);
  const unsigned lds0 = (unsigned)(uintptr_t)shm; const lds_cptr shm3 = (lds_cptr)shm;
  float* wsf = sml + wid * 128;
  unsigned koff, voff[4];
  { const int row = wid * 8 + (lane >> 3); koff = (unsigned)(row * 128 + (((lane & 7) ^ (row & 7)) << 4)); }
#pragma unroll
  for (int i = 0; i < 4; ++i) { const int q = wid * 4 + i, st = 2 * q + (lane >> 5), kk = (st >> 3) * 8 + ((lane & 31) >> 2), k = (kk & ~0xC) | ((kk & 4) << 1) | ((kk & 8) >> 1), c = (st & 7) * 32 + (lane & 3) * 8;
    voff[i] = (unsigned)(k * 512 + c * 2); }
  const unsigned kdst = lds0 + LDS_K + wid * 1024, vdst = lds0 + LDS_V + wid * 4096;
  const int NT = seq / 64;
  i32x4v qr[4]; float Cq, thrq;
  { const u32x4* Qw = (const u32x4*)(Qb + (size_t)(wid * 32 + r32) * 128 + hi * 16);
    u32x4 qa[4], qb[4];
#pragma unroll
    for (int d0 = 0; d0 < 4; ++d0) { qa[d0] = Qw[d0 * 4]; qb[d0] = Qw[d0 * 4 + 1]; }
    float mx = 0.f;
#define Q5_MX(w) mx = fmaxf(mx, fmaxf(__builtin_fabsf(blo(w)), __builtin_fabsf(bhi(w))))
#pragma unroll
    for (int d0 = 0; d0 < 4; ++d0) { Q5_MX(qa[d0].x); Q5_MX(qa[d0].y); Q5_MX(qa[d0].z); Q5_MX(qa[d0].w); Q5_MX(qb[d0].x); Q5_MX(qb[d0].y); Q5_MX(qb[d0].z); Q5_MX(qb[d0].w); }
#undef Q5_MX
    { auto rr = __builtin_amdgcn_permlane32_swap(__float_as_uint(mx), __float_as_uint(mx), false, false); mx = fmaxf(__uint_as_float(rr[0]), __uint_as_float(rr[1])); }
    const float inv = mx > 0.f ? 127.f / mx : 0.f, qs = mx * (1.f / 127.f);
    Cq = C * qs; thrq = mx > 0.f ? THR / (SCALE * qs) : 3.0e38f;
#define Q5_Q2(w0, w1) q8p(blo(w0) * inv, bhi(w0) * inv, blo(w1) * inv, bhi(w1) * inv)
#pragma unroll
    for (int d0 = 0; d0 < 4; ++d0) { qr[d0][0] = (int)Q5_Q2(qa[d0].x, qa[d0].y); qr[d0][1] = (int)Q5_Q2(qa[d0].z, qa[d0].w); qr[d0][2] = (int)Q5_Q2(qb[d0].x, qb[d0].y); qr[d0][3] = (int)Q5_Q2(qb[d0].z, qb[d0].w); }
#undef Q5_Q2
  }
  { glds16((const char*)Kc + koff, (unsigned)__builtin_amdgcn_readfirstlane(kdst));
#pragma unroll
    for (int i = 0; i < 4; ++i) glds16((const char*)Vc + voff[i], (unsigned)__builtin_amdgcn_readfirstlane(vdst + i * 1024)); }
  const int kx = (r32 & 7) << 4;
  const lds_cptr kp0 = shm3 + LDS_K + r32 * 128, vp0 = shm3 + LDS_V + v_rd_base(lane);
  float ksn0 = Sc[0], ksn1 = Sc[1];
  constexpr float BIAS = 12582912.f;
  i32x16 bini;
#pragma unroll
  for (int r = 0; r < 16; ++r) bini[r] = 0x4B400000;
  asm volatile("" : "+v"(bini));
  float m_reg = -1e30f, l_reg = 0.f, alpha = 1.f; f32x16 o[8];
#pragma unroll
  for (int d = 0; d < 8; ++d) o[d] = f32x16{};
  f32x16 p; i32x16 p8; bf16x8 pa0, pa1; float ks0, ks1;
#define A5_SB() __builtin_amdgcn_sched_barrier(0)
#define A5_PK(L, H) (bf16x8){L[0], L[1], L[2], L[3], H[0], H[1], H[2], H[3]}
#define A5_KLD(d0) (*(const __attribute__((address_space(3))) i32x4v*)(kb + ((((d0) * 32 + hi * 16)) ^ kx)))
#define A5_VLDA(S, d0) do { S##0 = vtr(vp + (d0) * 512); S##1 = vtr(vp + (d0) * 512 + 4096); } while (0)
#define A5_VLDB(S, d0) do { S##0 = vtr(vp + (d0) * 512 + 8192); S##1 = vtr(vp + (d0) * 512 + 12288); } while (0)
#define A5_PVA(d0, S) o[d0] = __builtin_amdgcn_mfma_f32_32x32x16_bf16(pa0, A5_PK(S##0, S##1), o[d0], 0, 0, 0)
#define A5_PVB(d0, S) o[d0] = __builtin_amdgcn_mfma_f32_32x32x16_bf16(pa1, A5_PK(S##0, S##1), o[d0], 0, 0, 0)
#define A5_MAX3(a, b, c) fmaxf(fmaxf((a), (b)), (c))
#define A5_NOPIECE(i) do { } while (0)
#define A5_PIECE(i) do { if ((i) == 0) glds16(ktn + koff, kdn); else if ((i) < 5) glds16(vtn + voff[(i) - 1], vdn + ((i) - 1) * 1024); } while (0)
#define A5_HALF(KOFF, KSB, VOFF, PIECE) do { \
    const lds_cptr kb = kp0 + (KOFF); const lds_cptr vp = vp0 + (VOFF); \
    i32x4v ka, kc; s16x4 va0, va1, vb0, vb1; \
    ka = A5_KLD(0); kc = A5_KLD(1); A5_SB(); \
    p8 = __builtin_amdgcn_mfma_i32_32x32x32_i8(ka, qr[0], bini, 0, 0, 0); ka = A5_KLD(2); PIECE(0); PIECE(1); A5_SB(); \
    p8 = __builtin_amdgcn_mfma_i32_32x32x32_i8(kc, qr[1], p8, 0, 0, 0); kc = A5_KLD(3); PIECE(2); PIECE(3); A5_SB(); \
    p8 = __builtin_amdgcn_mfma_i32_32x32x32_i8(ka, qr[2], p8, 0, 0, 0); PIECE(4); A5_VLDA(va, 0); A5_SB(); \
    p8 = __builtin_amdgcn_mfma_i32_32x32x32_i8(kc, qr[3], p8, 0, 0, 0); A5_VLDA(vb, 1); A5_SB(); \
    _Pragma("unroll") for (int r = 0; r < 16; ++r) p[r] = __int_as_float(p8[r]); \
    const float x1_ = A5_MAX3(p[0], p[1], p[2]), x2_ = A5_MAX3(p[3], p[4], p[5]), x3_ = A5_MAX3(p[6], p[7], p[8]), x4_ = A5_MAX3(p[9], p[10], p[11]), x5_ = A5_MAX3(p[12], p[13], p[14]); \
    float pmax = fmaxf(A5_MAX3(x1_, x2_, x3_), A5_MAX3(x4_, x5_, p[15])); \
    { auto rr = __builtin_amdgcn_permlane32_swap(__float_as_uint(pmax), __float_as_uint(pmax), false, false); pmax = fmaxf(__uint_as_float(rr[0]), __uint_as_float(rr[1])); } \
    pmax = (pmax - BIAS) * (KSB); \
    const float mn = (pmax - m_reg > thrq) ? fmaxf(m_reg, pmax) : m_reg; \
    alpha = __builtin_amdgcn_exp2f((m_reg - mn) * Cq); m_reg = mn; const float c1_ = (KSB) * Cq, mnC = -fmaf(BIAS, c1_, mn * Cq); \
    _Pragma("unroll") for (int r = 0; r < 16; ++r) p[r] = __builtin_amdgcn_exp2f(fmaf(p[r], c1_, mnC)); \
    float ps = ((p[0] + p[1]) + (p[2] + p[3])) + ((p[4] + p[5]) + (p[6] + p[7])); ps += ((p[8] + p[9]) + (p[10] + p[11])) + ((p[12] + p[13]) + (p[14] + p[15])); \
    { auto rr = __builtin_amdgcn_permlane32_swap(__float_as_uint(ps), __float_as_uint(ps), false, false); ps = __uint_as_float(rr[0]) + __uint_as_float(rr[1]); } \
    l_reg = l_reg * alpha + ps; \
    { unsigned a0 = cvtpk(p[0], p[1]), a1 = cvtpk(p[2], p[3]), b0 = cvtpk(p[4], p[5]), b1 = cvtpk(p[6], p[7]); \
      auto r0 = __builtin_amdgcn_permlane32_swap(a0, b0, false, false); auto r1 = __builtin_amdgcn_permlane32_swap(a1, b1, false, false); u32x4 w = {r0[0], r1[0], r0[1], r1[1]}; pa0 = __builtin_bit_cast(bf16x8, w); } \
    { unsigned a0 = cvtpk(p[8], p[9]), a1 = cvtpk(p[10], p[11]), b0 = cvtpk(p[12], p[13]), b1 = cvtpk(p[14], p[15]); \
      auto r0 = __builtin_amdgcn_permlane32_swap(a0, b0, false, false); auto r1 = __builtin_amdgcn_permlane32_swap(a1, b1, false, false); u32x4 w = {r0[0], r1[0], r0[1], r1[1]}; pa1 = __builtin_bit_cast(bf16x8, w); } \
    if (__any(alpha < 1.f)) { if (hi == 0) wsf[r32] = alpha; asm volatile("s_waitcnt lgkmcnt(0)" ::: "memory"); \
      _Pragma("unroll") for (int r = 0; r < 16; ++r) { const float a_ = wsf[crow(r, hi)]; \
        _Pragma("unroll") for (int d = 0; d < 8; ++d) o[d][r] *= a_; } } \
    A5_SB(); \
    A5_PVA(0, va); A5_VLDA(va, 2); A5_SB(); A5_PVA(1, vb); A5_VLDA(vb, 3); A5_SB(); A5_PVA(2, va); A5_VLDA(va, 4); A5_SB(); A5_PVA(3, vb); A5_VLDA(vb, 5); A5_SB(); \
    A5_PVA(4, va); A5_VLDA(va, 6); A5_SB(); A5_PVA(5, vb); A5_VLDA(vb, 7); A5_SB(); A5_PVA(6, va); A5_VLDB(va, 0); A5_SB(); A5_PVA(7, vb); A5_VLDB(vb, 1); A5_SB(); \
    A5_PVB(0, va); A5_VLDB(va, 2); A5_SB(); A5_PVB(1, vb); A5_VLDB(vb, 3); A5_SB(); A5_PVB(2, va); A5_VLDB(va, 4); A5_SB(); A5_PVB(3, vb); A5_VLDB(vb, 5); A5_SB(); \
    A5_PVB(4, va); A5_VLDB(va, 6); A5_SB(); A5_PVB(5, vb); A5_VLDB(vb, 7); A5_SB(); A5_PVB(6, va); A5_SB(); A5_PVB(7, vb); A5_SB(); } while (0)
#define A5_TILE(KS, VS, KSN, VSN, j) do { \
    A2_WAIT_BAR(0); \
    asm volatile("" : "+v"(ksn0), "+v"(ksn1)); ks0 = ksn0; ks1 = ksn1;        \
    const int tn_ = ((j) + 1 < NT) ? (j) + 1 : NT - 1; \
    const char* ktn = (tn_ * 64 < CTXN) ? (const char*)Kc + (size_t)(tn_ * 64) * 128 : (const char*)Kl + (size_t)(tn_ * 64 - CTXN) * 128; \
    { const float* stn = (tn_ * 64 < CTXN) ? Sc + tn_ * 2 : Sl + (tn_ * 2 - CTXN / 32); ksn0 = stn[0]; ksn1 = stn[1]; } \
    const char* vtn = (tn_ * 64 < CTXN) ? (const char*)Vc + (size_t)(tn_ * 64) * 512 : (const char*)Vl + (size_t)(tn_ * 64 - CTXN) * 512; \
    const unsigned kdn = (unsigned)__builtin_amdgcn_readfirstlane(kdst + (KSN)), vdn = (unsigned)__builtin_amdgcn_readfirstlane(vdst + (VSN)); \
    A5_HALF((KS), ks0, (VS), A5_PIECE); \
    A5_HALF((KS) + 4096, ks1, (VS) + 16384, A5_NOPIECE); } while (0)
  for (int j = 0; j < NT; j += 2) {
    A5_TILE(0, 0, KBUF, VBUF, j);
    A5_TILE(KBUF, VBUF, 0, 0, j + 1);
  }
#undef A5_TILE
#undef A5_HALF
#undef A5_PIECE
#undef A5_NOPIECE
#undef A5_MAX3
#undef A5_PVA
#undef A5_PVB
#undef A5_VLDA
#undef A5_VLDB
#undef A5_KLD
#undef A5_PK
#undef A5_SB
  if (hi == 0) wsf[32 + r32] = l_reg;
  asm volatile("s_waitcnt lgkmcnt(0)" ::: "memory");
  int lane2 = lane; asm volatile("" : "+v"(lane2));
  const int r32b = lane2 & 31, hib = lane2 >> 5;
  float rli[16];
#pragma unroll
  for (int r = 0; r < 16; ++r) rli[r] = __builtin_amdgcn_rcpf(wsf[32 + crow(r, hib)]);
  bf16* Ow = Ob + (size_t)(wid * 32) * LDO + r32b;
#pragma unroll
  for (int r = 0; r < 16; ++r)
#pragma unroll
    for (int d = 0; d < 8; ++d) Ow[(size_t)crow(r, hib) * LDO + d * 32] = (bf16)(cvtpk(o[d][r] * rli[r], 0.f) & 0xffffu);
  A2_WAIT_BAR(0);
}
}

#ifndef FORCE_LAM_ALL8
#define FORCE_LAM_ALL8 0.45f
#endif
constexpr int NWAVES = 8;
constexpr int G8T = 8;
constexpr int QB8 = 384 + 8 * G8T;
constexpr float LAM_ALL8 = FORCE_LAM_ALL8, LAM_SAFE = 0.55f;
constexpr int DM = 4096, NB = 4, SEQL = 4096, CTXL = 256;
constexpr int MLAT = NB * SEQL, MCTX = NB * CTXL, MTOT = MLAT + MCTX;
constexpr int NIN0 = 16384;
constexpr float EPS = 1e-6f;
constexpr int N_PHASES = 14;

constexpr size_t MiB = 1u << 20;
constexpr size_t WS_CTL = 0, CTL_ZERO_BYTES = 1 * MiB;
constexpr size_t WS_MOD = 1 * MiB;
constexpr size_t WS_ROPE = WS_MOD + 512 * 1024;
constexpr size_t WS_A16 = WS_ROPE + 64 * 1024;
constexpr size_t WS_RS = WS_A16 + 256 * 1024;
constexpr size_t WS_CS = WS_RS + 72 * 1024;
constexpr size_t WS_CS2 = WS_CS + 64 * 1024;
constexpr size_t WS_WIN0 = 2 * MiB;
constexpr size_t WS_WOUT0 = WS_WIN0 + 128 * MiB;
constexpr size_t WS_W5IN = WS_WOUT0 + 32 * MiB;
constexpr size_t WS_WGLU = WS_W5IN + 64 * MiB;
constexpr size_t WS_W5OUT = WS_WGLU + 32 * MiB;
constexpr size_t WS_E = WS_W5OUT + 32 * MiB;
constexpr size_t WS_W2 = WS_E + 32 * MiB;
constexpr size_t WS_H = WS_W2 + 64 * MiB;
constexpr size_t WS_P = WS_H + 136 * MiB;
constexpr size_t WS_OB = WS_P + 544 * MiB;
constexpr size_t WS_PARTM = WS_OB + 272 * MiB;
constexpr size_t WS_END = WS_PARTM + 8 * MiB;
constexpr size_t WS_QH = WS_P, WS_KH = WS_P + 136 * MiB, WS_VH = WS_P + 272 * MiB, WS_GT = WS_P + 408 * MiB;
constexpr size_t WS_AO = WS_H, WS_OUT0 = WS_P, WS_XS = WS_P, WS_SZ = WS_P + 320 * MiB, WS_HLOC = WS_OB, WS_YG = WS_H, WS_Y2 = WS_OB, WS_OUT1 = WS_P;
constexpr size_t CTL_COLMAX2 = 320 * 1024, CTL_TOKMAX = 384 * 1024;
constexpr size_t CTL_COLMAX = 256 * 1024;
constexpr int CW_TMO = 0, CW_BAR = 4096, CW_MODT = 16384;

constexpr int RING_OFF = 0, RING_BYTES = 131072;
constexpr int LDSCTL_OFF = RING_BYTES, MISC_OFF = LDSCTL_OFF + 320;
constexpr int LDS_BYTES = 147456;
constexpr int ATT_SML_OFF = RING_BYTES + 1024;

#define GAS __attribute__((address_space(1)))
#define LAS __attribute__((address_space(3)))
typedef unsigned short bf16;
typedef unsigned v4u __attribute__((ext_vector_type(4)));
typedef unsigned v2u __attribute__((ext_vector_type(2)));
typedef float f32x4 __attribute__((ext_vector_type(4)));
typedef float f32x2 __attribute__((ext_vector_type(2)));
typedef GAS unsigned gu32;
#define RLX_AGENT __ATOMIC_RELAXED, __HIP_MEMORY_SCOPE_AGENT
#define LDS_WAIT() asm volatile("s_waitcnt lgkmcnt(0)" ::: "memory")
__device__ __forceinline__ unsigned pk2(float lo, float hi) { return pg8::cvt_pk_bf16(lo, hi); }
__device__ __forceinline__ float wave_sum(float v) {
#pragma unroll
    for (int o = 1; o < 64; o <<= 1) v += __shfl_xor(v, o);
    return v;
}
__device__ __forceinline__ float half_sum(float v) {
#pragma unroll
    for (int o = 1; o < 32; o <<= 1) v += __shfl_xor(v, o);
    return v;
}

#define XB_TMO      128
#define XB_XCNT(j)  (256  + 64 * (j))
#define XB_XSUB(j)  (1280 + 64 * (j))
#define XB_XGEN(j)  (2304 + 64 * (j))
#define XB_TOP      3328
#define XB_TOPGEN   3392
#define XCD_BAR_WORDS 3456
#define XB_SPIN_CAP (1u << 18)
__device__ __forceinline__ unsigned xb_ld(unsigned* p)              { return __hip_atomic_load(p, __ATOMIC_RELAXED, __HIP_MEMORY_SCOPE_AGENT); }
__device__ __forceinline__ unsigned xb_add(unsigned* p, unsigned v) { return __hip_atomic_fetch_add(p, v, __ATOMIC_RELAXED, __HIP_MEMORY_SCOPE_AGENT); }
__device__ __forceinline__ unsigned xb_xcc_id() { return (unsigned)__builtin_amdgcn_s_getreg((3 << 11) | 20) & 0xFu; }
#define XB_SPIN(cond, bar) do { unsigned _sp = 0; while (cond) { __builtin_amdgcn_s_sleep(1); \
    if ((++_sp & 255u) == 0u) { if (xb_ld(&(bar)[XB_TMO])) break; if (_sp > XB_SPIN_CAP) { atomicAdd(&(bar)[XB_TMO], 1u); break; } } } } while (0)
struct XcdBarrier { unsigned* bar; unsigned x; volatile LAS unsigned* st; };
__device__ __forceinline__ XcdBarrier xcd_barrier_post(unsigned* bar, volatile LAS unsigned* st) {
    XcdBarrier b; b.bar = bar; b.x = xb_xcc_id(); b.st = st;
    if (threadIdx.x == 0) (void)xb_add(&bar[XB_XCNT(b.x)], 1u);
    return b;
}
__device__ __forceinline__ void xcd_barrier_complete(unsigned* bar, unsigned x, unsigned& nloc, unsigned& nx) {
    const unsigned G = gridDim.x * gridDim.y * gridDim.z;
    unsigned sum, cnt, mine, sp = 0u;
    for (;;) {
        sum = 0u; cnt = 0u; mine = 0u;
#pragma unroll
        for (unsigned j = 0; j < 16; ++j) { const unsigned c = xb_ld(&bar[XB_XCNT(j)]); sum += c; cnt += (c > 0u) ? 1u : 0u; mine = (j == x) ? c : mine; }
        if (sum == G) break;
        __builtin_amdgcn_s_sleep(1);
        if ((++sp & 255u) == 0u) { if (xb_ld(&bar[XB_TMO])) break; if (sp > XB_SPIN_CAP) { atomicAdd(&bar[XB_TMO], 1u); break; } }
    }
    nloc = mine > 0u ? mine : 1u; nx = cnt > 0u ? cnt : 1u;
}
__device__ __forceinline__ void xcd_barrier(const XcdBarrier& b) {
    asm volatile("s_waitcnt vmcnt(0)" ::: "memory");
    __syncthreads();
    if (threadIdx.x == 0) {
        unsigned* bar = b.bar;
        __builtin_amdgcn_s_waitcnt(0);
        unsigned nloc = b.st[0], nx = b.st[1];
        if (nloc == 0u) { xcd_barrier_complete(bar, b.x, nloc, nx); b.st[0] = nloc; b.st[1] = nx; }
        const unsigned old = xb_add(&bar[XB_XSUB(b.x)], 1u);
        const unsigned gen = old / nloc;
        if (old + 1u == (gen + 1u) * nloc) {
            __builtin_amdgcn_fence(__ATOMIC_RELEASE, "agent");
            asm volatile("s_waitcnt vmcnt(0)" ::: "memory");
            const unsigned og = xb_add(&bar[XB_TOP], 1u);
            const unsigned tg = og / nx;
            if (og + 1u == (tg + 1u) * nx) xb_add(&bar[XB_TOPGEN], 1u);
            else XB_SPIN(xb_ld(&bar[XB_TOPGEN]) == tg, bar);
            __builtin_amdgcn_fence(__ATOMIC_ACQUIRE, "agent");
            xb_add(&bar[XB_XGEN(b.x)], 1u);
            asm volatile("s_waitcnt vmcnt(0)" ::: "memory");
        } else {
            XB_SPIN(xb_ld(&bar[XB_XGEN(b.x)]) == gen, bar);
            __builtin_amdgcn_fence(__ATOMIC_ACQUIRE, "agent");
            asm volatile("s_waitcnt vmcnt(0)" ::: "memory");
        }
    }
    __syncthreads();
}

__device__ __forceinline__ void sincos_d(double x, double& s, double& c) {
    const double k = __builtin_rint(x * 0.15915494309189535);
    double r = __builtin_fma(-k, 6.283185307179586, x); r = __builtin_fma(-k, 2.4492935982947064e-16, r);
    const double q = r * 0.25, q2 = q * q;
    double sp = -7.647163731819816e-13;
    sp = sp * q2 + 1.6059043836821613e-10;
    sp = sp * q2 - 2.505210838544172e-08;
    sp = sp * q2 + 2.7557319223985893e-06;
    sp = sp * q2 - 1.984126984126984e-04;
    sp = sp * q2 + 8.333333333333333e-03;
    sp = sp * q2 - 1.6666666666666666e-01;
    double s1 = q + q * q2 * sp;
    double cp = 4.779477332387385e-14;
    cp = cp * q2 - 1.1470745597729725e-11;
    cp = cp * q2 + 2.08767569878681e-09;
    cp = cp * q2 - 2.755731922398589e-07;
    cp = cp * q2 + 2.48015873015873e-05;
    cp = cp * q2 - 1.388888888888889e-03;
    cp = cp * q2 + 4.1666666666666664e-02;
    cp = cp * q2 - 0.5;
    double c1 = 1.0 + q2 * cp;
    double s2 = 2.0 * s1 * c1, c2 = 1.0 - 2.0 * s1 * s1;
    s = 2.0 * s2 * c2; c = 1.0 - 2.0 * s2 * s2;
}
__device__ __forceinline__ double exp_d(double x) {
    const double k = __builtin_rint(x * 1.4426950408889634);
    const double r = __builtin_fma(-k, 0.6931471805599453, x) - k * 2.3190468138462996e-17;
    double p = 1.0 / 479001600.0;
    p = p * r + 1.0 / 39916800.0; p = p * r + 1.0 / 3628800.0; p = p * r + 1.0 / 362880.0; p = p * r + 1.0 / 40320.0; p = p * r + 1.0 / 5040.0;
    p = p * r + 1.0 / 720.0; p = p * r + 1.0 / 120.0; p = p * r + 1.0 / 24.0; p = p * r + 1.0 / 6.0; p = p * r + 0.5; p = p * r + 1.0; p = p * r + 1.0;
    const long long ki = (long long)k;
    const double sc = __builtin_bit_cast(double, (unsigned long long)((ki + 1023) << 52));
    return p * sc;
}

struct Args { const float* in[23]; float* out; unsigned char* ws; int ph_lo, ph_hi; };
enum { I_X = 0, I_C, I_CTX, I_CCTX, I_ADAW, I_ADAB, I_NPRE, I_NPOST, I_AWIN, I_AWOUT, I_ALAM, I_ASUB, I_SWIN, I_SARE, I_SAIM, I_SLDT, I_SBRE, I_SBIM, I_SCRE, I_SCIM, I_SD, I_SWGLU, I_SWOUT };

template <bool QKPERM>
__device__ __forceinline__ void transpose_item(const float* W, int K, int N, bf16* WT, LAS float* scr, int item, int lane, int row_sub = 0) {
    const int nblk = N / 32, kb = item / nblk, nb = item % nblk, k0 = 64 * kb, n0 = 32 * nb;
#pragma unroll 8
    for (int i = 0; i < 32; ++i) { const int kk = 2 * i + (lane >> 5); scr[kk * 33 + (lane & 31)] = __builtin_nontemporal_load(W + (size_t)(k0 + kk) * N + n0 + (lane & 31)); }
    LDS_WAIT(); asm volatile("" ::: "memory");
    const int c = lane & 7;
#pragma unroll
    for (int j = 0; j < 4; ++j) { const int n = (lane >> 3) + 8 * j; const LAS float* s = scr + (8 * c) * 33 + n;
        v4u o; o.x = pk2(s[0 * 33], s[1 * 33]); o.y = pk2(s[2 * 33], s[3 * 33]); o.z = pk2(s[4 * 33], s[5 * 33]); o.w = pk2(s[6 * 33], s[7 * 33]);
        int nn = n0 + n;
        if (QKPERM && nn < 8192) { const int d = nn & 127, a = d >> 6, jj = (d >> 5) & 1, f = d & 31; nn = (nn & ~127) + 2 * (a * 32 + f) + jj; }
        *(GAS v4u*)(WT + pg8::blk_off(nn - row_sub, k0 + 8 * c)) = o; }
    LDS_WAIT(); asm volatile("" ::: "memory");
}

#define GEMV_ITEM(item) do { \
                const int layer = item / 384, rem = item % 384, ks = rem / 24, cs = rem % 24, k0 = ks * 256, n0 = cs * 512; \
                for (int e = tid; e < 1280; e += NWAVES * 64) { const int r = e >> 8, kk = e & 255; const float v = (r < 4) ? cvec[r * 4096 + k0 + kk] : cctx[k0 + kk]; sv[e] = v * pg8::sigmoidf_fast(v); } \
                __syncthreads(); \
                const int cg = tid & 127, sub = tid >> 7; \
                const float* wp = args.in[I_ADAW] + ((size_t)layer * 4096 + k0 + sub * 64) * 12288 + n0 + cg * 4; \
                f32x4 acc[5]; \
_Pragma("unroll") \
                for (int r = 0; r < 5; ++r) acc[r] = (f32x4){0.f, 0.f, 0.f, 0.f}; \
                for (int i = 0; i < 64; i += 8) { \
                    f32x4 w[8]; \
_Pragma("unroll") \
                    for (int q = 0; q < 8; ++q) w[q] = __builtin_nontemporal_load((const GAS f32x4*)(wp + (size_t)(i + q) * 12288)); \
_Pragma("unroll") \
                    for (int q = 0; q < 8; ++q) \
_Pragma("unroll") \
                        for (int r = 0; r < 5; ++r) acc[r] += w[q] * sv[r * 256 + sub * 64 + i + q]; \
                } \
_Pragma("unroll") \
                for (int r = 0; r < 5; ++r) red[(sub * 128 + cg) * 5 + r] = acc[r]; \
                __syncthreads(); \
                float* part = PARTM + ((size_t)((layer * 24 + cs) * 16 + ks)) * 2560; \
                for (int e = tid; e < 640; e += NWAVES * 64) { const int cg2 = e / 5, r = e % 5; \
                    const f32x4 sm = red[(0 * 128 + cg2) * 5 + r] + red[(1 * 128 + cg2) * 5 + r] + red[(2 * 128 + cg2) * 5 + r] + red[(3 * 128 + cg2) * 5 + r]; \
                    float* pp = part + r * 512 + cg2 * 4; \
                    __hip_atomic_store(pp + 0, sm.x, __ATOMIC_RELAXED, __HIP_MEMORY_SCOPE_AGENT); __hip_atomic_store(pp + 1, sm.y, __ATOMIC_RELAXED, __HIP_MEMORY_SCOPE_AGENT); \
                    __hip_atomic_store(pp + 2, sm.z, __ATOMIC_RELAXED, __HIP_MEMORY_SCOPE_AGENT); __hip_atomic_store(pp + 3, sm.w, __ATOMIC_RELAXED, __HIP_MEMORY_SCOPE_AGENT); } \
                asm volatile("s_waitcnt vmcnt(0)" ::: "memory"); \
                __syncthreads(); \
                if (tid == 0) MISC[16] = __hip_atomic_fetch_add((unsigned*)(ctl + CW_MODT + 64 * (layer * 24 + cs)), 1u, __ATOMIC_RELAXED, __HIP_MEMORY_SCOPE_AGENT); \
                __syncthreads(); \
                if (MISC[16] == 15u) { \
                    __builtin_amdgcn_fence(__ATOMIC_ACQUIRE, "agent"); \
                    const float* pb = PARTM + ((size_t)((layer * 24 + cs) * 16)) * 2560; \
                    for (int e = tid; e < 2560; e += NWAVES * 64) { const int r = e >> 9, cn = e & 511; float sm = args.in[I_ADAB][layer * 12288 + n0 + cn]; \
_Pragma("unroll") \
                        for (int k = 0; k < 16; ++k) sm += __hip_atomic_load(pb + (size_t)k * 2560 + e, __ATOMIC_RELAXED, __HIP_MEMORY_SCOPE_AGENT); \
                        MOD[((size_t)layer * 5 + r) * 12288 + n0 + cn] = sm; } \
                } \
                __syncthreads(); \
            } while (0)

__device__ __forceinline__ float wave_max(float v) {
#pragma unroll
    for (int o = 1; o < 64; o <<= 1) v = fmaxf(v, __shfl_xor(v, o));
    return v;
}
__device__ __forceinline__ int qkperm_col(int nn) { if (nn < 8192) { const int d = nn & 127, a = d >> 6, jj = (d >> 5) & 1, f = d & 31; nn = (nn & ~127) + 2 * (a * 32 + f) + jj; } return nn; }
template <bool PERM>
__device__ __forceinline__ void colmax_item(const float* W, int N, unsigned* colmax, int item, int lane) {
    const int nblk = N / 32, kb = item / nblk, nb = item % nblk, k0 = 64 * kb, n0 = 32 * nb; float m = 0.f;
#pragma unroll 8
    for (int i = 0; i < 32; ++i) m = fmaxf(m, __builtin_fabsf(__builtin_nontemporal_load(W + (size_t)(k0 + 2 * i + (lane >> 5)) * N + n0 + (lane & 31))));
    m = fmaxf(m, __shfl_xor(m, 32));
    if (lane < 32) (void)__hip_atomic_fetch_max(colmax + (PERM ? qkperm_col(n0 + lane) : n0 + lane), __float_as_uint(m), __ATOMIC_RELAXED, __HIP_MEMORY_SCOPE_AGENT);
}
__device__ __forceinline__ unsigned q8pack(float a, float b, float c, float d) {
    const int ia = (int)__builtin_rintf(a), ib = (int)__builtin_rintf(b), ic = (int)__builtin_rintf(c), id = (int)__builtin_rintf(d);
    return (unsigned)(ia & 255) | ((unsigned)(ib & 255) << 8) | ((unsigned)(ic & 255) << 16) | ((unsigned)id << 24);
}
template <bool PERM>
__device__ __forceinline__ void quant_item(const float* W, int N, const unsigned* colmax, unsigned char* WQ, float* CS, LAS float* scr, int item, int lane) {
    const int nblk = N / 32, kb = item / nblk, nb = item % nblk, k0 = 64 * kb, n0 = 32 * nb;
#pragma unroll 8
    for (int i = 0; i < 32; ++i) { const int kk = 2 * i + (lane >> 5); scr[kk * 33 + (lane & 31)] = __builtin_nontemporal_load(W + (size_t)(k0 + kk) * N + n0 + (lane & 31)); }
    LDS_WAIT(); asm volatile("" ::: "memory");
    const int c = lane & 7;
#pragma unroll
    for (int j = 0; j < 4; ++j) { const int n = (lane >> 3) + 8 * j, nn = PERM ? qkperm_col(n0 + n) : n0 + n; const LAS float* sp = scr + (8 * c) * 33 + n;
        const float cm = __uint_as_float(colmax[nn]), inv = cm > 0.f ? 127.f / cm : 0.f;
        v2u o; o.x = q8pack(sp[0 * 33] * inv, sp[1 * 33] * inv, sp[2 * 33] * inv, sp[3 * 33] * inv); o.y = q8pack(sp[4 * 33] * inv, sp[5 * 33] * inv, sp[6 * 33] * inv, sp[7 * 33] * inv);
        *(GAS v2u*)(WQ + pg8::blk8_off(nn, k0 + 8 * c)) = o;
        if (kb == 0 && c == 0) CS[nn] = cm * (1.f / 127.f); }
    LDS_WAIT(); asm volatile("" ::: "memory");
}

__global__ void __launch_bounds__(NWAVES * 64, 2) fwd_kernel(Args args) {
    extern __shared__ __attribute__((aligned(16))) unsigned char lds[];
    LAS unsigned char* L = (LAS unsigned char*)lds;
    volatile LAS unsigned* MISC = (volatile LAS unsigned*)(L + MISC_OFF);
    const int tid = threadIdx.x, lane = tid & 63, wave = __builtin_amdgcn_readfirstlane(tid >> 6);
    const int G = gridDim.x; const int bx = blockIdx.x; const int vcu = (G % 8 == 0) ? (bx % 8) * (G / 8) + bx / 8 : bx;
    const int gw = vcu * NWAVES + wave, NGW = G * NWAVES;
    unsigned char* ws = args.ws;
    gu32* ctl = (gu32*)(ws + WS_CTL);
    for (int u = tid; u < (LDS_BYTES - LDSCTL_OFF) / 4; u += NWAVES * 64) ((LAS unsigned*)(L + LDSCTL_OFF))[u] = 0u;
    __syncthreads();
    XcdBarrier bar; bar.bar = (unsigned*)(ctl + CW_BAR); bar.x = 0; bar.st = nullptr;
    if (!MK_PER_PHASE) bar = xcd_barrier_post((unsigned*)(ctl + CW_BAR), MISC + 8);
    const int lo = args.ph_lo, hi = args.ph_hi;
#define IN(k) (lo <= (k) && (k) < hi)
#define SEAM(k) do { if (IN(k) && IN((k) + 1)) xcd_barrier(bar); } while (0)

    int n8;
    { const float* lv_ = args.in[I_ALAM];
      const float d01_ = wave_sum(lv_[lane] * lv_[128 + lane] + lv_[64 + lane] * lv_[192 + lane]), d23_ = wave_sum(lv_[256 + lane] * lv_[384 + lane] + lv_[320 + lane] * lv_[448 + lane]);
      const float lam_ = __expf(d01_) - __expf(d23_) + 0.2f; n8 = __builtin_amdgcn_readfirstlane((lam_ <= LAM_ALL8) ? 64 : (lam_ <= LAM_SAFE) ? 48 + G8T : 32); }
    const int qb8 = n8 * 8; const bool need_hb = (n8 != 64);
    const float* x = args.in[I_X]; const float* cvec = args.in[I_C]; const float* ctx = args.in[I_CTX]; const float* cctx = args.in[I_CCTX];
    float* RS = (float*)(ws + WS_RS); float* CS = (float*)(ws + WS_CS); unsigned* COLMAX = (unsigned*)(ws + WS_CTL + CTL_COLMAX);
    unsigned char* HQ = ws + WS_OB; unsigned char* WQ8 = ws + WS_WIN0; bf16* WG0 = (bf16*)(ws + WS_WIN0 + 64 * MiB);
    float* CS2 = (float*)(ws + WS_CS2); unsigned* COLMAX2 = (unsigned*)(ws + WS_CTL + CTL_COLMAX2); unsigned* TOKMAX = (unsigned*)(ws + WS_CTL + CTL_TOKMAX);
    unsigned char* WGLU8 = ws + WS_WGLU; unsigned char* A8 = ws + WS_P;
    unsigned char* K8 = ws + WS_H; float* KSC = (float*)(ws + WS_H + 72 * MiB);
    bf16* X1B = (bf16*)(ws + WS_WIN0);
    float* MOD = (float*)(ws + WS_MOD); float* PARTM = (float*)(ws + WS_PARTM); float* ROPE = (float*)(ws + WS_ROPE); float* A16 = (float*)(ws + WS_A16);
    bf16* Win0 = (bf16*)(ws + WS_WIN0); bf16* Wout0 = (bf16*)(ws + WS_WOUT0); bf16* W5in = (bf16*)(ws + WS_W5IN); bf16* Wglu = (bf16*)(ws + WS_WGLU); bf16* W5out = (bf16*)(ws + WS_W5OUT);
    bf16* Etab = (bf16*)(ws + WS_E); bf16* W2tab = (bf16*)(ws + WS_W2);
    bf16* Hb = (bf16*)(ws + WS_H); bf16* OB = (bf16*)(ws + WS_OB); bf16* QH = (bf16*)(ws + WS_QH); bf16* KH = (bf16*)(ws + WS_KH); bf16* VH = (bf16*)(ws + WS_VH); bf16* GT = (bf16*)(ws + WS_GT);
    bf16* AO = (bf16*)(ws + WS_AO); bf16* OUT0 = (bf16*)(ws + WS_OUT0); bf16* XS = (bf16*)(ws + WS_XS); bf16* SZ = (bf16*)(ws + WS_SZ);
    bf16* HLOC = (bf16*)(ws + WS_HLOC); bf16* YG = (bf16*)(ws + WS_YG); bf16* Y2 = (bf16*)(ws + WS_Y2); bf16* OUT1 = (bf16*)(ws + WS_OUT1);

    if (IN(0)) {
        {
            LAS float* sv = (LAS float*)L;
            LAS f32x4* red = (LAS f32x4*)(L + 8192);
            for (int item = vcu; item < 384; item += G) GEMV_ITEM(item);
        }
        __syncthreads();
        if (vcu == 0) for (int e = tid; e < 2048; e += 512) { const int pos = e >> 5, f = e & 31; const double invf = exp_d(-(double)f * (9.210340371976184 / 32.0)); double sn, cs; sincos_d((double)pos * invf, sn, cs);
            *(GAS f32x2*)(ROPE + e * 2) = (f32x2){(float)cs, (float)sn}; }
        __syncthreads();
        {
            LAS float* scr = (LAS float*)(L + RING_OFF + wave * 16384);
            constexpr int I_0 = 64 * 512, I_1 = 0, I_2 = 0, I_3 = 0, I_4 = 0;
            constexpr int NITEMS = I_0 + I_1 + I_2 + I_3 + I_4;
            for (int it = gw; it < NITEMS; it += NGW) {
                int r = it;
                if (r < I_0) { if ((r % 512) < qb8) colmax_item<true>(args.in[I_AWIN], 16384, COLMAX, r, lane);
                               else transpose_item<false>(args.in[I_AWIN], 4096, 16384, WG0, scr, r, lane, 8192);
                               continue; } r -= I_0;
                if (r < I_1) { transpose_item<false>(args.in[I_AWOUT], 4096, 4096, Wout0, scr, r, lane); continue; } r -= I_1;
                if (r < I_2) { transpose_item<false>(args.in[I_SWIN], 4096, 8192, W5in, scr, r, lane); continue; } r -= I_2;
                if (r < I_3) { colmax_item<false>(args.in[I_SWGLU], 4096, COLMAX2, r, lane); continue; } r -= I_3;
                (void)r;
            }
        }
        __syncthreads();
        __syncthreads();
    }
    SEAM(0);

    if (IN(1)) {
        const float* npre = args.in[I_NPRE];
        const int wgb = G >> 2, bq = (wgb > 0) ? vcu / wgb : 4, wl = (wgb > 0) ? vcu % wgb : 0;
        LAS f32x4* Va = (LAS f32x4*)L; LAS f32x4* Vs = Va + 1024;
#define P1_LOADVEC(mb) do { const float* shift_ = MOD + (size_t)(mb) * 12288; const float* scale_ = shift_ + 4096; \
            for (int q = tid; q < 1024; q += NWAVES * 64) { Va[q] = ((const GAS f32x4*)npre)[q] * (((const GAS f32x4*)scale_)[q] + 1.f); Vs[q] = ((const GAS f32x4*)shift_)[q]; } } while (0)
#define P1_ROW(row, xr) do { \
            unsigned vbase = (unsigned)lane * 16u; asm volatile("" : "+v"(vbase)); \
            const LAS f32x4* Va_ = (const LAS f32x4*)(L + vbase); const LAS f32x4* Vs_ = Va_ + 1024; \
            f32x4 v[16]; float ss = 0.f; \
            _Pragma("unroll") for (int j = 0; j < 16; ++j) { v[j] = __builtin_nontemporal_load((const GAS f32x4*)(xr) + lane + 64 * j); ss += (v[j].x * v[j].x + v[j].y * v[j].y) + (v[j].z * v[j].z + v[j].w * v[j].w); } \
            const float rstd = __builtin_amdgcn_rsqf(wave_sum(ss) * (1.f / DM) + EPS); float mx = 0.f; \
            _Pragma("unroll") for (int j = 0; j < 16; ++j) { v[j] = v[j] * rstd * Va_[64 * j] + Vs_[64 * j]; \
                mx = fmaxf(fmaxf(mx, fmaxf(__builtin_fabsf(v[j].x), __builtin_fabsf(v[j].y))), fmaxf(__builtin_fabsf(v[j].z), __builtin_fabsf(v[j].w))); if ((j & 3) == 3) __builtin_amdgcn_sched_barrier(0); } \
            mx = wave_max(mx); const float inv = mx > 0.f ? 127.f / mx : 0.f; if (lane == 0) RS[(row)] = mx * (1.f / 127.f); \
            _Pragma("unroll") for (int j = 0; j < 16; ++j) { if (need_hb) *(GAS v2u*)(Hb + pg8::blk_off((row), 4 * (lane + 64 * j))) = (v2u){pk2(v[j].x, v[j].y), pk2(v[j].z, v[j].w)};        \
                *(GAS unsigned*)(HQ + pg8::blk8_off((row), 4 * (lane + 64 * j))) = q8pack(v[j].x * inv, v[j].y * inv, v[j].z * inv, v[j].w * inv); } } while (0)
        if (bq < 4) P1_LOADVEC(bq);
        __syncthreads();
        if (bq < 4) for (int r = wl * NWAVES + wave; r < SEQL; r += wgb * NWAVES) { const int row = bq * SEQL + r; P1_ROW(row, x + (size_t)row * DM); }
        __syncthreads();
        P1_LOADVEC(4);
        __syncthreads();
        for (int row = MLAT + gw; row < MTOT; row += NGW) P1_ROW(row, ctx + (size_t)(row - MLAT) * DM);
        __syncthreads();
        { LAS float* scr = (LAS float*)(L + RING_OFF + wave * 16384);
          for (int it = gw; it < 64 * 512; it += NGW) if ((it % 512) < qb8) quant_item<true>(args.in[I_AWIN], 16384, COLMAX, WQ8, CS, scr, it, lane);
        }
        __syncthreads();
#undef P1_ROW
#undef P1_LOADVEC
    }
    SEAM(1);

    if (IN(2)) {
        { pg8::Gemm g{(const pg8::bf16_t*)HQ, (const pg8::bf16_t*)WQ8, 2048, 128u, 32u, 32768u, 1048576u, 128u, 32768u, 1048576u}; pg8::StaticOrder S; S.init(68, n8, G, bx);
          pg8::EpiRope8 E{QH, KH, VH, GT, ROPE, RS, CS};
          pg8::gemm_phase<pg8::EpiRope8, pg8::StaticOrder, PG8_ALIGN, PG8_SP2, true>(L + RING_OFF, g, S, E); }
        { pg8::Gemm g{Hb, WG0 + (size_t)(n8 - 32) * 1048576, 4096, 128u, 32u, 32768u, 2097152u, 128u, 32768u, 2097152u}; pg8::StaticOrder S; S.init(68, 64 - n8, G, G - 1 - bx);
          pg8::EpiRope E{QH, KH, VH, GT, ROPE, n8};
          pg8::gemm_phase<pg8::EpiRope, pg8::StaticOrder, PG8_ALIGN, PG8_SP2>(L + RING_OFF, g, S, E); }
        { const bool reg = (G == 256); const int ntw = reg ? 64 : G, ncw0 = reg ? 64 : 0, ncw = reg ? 160 : G;
          if (bx < ntw) {
        for (int g = 192 + bx; g < 256; g += ntw) {
            LAS f32x2* pw = (LAS f32x2*)L;
            LAS f32x2* Bb = (LAS f32x2*)(L + 17408);
            LAS f32x2* Cc = (LAS f32x2*)(L + 17408 + 16384);
            LAS float* Kt = (LAS float*)(L + 17408 + 32768);
            LAS f32x2* fz = (LAS f32x2*)(L + 17408 + 65536);
            if (tid < 128) {
                const int d = tid >> 6, p = tid & 63; const int gi = (d * 256 + g) * 64 + p;
                const double dt = exp_d((double)args.in[I_SLDT][d * 256 + g]);
                const double Ar = (double)args.in[I_SARE][gi], Ai = (double)args.in[I_SAIM][gi];
                const double mag = exp_d(Ar * dt); double sn, cs; sincos_d(Ai * dt, sn, cs);
                const double ar = mag * cs, ai = mag * sn;
                const double den = Ar * Ar + Ai * Ai;
                const double fr_ = ((ar - 1.0) * Ar + ai * Ai) / den, fi_ = (ai * Ar - (ar - 1.0) * Ai) / den;
                fz[d * 64 + p] = (f32x2){(float)fr_, (float)fi_};
                double pr = 1.0, pi = 0.0;
                for (int n = 0; n <= 16; ++n) { pw[(d * 17 + n) * 64 + p] = (f32x2){(float)pr, (float)pi}; const double t = pr * ar - pi * ai; pi = pr * ai + pi * ar; pr = t; }
                *(GAS f32x2*)(A16 + (size_t)gi * 2) = pw[(d * 17 + 16) * 64 + p];
            }
            __syncthreads();
            for (int e = tid; e < 2048; e += 512) {
                { const int d = e >> 10, p = (e >> 4) & 63, c = e & 15; const size_t gi = ((size_t)(d * 256 + g) * 64 + p) * 16 + c;
                  const float br = args.in[I_SBRE][gi], bi = args.in[I_SBIM][gi]; const f32x2 f = fz[d * 64 + p];
                  Bb[e] = (f32x2){f.x * br - f.y * bi, f.x * bi + f.y * br}; }
                { const int d = e >> 10, c = (e >> 6) & 15, p = e & 63; const size_t gi = ((size_t)(d * 256 + g) * 16 + c) * 64 + p;
                  Cc[e] = (f32x2){args.in[I_SCRE][gi], args.in[I_SCIM][gi]}; }
            }
            __syncthreads();
            {
                const int cp = tid & 15, c = (tid >> 4) & 15, d = tid >> 8; float kacc[16];
#pragma unroll
                for (int t = 0; t < 16; ++t) kacc[t] = 0.f;
                for (int p = 0; p < 64; ++p) { const f32x2 cc = Cc[(d * 16 + c) * 64 + p], bb = Bb[(d * 64 + p) * 16 + cp];
                    const float tr = cc.x * bb.x - cc.y * bb.y, ti = cc.x * bb.y + cc.y * bb.x;
#pragma unroll
                    for (int t = 0; t < 16; ++t) { const f32x2 aa = pw[(d * 17 + t) * 64 + p]; kacc[t] += tr * aa.x - ti * aa.y; } }
#pragma unroll
                for (int t = 0; t < 16; ++t) Kt[((d * 16 + t) * 16 + c) * 16 + cp] = kacc[t];
            }
            __syncthreads();
            const float* Dk = args.in[I_SD] + g * 16;
            for (int e = tid; e < 16384; e += 512) {
                const int ch = e & 63, n = e >> 6, t = n >> 4, c = n & 15; float v[8];
                if (ch < 32) { const int sI = ch >> 1, c0 = (ch & 1) * 8;
#pragma unroll
                    for (int i = 0; i < 8; ++i) v[i] = 0.f;
                    if (sI <= t) { const LAS f32x4* kp = (const LAS f32x4*)(Kt + ((0 * 16 + (t - sI)) * 16 + c) * 16 + c0); const f32x4 a0 = kp[0], a1 = kp[1];
                        v[0] += a0.x; v[1] += a0.y; v[2] += a0.z; v[3] += a0.w; v[4] += a1.x; v[5] += a1.y; v[6] += a1.z; v[7] += a1.w; }
                    if (sI >= t) { const LAS f32x4* kp = (const LAS f32x4*)(Kt + ((1 * 16 + (sI - t)) * 16 + c) * 16 + c0); const f32x4 a0 = kp[0], a1 = kp[1];
                        v[0] += a0.x; v[1] += a0.y; v[2] += a0.z; v[3] += a0.w; v[4] += a1.x; v[5] += a1.y; v[6] += a1.z; v[7] += a1.w; }
                    if (sI == t && (c >> 3) == (ch & 1)) { const float dk = Dk[c];
#pragma unroll
                        for (int i = 0; i < 8; ++i) v[i] += ((c & 7) == i) ? dk : 0.f; }
                } else { const int kk = (ch - 32) * 8, d = kk >> 7, p0 = (kk & 127) >> 1, pwn = d == 0 ? t + 1 : 16 - t;
#pragma unroll
                    for (int i = 0; i < 4; ++i) { const f32x2 cc = Cc[(d * 16 + c) * 64 + p0 + i], aa = pw[(d * 17 + pwn) * 64 + p0 + i]; v[2 * i] = cc.x * aa.x - cc.y * aa.y; v[2 * i + 1] = -(cc.x * aa.y + cc.y * aa.x); } }
                *(GAS v4u*)(W2tab + ((size_t)g * 256 + n) * 512 + 8 * ch) = (v4u){pk2(v[0], v[1]), pk2(v[2], v[3]), pk2(v[4], v[5]), pk2(v[6], v[7])};
            }
            for (int e = tid; e < 8192; e += 512) {
                const int ch = e & 31, n = e >> 5, d = n >> 7, p = (n & 127) >> 1, ri = n & 1, sI = ch >> 1, c0 = (ch & 1) * 8, pwn = d == 0 ? 15 - sI : sI;
                const f32x2 aa = pw[(d * 17 + pwn) * 64 + p]; float v[8];
#pragma unroll
                for (int i = 0; i < 8; ++i) { const f32x2 b = Bb[(d * 64 + p) * 16 + c0 + i]; v[i] = ri ? (aa.x * b.y + aa.y * b.x) : (aa.x * b.x - aa.y * b.y); }
                *(GAS v4u*)(Etab + ((size_t)g * 256 + n) * 256 + 8 * ch) = (v4u){pk2(v[0], v[1]), pk2(v[2], v[3]), pk2(v[4], v[5]), pk2(v[6], v[7])};
            }
            __syncthreads();
        }
          }
          if (bx >= ncw0 && bx < ncw0 + ncw) { LAS float* scr = (LAS float*)(L + RING_OFF + wave * 16384);
              for (int it = (bx - ncw0) * NWAVES + wave; it < 2 * 64 * 128; it += ncw * NWAVES) {
                  if (it < 64 * 128) transpose_item<false>(args.in[I_AWOUT], 4096, 4096, Wout0, scr, it, lane);
                  else colmax_item<false>(args.in[I_SWGLU], 4096, COLMAX2, it - 64 * 128, lane); } } }
    }
    SEAM(2);

    if (IN(3)) {
        { constexpr int NBLK = 32 * 17408 / 32; const int nsw = G * NWAVES;
          for (int blk = bx * NWAVES + wave; blk < NBLK; blk += nsw) {
              v4u kv[8]; const size_t r0 = (size_t)blk * 32 + (lane >> 4);
#pragma unroll
              for (int u = 0; u < 8; ++u) kv[u] = __builtin_nontemporal_load((const v4u*)(KH + (r0 + 4 * u) * 128 + (lane & 15) * 8));
              float m = 0.f;
#pragma unroll
              for (int u = 0; u < 8; ++u) { m = fmaxf(m, fmaxf(fmaxf(__builtin_fabsf(pg8::bflo(kv[u].x)), __builtin_fabsf(pg8::bfhi(kv[u].x))), fmaxf(__builtin_fabsf(pg8::bflo(kv[u].y)), __builtin_fabsf(pg8::bfhi(kv[u].y)))));
                                            m = fmaxf(m, fmaxf(fmaxf(__builtin_fabsf(pg8::bflo(kv[u].z)), __builtin_fabsf(pg8::bfhi(kv[u].z))), fmaxf(__builtin_fabsf(pg8::bflo(kv[u].w)), __builtin_fabsf(pg8::bfhi(kv[u].w))))); }
              m = fmaxf(m, __shfl_xor(m, 1)); m = fmaxf(m, __shfl_xor(m, 2)); m = fmaxf(m, __shfl_xor(m, 4)); m = fmaxf(m, __shfl_xor(m, 8)); m = fmaxf(m, __shfl_xor(m, 16)); m = fmaxf(m, __shfl_xor(m, 32));
              const float inv = m > 0.f ? 127.f / m : 0.f;
#pragma unroll
              for (int u = 0; u < 8; ++u) { v2u o; o.x = q8pack(pg8::bflo(kv[u].x) * inv, pg8::bfhi(kv[u].x) * inv, pg8::bflo(kv[u].y) * inv, pg8::bfhi(kv[u].y) * inv); o.y = q8pack(pg8::bflo(kv[u].z) * inv, pg8::bfhi(kv[u].z) * inv, pg8::bflo(kv[u].w) * inv, pg8::bfhi(kv[u].w) * inv);
                  *(GAS v2u*)(K8 + (r0 + 4 * u) * 128 + (lane & 15) * 8) = o; }
              if (lane == 0) KSC[blk] = m * (1.f / 127.f); } }
        xcd_barrier(bar);
        float* sml = (float*)((char*)lds + ATT_SML_OFF);
        for (int i = 0;; ++i) {
            const long Lu = (long)i * G + bx; if (Lu >= 2176) break;
            int b, h, n, qrow0, seq;
            if (Lu < 2048) { const int xcd = (int)(Lu & 7), k = (int)(Lu >> 3), bh = xcd * 8 + (k >> 5), r = k & 31; b = bh >> 4; h = bh & 15; n = r >> 4; qrow0 = b * 4096 + (r & 15) * 256; seq = 4352; }
            else { const int e = (int)Lu - 2048; b = e >> 5; h = (e >> 1) & 15; n = e & 1; qrow0 = MLAT + b * 256; seq = 256; }
            const size_t hm = (size_t)(h * 2 + n) * 17408, qk0 = hm * 128, v0 = (size_t)h * 17408 * 256; const size_t crow = MLAT + b * 256, lrow = b * 4096;
            att2::attn_unit256q(QH + qk0 + (size_t)qrow0 * 128, K8 + (hm + crow) * 128, K8 + (hm + lrow) * 128, KSC + (hm + crow) / 32, KSC + (hm + lrow) / 32, VH + v0 + crow * 256, VH + v0 + lrow * 256,
                                OB + (size_t)qrow0 * 8192 + n * 4096 + h * 256, seq, (char*)lds + RING_OFF, sml);
        }
        __syncthreads();
    }
    SEAM(3);

    if (IN(4)) {
        const float* lv = args.in[I_ALAM]; const float* sub = args.in[I_ASUB];
        const float d01 = wave_sum(lv[lane] * lv[128 + lane] + lv[64 + lane] * lv[192 + lane]);
        const float d23 = wave_sum(lv[256 + lane] * lv[384 + lane] + lv[320 + lane] * lv[448 + lane]);
        const float lam = __expf(d01) - __expf(d23) + 0.2f;
        const int hl = lane >> 5, cl = (lane & 31) * 8;
        f32x4 sg0 = *(const GAS f32x4*)(sub + cl), sg1 = *(const GAS f32x4*)(sub + cl + 4);
        sg0 = sg0 * 0.8f; sg1 = sg1 * 0.8f;
        for (int row = gw; row < MTOT; row += NGW) {
            const bf16* o0p = OB + (size_t)row * 8192; const bf16* gp = GT + (size_t)row * DM;
            v4u av[8], bv[8], gv[8];
#pragma unroll
            for (int j = 0; j < 8; ++j) { const int col = (2 * j + hl) * 256 + cl;
                av[j] = __builtin_nontemporal_load((const GAS v4u*)(o0p + col)); bv[j] = __builtin_nontemporal_load((const GAS v4u*)(o0p + 4096 + col)); gv[j] = __builtin_nontemporal_load((const GAS v4u*)(gp + col)); }
#pragma unroll
            for (int j = 0; j < 8; ++j) { const int col = (2 * j + hl) * 256 + cl; const v4u a = av[j], b = bv[j], gt = gv[j];
                float o[8];
                o[0] = pg8::bflo(a.x) - lam * pg8::bflo(b.x); o[1] = pg8::bfhi(a.x) - lam * pg8::bfhi(b.x); o[2] = pg8::bflo(a.y) - lam * pg8::bflo(b.y); o[3] = pg8::bfhi(a.y) - lam * pg8::bfhi(b.y);
                o[4] = pg8::bflo(a.z) - lam * pg8::bflo(b.z); o[5] = pg8::bfhi(a.z) - lam * pg8::bfhi(b.z); o[6] = pg8::bflo(a.w) - lam * pg8::bflo(b.w); o[7] = pg8::bfhi(a.w) - lam * pg8::bfhi(b.w);
                float ss = 0.f;
#pragma unroll
                for (int e = 0; e < 8; ++e) ss += o[e] * o[e];
                const float rstd = __builtin_amdgcn_rsqf(half_sum(ss) * (1.f / 256.f) + EPS);
                float gg[8] = {pg8::bflo(gt.x), pg8::bfhi(gt.x), pg8::bflo(gt.y), pg8::bfhi(gt.y), pg8::bflo(gt.z), pg8::bfhi(gt.z), pg8::bflo(gt.w), pg8::bfhi(gt.w)};
#pragma unroll
                for (int e = 0; e < 8; ++e) o[e] = o[e] * rstd * (e < 4 ? sg0[e] : sg1[e - 4]) * (gg[e] * pg8::sigmoidf_fast(gg[e]));
                *(GAS v4u*)(AO + pg8::blk_off(row, col)) = (v4u){pk2(o[0], o[1]), pk2(o[2], o[3]), pk2(o[4], o[5]), pk2(o[6], o[7])}; }
        }
    }
    SEAM(4);

    if (IN(5)) {
        pg8::Gemm g{AO, Wout0, 4096, 128u, 32u, 32768u, 2097152u, 128u, 32768u, 2097152u}; pg8::StaticOrder S; S.init(68, 16, G, bx);
        pg8::EpiStore E{OUT0, 4096, 1};
        pg8::gemm_phase<pg8::EpiStore, pg8::StaticOrder, PG8_ALIGN, PG8_SP2>(L + RING_OFF, g, S, E);
        const int first_free = (G > 64) ? 64 : 0, nfree = G - first_free;
        if (bx >= first_free) {
            LAS float* sv = (LAS float*)L; LAS f32x4* red = (LAS f32x4*)(L + 8192);
            for (int item = 384 + (bx - first_free); item < 768; item += nfree) GEMV_ITEM(item);
            __syncthreads();
            { LAS float* scr = (LAS float*)(L + RING_OFF + wave * 16384); const int nfw = nfree * NWAVES;
              for (int it = (bx - first_free) * NWAVES + wave; it < 64 * 256; it += nfw) transpose_item<false>(args.in[I_SWIN], 4096, 8192, W5in, scr, it, lane); }
        }
    }
    SEAM(5);

    if (IN(6)) {
        const float* npost = args.in[I_NPOST]; const float* npre1 = args.in[I_NPRE] + 4096;
        const int wgb = G >> 2, bq = (wgb > 0) ? vcu / wgb : 4, wl = (wgb > 0) ? vcu % wgb : 0;
        LAS f32x4* Vg = (LAS f32x4*)L; LAS f32x4* Va = Vg + 1024; LAS f32x4* Vs = Va + 1024;
#define P6_LOADVEC(mb) do { const float* gate0_ = MOD + (size_t)(mb) * 12288 + 8192; const float* shift1_ = MOD + (size_t)(5 + (mb)) * 12288; const float* scale1_ = shift1_ + 4096; \
            for (int q = tid; q < 1024; q += NWAVES * 64) { Vg[q] = ((const GAS f32x4*)gate0_)[q] * ((const GAS f32x4*)npost)[q]; Va[q] = ((const GAS f32x4*)npre1)[q] * (((const GAS f32x4*)scale1_)[q] + 1.f); Vs[q] = ((const GAS f32x4*)shift1_)[q]; } } while (0)
#define P6_ROW(row, xr, LAT) do { const bf16* op = OUT0 + (size_t)(row) * DM; \
            unsigned vbase = (unsigned)lane * 16u; asm volatile("" : "+v"(vbase)); \
            const LAS f32x4* Vg_ = (const LAS f32x4*)(L + vbase); const LAS f32x4* Va_ = Vg_ + 1024; const LAS f32x4* Vs_ = Va_ + 1024; \
            v2u ov[16]; float ss = 0.f; \
            _Pragma("unroll") for (int j = 0; j < 16; ++j) { ov[j] = ((const GAS v2u*)op)[lane + 64 * j]; const float a = pg8::bflo(ov[j].x), b = pg8::bfhi(ov[j].x), c = pg8::bflo(ov[j].y), d = pg8::bfhi(ov[j].y); ss += (a * a + b * b) + (c * c + d * d); } \
            f32x4 v[16]; \
            _Pragma("unroll") for (int j = 0; j < 16; ++j) v[j] = ((const GAS f32x4*)(xr))[lane + 64 * j]; \
            const float rstd0 = __builtin_amdgcn_rsqf(wave_sum(ss) * (1.f / DM) + EPS); float ss1 = 0.f; \
            _Pragma("unroll") for (int j = 0; j < 16; ++j) { const f32x4 o4 = {pg8::bflo(ov[j].x), pg8::bfhi(ov[j].x), pg8::bflo(ov[j].y), pg8::bfhi(ov[j].y)}; \
                v[j] = v[j] + Vg_[64 * j] * (o4 * rstd0); ss1 += (v[j].x * v[j].x + v[j].y * v[j].y) + (v[j].z * v[j].z + v[j].w * v[j].w); \
                if (LAT) ((GAS v2u*)(X1B + (size_t)(row) * DM))[lane + 64 * j] = (v2u){pk2(v[j].x, v[j].y), pk2(v[j].z, v[j].w)}; if ((j & 3) == 3) __builtin_amdgcn_sched_barrier(0); } \
            const float rstd1 = __builtin_amdgcn_rsqf(wave_sum(ss1) * (1.f / DM) + EPS); \
            _Pragma("unroll") for (int j = 0; j < 16; ++j) { const f32x4 h = v[j] * rstd1 * Va_[64 * j] + Vs_[64 * j]; *(GAS v2u*)(Hb + pg8::blk_off((row), 4 * (lane + 64 * j))) = (v2u){pk2(h.x, h.y), pk2(h.z, h.w)}; \
                if ((j & 3) == 3) __builtin_amdgcn_sched_barrier(0); } } while (0)
        if (bq < 4) P6_LOADVEC(bq);
        __syncthreads();
        if (bq < 4) for (int r = wl * NWAVES + wave; r < SEQL; r += wgb * NWAVES) { const int row = bq * SEQL + r; P6_ROW(row, x + (size_t)row * DM, true); }
        __syncthreads();
        P6_LOADVEC(4);
        __syncthreads();
        for (int row = MLAT + gw; row < MTOT; row += NGW) P6_ROW(row, ctx + (size_t)(row - MLAT) * DM, false);
        __syncthreads();
#undef P6_ROW
#undef P6_LOADVEC
    }
    SEAM(6);

    if (IN(7)) {
        pg8::Gemm g{Hb, W5in, 4096, 128u, 32u, 32768u, 2097152u, 128u, 32768u, 2097152u}; pg8::OrderP7 S{G, bx};
        pg8::EpiS5In E{XS, SZ};
        pg8::gemm_phase<pg8::EpiS5In, pg8::OrderP7, PG8_ALIGN, PG8_SP2>(L + RING_OFF, g, S, E);
        { const int first_free = (G > 64) ? 64 : 0, nfw = (G - first_free) * NWAVES;
          if (bx >= first_free) {
        for (int g = bx - first_free; g < ((G >= 128) ? 192 : 256); g += G - first_free) {
            LAS f32x2* pw = (LAS f32x2*)L;
            LAS f32x2* Bb = (LAS f32x2*)(L + 17408);
            LAS f32x2* Cc = (LAS f32x2*)(L + 17408 + 16384);
            LAS float* Kt = (LAS float*)(L + 17408 + 32768);
            LAS f32x2* fz = (LAS f32x2*)(L + 17408 + 65536);
            if (tid < 128) {
                const int d = tid >> 6, p = tid & 63; const int gi = (d * 256 + g) * 64 + p;
                const double dt = exp_d((double)args.in[I_SLDT][d * 256 + g]);
                const double Ar = (double)args.in[I_SARE][gi], Ai = (double)args.in[I_SAIM][gi];
                const double mag = exp_d(Ar * dt); double sn, cs; sincos_d(Ai * dt, sn, cs);
                const double ar = mag * cs, ai = mag * sn;
                const double den = Ar * Ar + Ai * Ai;
                const double fr_ = ((ar - 1.0) * Ar + ai * Ai) / den, fi_ = (ai * Ar - (ar - 1.0) * Ai) / den;
                fz[d * 64 + p] = (f32x2){(float)fr_, (float)fi_};
                double pr = 1.0, pi = 0.0;
                for (int n = 0; n <= 16; ++n) { pw[(d * 17 + n) * 64 + p] = (f32x2){(float)pr, (float)pi}; const double t = pr * ar - pi * ai; pi = pr * ai + pi * ar; pr = t; }
                *(GAS f32x2*)(A16 + (size_t)gi * 2) = pw[(d * 17 + 16) * 64 + p];
            }
            __syncthreads();
            for (int e = tid; e < 2048; e += 512) {
                { const int d = e >> 10, p = (e >> 4) & 63, c = e & 15; const size_t gi = ((size_t)(d * 256 + g) * 64 + p) * 16 + c;
                  const float br = args.in[I_SBRE][gi], bi = args.in[I_SBIM][gi]; const f32x2 f = fz[d * 64 + p];
                  Bb[e] = (f32x2){f.x * br - f.y * bi, f.x * bi + f.y * br}; }
                { const int d = e >> 10, c = (e >> 6) & 15, p = e & 63; const size_t gi = ((size_t)(d * 256 + g) * 16 + c) * 64 + p;
                  Cc[e] = (f32x2){args.in[I_SCRE][gi], args.in[I_SCIM][gi]}; }
            }
            __syncthreads();
            {
                const int cp = tid & 15, c = (tid >> 4) & 15, d = tid >> 8; float kacc[16];
#pragma unroll
                for (int t = 0; t < 16; ++t) kacc[t] = 0.f;
                for (int p = 0; p < 64; ++p) { const f32x2 cc = Cc[(d * 16 + c) * 64 + p], bb = Bb[(d * 64 + p) * 16 + cp];
                    const float tr = cc.x * bb.x - cc.y * bb.y, ti = cc.x * bb.y + cc.y * bb.x;
#pragma unroll
                    for (int t = 0; t < 16; ++t) { const f32x2 aa = pw[(d * 17 + t) * 64 + p]; kacc[t] += tr * aa.x - ti * aa.y; } }
#pragma unroll
                for (int t = 0; t < 16; ++t) Kt[((d * 16 + t) * 16 + c) * 16 + cp] = kacc[t];
            }
            __syncthreads();
            const float* Dk = args.in[I_SD] + g * 16;
            for (int e = tid; e < 16384; e += 512) {
                const int ch = e & 63, n = e >> 6, t = n >> 4, c = n & 15; float v[8];
                if (ch < 32) { const int sI = ch >> 1, c0 = (ch & 1) * 8;
#pragma unroll
                    for (int i = 0; i < 8; ++i) v[i] = 0.f;
                    if (sI <= t) { const LAS f32x4* kp = (const LAS f32x4*)(Kt + ((0 * 16 + (t - sI)) * 16 + c) * 16 + c0); const f32x4 a0 = kp[0], a1 = kp[1];
                        v[0] += a0.x; v[1] += a0.y; v[2] += a0.z; v[3] += a0.w; v[4] += a1.x; v[5] += a1.y; v[6] += a1.z; v[7] += a1.w; }
                    if (sI >= t) { const LAS f32x4* kp = (const LAS f32x4*)(Kt + ((1 * 16 + (sI - t)) * 16 + c) * 16 + c0); const f32x4 a0 = kp[0], a1 = kp[1];
                        v[0] += a0.x; v[1] += a0.y; v[2] += a0.z; v[3] += a0.w; v[4] += a1.x; v[5] += a1.y; v[6] += a1.z; v[7] += a1.w; }
                    if (sI == t && (c >> 3) == (ch & 1)) { const float dk = Dk[c];
#pragma unroll
                        for (int i = 0; i < 8; ++i) v[i] += ((c & 7) == i) ? dk : 0.f; }
                } else { const int kk = (ch - 32) * 8, d = kk >> 7, p0 = (kk & 127) >> 1, pwn = d == 0 ? t + 1 : 16 - t;
#pragma unroll
                    for (int i = 0; i < 4; ++i) { const f32x2 cc = Cc[(d * 16 + c) * 64 + p0 + i], aa = pw[(d * 17 + pwn) * 64 + p0 + i]; v[2 * i] = cc.x * aa.x - cc.y * aa.y; v[2 * i + 1] = -(cc.x * aa.y + cc.y * aa.x); } }
                *(GAS v4u*)(W2tab + ((size_t)g * 256 + n) * 512 + 8 * ch) = (v4u){pk2(v[0], v[1]), pk2(v[2], v[3]), pk2(v[4], v[5]), pk2(v[6], v[7])};
            }
            for (int e = tid; e < 8192; e += 512) {
                const int ch = e & 31, n = e >> 5, d = n >> 7, p = (n & 127) >> 1, ri = n & 1, sI = ch >> 1, c0 = (ch & 1) * 8, pwn = d == 0 ? 15 - sI : sI;
                const f32x2 aa = pw[(d * 17 + pwn) * 64 + p]; float v[8];
#pragma unroll
                for (int i = 0; i < 8; ++i) { const f32x2 b = Bb[(d * 64 + p) * 16 + c0 + i]; v[i] = ri ? (aa.x * b.y + aa.y * b.x) : (aa.x * b.x - aa.y * b.y); }
                *(GAS v4u*)(Etab + ((size_t)g * 256 + n) * 256 + 8 * ch) = (v4u){pk2(v[0], v[1]), pk2(v[2], v[3]), pk2(v[4], v[5]), pk2(v[6], v[7])};
            }
            __syncthreads();
        }
              LAS float* scr = (LAS float*)(L + RING_OFF + wave * 16384);
              for (int it = (bx - first_free) * NWAVES + wave; it < 2 * 64 * 128; it += nfw) {
                  if (it < 64 * 128) quant_item<false>(args.in[I_SWGLU], 4096, COLMAX2, WGLU8, CS2, scr, it, lane);
                  else transpose_item<false>(args.in[I_SWOUT], 4096, 4096, W5out, scr, it - 64 * 128, lane); } } }
    }
    SEAM(7);

    if (IN(8)) {
        { pg8::Gemm g{XS, Etab, 256, 1024u, 32u, 128u, 262144u, 512u, 128u, 131072u}; pg8::OrderGrp<5> S{G, vcu};
          pg8::EpiStore E{HLOC, 256, 0};
          pg8::gemm_phase<pg8::EpiStore, pg8::OrderGrp<5>, PG8_ALIGN, PG8_SP2>(L + RING_OFF, g, S, E); }
        asm volatile("s_waitcnt vmcnt(0)" ::: "memory"); __syncthreads();
        for (int g = vcu; g < 256; g += G) {
            const int d = wave & 1, b = wave >> 1, p = lane;
            const f32x2 a = *(const GAS f32x2*)(A16 + ((size_t)(d * 256 + g) * 64 + p) * 2);
            const bf16* hl = HLOC + (size_t)g * 1280 * 256 + d * 128 + 2 * p; bf16* xo = XS + (size_t)g * 1280 * 512 + 256 + d * 128 + 2 * p;
            float hr = 0.f, hi_ = 0.f;
            {   unsigned v[16];
#pragma unroll
                for (int j = 0; j < 16; ++j) { const int cj = d ? 15 - j : j; v[j] = *(const GAS unsigned*)(hl + (size_t)(1024 + b * 16 + cj) * 256); }
#pragma unroll
                for (int j = 0; j < 16; ++j) { const float tr = a.x * hr - a.y * hi_ + pg8::bflo(v[j]), ti = a.x * hi_ + a.y * hr + pg8::bfhi(v[j]); hr = tr; hi_ = ti; } }
            for (int j0 = 0; j0 < 256; j0 += 32) {
                unsigned v[32];
#pragma unroll
                for (int j = 0; j < 32; ++j) { const int cj = d ? 255 - (j0 + j) : (j0 + j); v[j] = *(const GAS unsigned*)(hl + (size_t)(b * 256 + cj) * 256); }
#pragma unroll
                for (int j = 0; j < 32; ++j) { const int cj = d ? 255 - (j0 + j) : (j0 + j);
                    *(GAS unsigned*)(xo + (size_t)(b * 256 + cj) * 512) = pk2(hr, hi_);
                    const float tr = a.x * hr - a.y * hi_ + pg8::bflo(v[j]), ti = a.x * hi_ + a.y * hr + pg8::bfhi(v[j]); hr = tr; hi_ = ti; }
            }
        }
        asm volatile("s_waitcnt vmcnt(0)" ::: "memory"); __syncthreads();
        { pg8::Gemm g{XS, W2tab, 512, 1024u, 32u, 128u, 262144u, 1024u, 128u, 262144u}; pg8::OrderGrp<4> S{G, vcu};
          pg8::EpiS5Out E{YG, TOKMAX};
          pg8::gemm_phase<pg8::EpiS5Out, pg8::OrderGrp<4>, PG8_ALIGN, PG8_SP2>(L + RING_OFF, g, S, E); }
    }
    if (IN(8) && IN(11)) xcd_barrier(bar);


    if (IN(11)) {
        for (int it = bx; it < 1024; it += G) { const int tb = it >> 5, gb = it & 31, g = gb * 8 + wave;
            v4u y0[8], y1[8]; float tm[8];
#pragma unroll
            for (int u = 0; u < 8; ++u) { const int token = tb * 512 + u * 64 + lane; const v4u* yp = (const v4u*)(YG + ((size_t)g * 16384 + token) * 16);
                y0[u] = __builtin_nontemporal_load(yp); y1[u] = __builtin_nontemporal_load(yp + 1); tm[u] = __uint_as_float(TOKMAX[token]); }
#pragma unroll
            for (int u = 0; u < 8; ++u) { const float inv = tm[u] > 0.f ? 127.f / tm[u] : 0.f;
                v4u o; o.x = q8pack(pg8::bflo(y0[u].x) * inv, pg8::bfhi(y0[u].x) * inv, pg8::bflo(y0[u].y) * inv, pg8::bfhi(y0[u].y) * inv); o.y = q8pack(pg8::bflo(y0[u].z) * inv, pg8::bfhi(y0[u].z) * inv, pg8::bflo(y0[u].w) * inv, pg8::bfhi(y0[u].w) * inv);
                o.z = q8pack(pg8::bflo(y1[u].x) * inv, pg8::bfhi(y1[u].x) * inv, pg8::bflo(y1[u].y) * inv, pg8::bfhi(y1[u].y) * inv); o.w = q8pack(pg8::bflo(y1[u].z) * inv, pg8::bfhi(y1[u].z) * inv, pg8::bflo(y1[u].w) * inv, pg8::bfhi(y1[u].w) * inv);
                *(LAS v4u*)(L + RING_OFF + (u * 64 + lane) * 128 + ((wave ^ (lane & 7)) << 4)) = o;
                if (gb == 0 && wave == 0) RS[tb * 512 + u * 64 + lane] = tm[u] * (1.f / 127.f); }
            __syncthreads();
#pragma unroll
            for (int i = 0; i < 8; ++i) { const int row = wave * 64 + i * 8 + (lane >> 3), piece = lane & 7;
                const v4u o = *(const LAS v4u*)(L + RING_OFF + row * 128 + ((piece ^ (row & 7)) << 4));
                *(GAS v4u*)(A8 + pg8::blk8_off(tb * 512 + row, gb * 128) + piece * 16) = o; }
            __syncthreads(); }
        xcd_barrier(bar);
        pg8::Gemm g{(const pg8::bf16_t*)A8, (const pg8::bf16_t*)WGLU8, 2048, 128u, 32u, 32768u, 1048576u, 128u, 32768u, 1048576u}; pg8::StaticOrder S; S.init(64, 16, G, bx);
        pg8::EpiGlu8 E{YG, SZ, Y2, RS, CS2};
        pg8::gemm_phase<pg8::EpiGlu8, pg8::StaticOrder, PG8_ALIGN, PG8_SP2, true>(L + RING_OFF, g, S, E);
    }
    SEAM(11);

    if (IN(12)) {
        pg8::Gemm g{Y2, W5out, 4096, 128u, 32u, 32768u, 2097152u, 128u, 32768u, 2097152u}; pg8::StaticOrder S; S.init(64, 16, G, bx);
        pg8::EpiStore E{OUT1, 4096, 1};
        pg8::gemm_phase<pg8::EpiStore, pg8::StaticOrder, PG8_ALIGN, PG8_SP2>(L + RING_OFF, g, S, E);
    }
    SEAM(12);

    if (IN(13)) {
        const float* npost1 = args.in[I_NPOST] + 4096;
        const int wgb = G >> 2, bq = (wgb > 0) ? vcu / wgb : 4, wl = (wgb > 0) ? vcu % wgb : 0;
        LAS f32x4* Vg = (LAS f32x4*)L;
        if (bq < 4) { const float* gate1 = MOD + (size_t)(5 + bq) * 12288 + 8192;
            for (int q = tid; q < 1024; q += NWAVES * 64) Vg[q] = ((const GAS f32x4*)gate1)[q] * ((const GAS f32x4*)npost1)[q]; }
        __syncthreads();
        if (bq < 4) for (int r = wl * NWAVES + wave; r < SEQL; r += wgb * NWAVES) {
            const int row = bq * SEQL + r; const bf16* op = OUT1 + (size_t)row * DM; float* xo = args.out + (size_t)row * DM;
            unsigned vbase = (unsigned)lane * 16u; asm volatile("" : "+v"(vbase));
            const LAS f32x4* Vg_ = (const LAS f32x4*)(L + vbase);
            v2u ov[16]; float ss = 0.f;
#pragma unroll
            for (int j = 0; j < 16; ++j) { ov[j] = ((const GAS v2u*)op)[lane + 64 * j]; const float a = pg8::bflo(ov[j].x), b = pg8::bfhi(ov[j].x), c = pg8::bflo(ov[j].y), d = pg8::bfhi(ov[j].y); ss += (a * a + b * b) + (c * c + d * d); }
            v2u xv[16]; const bf16* x1p = X1B + (size_t)row * DM;
#pragma unroll
            for (int j = 0; j < 16; ++j) xv[j] = ((const GAS v2u*)x1p)[lane + 64 * j];
            const float rstd = __builtin_amdgcn_rsqf(wave_sum(ss) * (1.f / DM) + EPS);
#pragma unroll
            for (int j = 0; j < 16; ++j) { const f32x4 o4 = {pg8::bflo(ov[j].x), pg8::bfhi(ov[j].x), pg8::bflo(ov[j].y), pg8::bfhi(ov[j].y)};
                const f32x4 x4 = {pg8::bflo(xv[j].x), pg8::bfhi(xv[j].x), pg8::bflo(xv[j].y), pg8::bfhi(xv[j].y)};
                ((GAS f32x4*)xo)[lane + 64 * j] = x4 + Vg_[64 * j] * (o4 * rstd); if ((j & 3) == 3) __builtin_amdgcn_sched_barrier(0); }
        }
    }
#undef IN
#undef SEAM
}

extern "C" void kernel_launch(void* const* d_in, const int* in_sizes, int n_in, void* d_out, int out_size, void* d_ws, size_t ws_size, hipStream_t stream) {
    static int grid = 0;
    if (grid == 0) {
        if (n_in != 23 || out_size != MLAT * DM || ws_size < WS_END) { fprintf(stderr, "kernel_launch: unexpected shapes: n_in %d out %d ws %zu (need %zu)\n", n_in, out_size, ws_size, (size_t)WS_END); grid = -1; return; }
        int dev = 0, cus = 0, per_cu = 0;
        if (hipGetDevice(&dev) != hipSuccess || hipDeviceGetAttribute(&cus, hipDeviceAttributeMultiprocessorCount, dev) != hipSuccess) { grid = -1; return; }
        if (hipFuncSetAttribute((const void*)fwd_kernel, hipFuncAttributeMaxDynamicSharedMemorySize, LDS_BYTES) != hipSuccess) { fprintf(stderr, "kernel_launch: hipFuncSetAttribute failed\n"); grid = -1; return; }
        if (hipOccupancyMaxActiveBlocksPerMultiprocessor(&per_cu, (const void*)fwd_kernel, NWAVES * 64, LDS_BYTES) != hipSuccess || per_cu < 1) { fprintf(stderr, "kernel_launch: occupancy query says %d\n", per_cu); }
        (void)hipGetLastError();
        grid = cus;
    }
    if (grid < 0) return;
    if (hipMemsetAsync((char*)d_ws + WS_CTL, 0, CTL_ZERO_BYTES, stream) != hipSuccess) return;
    Args a{};
    for (int i = 0; i < 23; ++i) a.in[i] = (const float*)d_in[i];
    a.out = (float*)d_out; a.ws = (unsigned char*)d_ws;
#if MK_PER_PHASE
    for (int p = 0; p < MK_LAST_PHASE; ++p) { a.ph_lo = p; a.ph_hi = p + 1; hipLaunchKernelGGL(fwd_kernel, dim3(grid), dim3(NWAVES * 64), LDS_BYTES, stream, a); }
#else
    a.ph_lo = 0; a.ph_hi = MK_LAST_PHASE;
    hipLaunchKernelGGL(fwd_kernel, dim3(grid), dim3(NWAVES * 64), LDS_BYTES, stream, a);
#endif
    const hipError_t le = hipPeekAtLastError();
    if (le != hipSuccess) fprintf(stderr, "kernel_launch: launch failed: %s\n", hipGetErrorName(le));
}
```
